# Optimizing an MI355X kernel written in HIP

```python
import math
import jax
import jax.numpy as jnp
from jax import lax
import numpy as np

D_MODEL = 4096
BATCH = 1
SEQ = 16384
DEPTH = 2

GRID_W = 64
CTX_LEN = 256
NORM_EPS = 1e-6

N_BRANCH = 3
D_BRANCH = D_MODEL // 4

D_A = D_BRANCH
H_A = 8
DV_A = D_A // H_A
DK_A = DV_A // 2
MLSTM_CHUNK = 128
GATE_CAP = 15.0

D_B = D_BRANCH
HYENA_ORDER = 2
N_BANDS = 16
EMB_DIM = 2 * N_BANDS + 1
FILTER_ORDER = 64
SHORT_W = 3
DECAY_TARGET = 1e-2
FAST_DECAY = 0.3
SLOW_DECAY = 1.5

D_C = D_BRANCH
HS_C = 64
H_C = D_C // HS_C
DECAY_LORA = 64
AAA_LORA = 64
GATE_LORA = 160
GN_EPS = 64e-5

N_A = 2 * H_A * DK_A + 2 * D_A + 4 * H_A
N_B = 3 * D_B
N_C = 3 * D_C + 2 * DECAY_LORA + 2 * AAA_LORA + GATE_LORA
N_G = N_BRANCH * D_MODEL
N_IN = N_A + N_B + N_C + N_G
IN_SPLITS = (N_A, N_A + N_B, N_A + N_B + N_C)
MLSTM_SPLITS = (H_A * DK_A, 2 * H_A * DK_A, 2 * H_A * DK_A + D_A, 2 * H_A * DK_A + 2 * D_A)
RWKV_SPLITS = (D_C, 2 * D_C, 3 * D_C, 3 * D_C + 2 * DECAY_LORA, 3 * D_C + 2 * DECAY_LORA + 2 * AAA_LORA)

N_EXPERTS = 32
TOP_K = 4
D_EXPERT = 512
SWIGLU_LIMIT = 7.0
SWIGLU_ALPHA = 1.702
MOE_BLOCK = 128

kernel_name = 'hybrid_mlstm_hyena_rwkv7_moe_dit'


def _rmsnorm(x, g):
    xf = x.astype(jnp.float32)
    return (xf * lax.rsqrt(jnp.mean(jnp.square(xf), axis=-1, keepdims=True) + NORM_EPS)).astype(x.dtype) * g


def _modulate(x, g, shift, scale):
    return _rmsnorm(x, g) * (1.0 + scale) + shift


def _shift3(t):
    tp = jnp.pad(t, ((0, 0), (1, 1), (0, 0)))
    return tp[:, :-2], tp[:, 2:]


def _to_colmajor(t, rows):
    b, l, ch = t.shape
    return t.reshape(b, rows, GRID_W, ch).transpose(0, 2, 1, 3).reshape(b, l, ch)


def _from_colmajor(t, rows):
    b, l, ch = t.shape
    return t.reshape(b, GRID_W, rows, ch).transpose(0, 2, 1, 3).reshape(b, l, ch)


def _mlstm_scan(q, k, v, i_pre, log_f, state):
    b_, h_, l_, _ = q.shape
    nc = l_ // MLSTM_CHUNK

    def chunks(a):
        return jnp.moveaxis(a.reshape(a.shape[:2] + (nc, MLSTM_CHUNK) + a.shape[3:]), 2, 0)

    lower = jnp.tril(jnp.ones((MLSTM_CHUNK, MLSTM_CHUNK), dtype=bool))

    def step(carry, inp):
        C, n, m = carry
        qc, kc, vc, ic, fc = inp
        b = jnp.cumsum(fc, axis=-1)
        log_d = jnp.where(lower, b[..., :, None] - b[..., None, :] + ic[..., None, :], -jnp.inf)
        inter = b + m[..., None]
        m_t = jnp.maximum(inter, jnp.max(log_d, axis=-1))
        w_prev = jnp.exp(inter - m_t)
        s = jnp.einsum('bhtk,bhsk->bhts', qc, kc) * jnp.exp(log_d - m_t[..., None])
        num = jnp.einsum('bhts,bhsv->bhtv', s, vc) + w_prev[..., None] * jnp.einsum('bhtk,bhkv->bhtv', qc, C)
        den = jnp.sum(s, axis=-1) + w_prev * jnp.einsum('bhtk,bhk->bht', qc, n)
        h = num / jnp.maximum(jnp.abs(den), jnp.exp(-m_t))[..., None]
        b_end = b[..., -1]
        log_w = b_end[..., None] - b + ic
        m_new = jnp.maximum(b_end + m, jnp.max(log_w, axis=-1))
        w = jnp.exp(log_w - m_new[..., None])
        keep = jnp.exp(b_end + m - m_new)
        C = keep[..., None, None] * C + jnp.einsum('bhs,bhsk,bhsv->bhkv', w, kc, vc)
        n = keep[..., None] * n + jnp.einsum('bhs,bhsk->bhk', w, kc)
        return (C, n, m_new), h

    state, hs = lax.scan(step, state, tuple(chunks(a) for a in (q, k, v, i_pre, log_f)))
    return jnp.moveaxis(hs, 0, 2).reshape(b_, h_, l_, v.shape[-1]), state


def _mlstm_zero_state(batch):
    st = (jnp.zeros((batch, H_A, DK_A, DV_A), jnp.float32),
          jnp.zeros((batch, H_A, DK_A), jnp.float32),
          jnp.zeros((batch, H_A), jnp.float32))
    return (st, st)


def _mlstm(za, gate_bias, norm_g, states):
    b_, l_, _ = za.shape
    q, k, v, o, gates = jnp.split(za, MLSTM_SPLITS, axis=-1)

    def heads(t, d):
        return t.reshape(b_, l_, H_A, d).transpose(0, 2, 1, 3)

    q, k, v = heads(q, DK_A) * DK_A ** -0.5, heads(k, DK_A), heads(v, DV_A)
    gates = gates.reshape(b_, l_, 2, 2, H_A).astype(jnp.float32) + gate_bias
    gates = (GATE_CAP * jnp.tanh(gates / GATE_CAP)).transpose(2, 3, 0, 4, 1)

    def fl(t):
        return jnp.flip(t, axis=2)

    h_f, st_f = _mlstm_scan(q, k, v, gates[0, 0], jax.nn.log_sigmoid(gates[0, 1]), states[0])
    h_b, st_b = _mlstm_scan(fl(q), fl(k), fl(v), fl(gates[1, 0]), fl(jax.nn.log_sigmoid(gates[1, 1])), states[1])
    h = h_f + fl(h_b)
    h = h * lax.rsqrt(jnp.mean(jnp.square(h), axis=-1, keepdims=True) + NORM_EPS)
    h = h.transpose(0, 2, 1, 3).reshape(b_, l_, D_A) * norm_g
    return h * jax.nn.sigmoid(o), (st_f, st_b)


def _hyena_filters(l_, w1, b1, w2, b2, w3, freq):
    pos = jnp.arange(l_, dtype=jnp.float32)
    t = pos / max(l_ - 1, 1)
    ang = (2.0 * math.pi / l_) * pos
    bands = jnp.linspace(1e-4, N_BANDS - 1, N_BANDS, dtype=jnp.float32)
    z = jnp.concatenate([t[:, None], jnp.cos(ang[:, None] * bands), -jnp.sin(ang[:, None] * bands)], axis=-1)
    hdn = jnp.sin(freq * (z @ w1 + b1))
    hdn = jnp.sin(freq * (hdn @ w2 + b2))
    filt = (hdn @ w3).reshape(l_, 2 * HYENA_ORDER, D_B)
    deltas = jnp.abs(jnp.linspace(math.log(DECAY_TARGET) / SLOW_DECAY, math.log(DECAY_TARGET) / FAST_DECAY, D_B,
                                  dtype=jnp.float32))
    return filt * jnp.exp(-t[:, None] * deltas)[:, None, :]


def _bidir_long_conv(u, k_fwd, k_bwd, skip):
    l_ = u.shape[1]
    kern = jnp.concatenate([k_fwd, jnp.zeros_like(k_fwd[:1]), jnp.flip(k_bwd[1:], axis=0)], axis=0)
    kern = kern * lax.rsqrt(jnp.sum(jnp.square(kern), axis=0, keepdims=True))
    uf = jnp.fft.rfft(u.astype(jnp.float32), n=2 * l_, axis=1)
    kf = jnp.fft.rfft(kern.astype(jnp.float32), n=2 * l_, axis=0)
    return jnp.fft.irfft(uf * kf, n=2 * l_, axis=1)[:, :l_] + u * skip


def _hyena(zb, p):
    conv_w, conv_b, w1, b1, w2, b2, w3, freq, skip = p
    prev, nxt = _shift3(zb)
    u = prev * conv_w[0] + zb * conv_w[1] + nxt * conv_w[2] + conv_b
    v, x1, x2 = jnp.split(u, 3, axis=-1)
    filt = _hyena_filters(zb.shape[1], w1, b1, w2, b2, w3, freq)
    y = x1 * _bidir_long_conv(v, filt[:, 0], filt[:, 1], skip[0])
    return x2 * _bidir_long_conv(y, filt[:, 2], filt[:, 3], skip[1])


def _heads_c(t):
    return t.reshape(t.shape[:-1] + (H_C, HS_C))


def _rwkv_scan(seq, state):
    xs = tuple(jnp.moveaxis(t.astype(jnp.float32), 1, 0) for t in seq)

    def step(S, inp):
        r_t, k_t, v_t, w_t, kk_t, a_t = inp
        S = (S * w_t[:, :, None, :]
             - jnp.einsum('bhvk,bhk->bhv', S, kk_t)[..., None] * (kk_t * a_t)[:, :, None, :]
             + v_t[..., None] * k_t[:, :, None, :])
        return S, jnp.einsum('bhvk,bhk->bhv', S, r_t)

    S, ys = lax.scan(step, state, xs)
    return jnp.moveaxis(ys, 0, 1), S


def _rwkv_zero_state(batch):
    s = jnp.zeros((batch, H_C, HS_C, HS_C), jnp.float32)
    return (s, s)


def _rwkv(zr, p, states):
    mu, w0, w2, a0, a2, g2, k_k, k_a, r_k, ln_w, ln_b = p
    b_, l_, _ = zr.shape
    prev, nxt = _shift3(zr)
    zr = zr + mu * (0.5 * (prev + nxt) - zr)
    r, k, v, wl, al, gl = jnp.split(zr, RWKV_SPLITS, axis=-1)
    wl = jnp.tanh(wl.reshape(b_, l_, 2, DECAY_LORA))
    al = al.reshape(b_, l_, 2, AAA_LORA)
    decay = jnp.exp(-math.exp(-0.5) * jax.nn.sigmoid((w0 + jnp.einsum('bldr,drc->bldc', wl, w2)).astype(jnp.float32)))
    a = jax.nn.sigmoid(a0 + jnp.einsum('bldr,drc->bldc', al, a2))
    g = jax.nn.sigmoid(gl) @ g2
    kk = _heads_c(k * k_k)
    kk = kk / jnp.maximum(jnp.sqrt(jnp.sum(jnp.square(kk), axis=-1, keepdims=True)), 1e-12)
    k_dir = k[:, :, None, :] * (1.0 + (a - 1.0) * k_a)
    rh, vh = _heads_c(r), _heads_c(v)
    seq_f = (rh, _heads_c(k_dir[:, :, 0]), vh, _heads_c(decay[:, :, 0]), kk, _heads_c(a[:, :, 0]))
    seq_b = tuple(jnp.flip(t, axis=1) for t in
                  (rh, _heads_c(k_dir[:, :, 1]), vh, _heads_c(decay[:, :, 1]), kk, _heads_c(a[:, :, 1])))
    y_f, st_f = _rwkv_scan(seq_f, states[0])
    y_b, st_b = _rwkv_scan(seq_b, states[1])
    y = y_f + jnp.flip(y_b, axis=1)
    mean = jnp.mean(y, axis=-1, keepdims=True)
    var = jnp.mean(jnp.square(y - mean), axis=-1, keepdims=True)
    gn = ((y - mean) * lax.rsqrt(var + GN_EPS)).reshape(b_, l_, D_C) * ln_w + ln_b
    bonus = jnp.sum(rh * _heads_c(k_dir[:, :, 0] + k_dir[:, :, 1]) * r_k.reshape(H_C, HS_C), axis=-1, keepdims=True) * vh
    return (gn + bonus.reshape(b_, l_, D_C)) * g, (st_f, st_b)


def _merge(zg, ys, w_branch, w_out):
    merged = 0.0
    for i in range(N_BRANCH):
        merged = merged + jax.nn.sigmoid(zg[..., i * D_MODEL:(i + 1) * D_MODEL]) * (ys[i] @ w_branch[i])
    return merged @ w_out


def _moe(h, p):
    w_r, b_r, w_gu, b_gu, w_dn, b_dn = p
    b_, l_, d_ = h.shape
    n_tok = b_ * l_
    tok = h.reshape(n_tok, d_)
    logits = (tok @ w_r + b_r).astype(jnp.float32)
    top_val, top_idx = lax.top_k(logits, TOP_K)
    top_w = jax.nn.softmax(top_val, axis=-1)
    flat_e = top_idx.reshape(-1)
    order = jnp.argsort(flat_e)
    e_sorted = flat_e[order]
    counts = jnp.bincount(flat_e, length=N_EXPERTS)
    padded = (counts + MOE_BLOCK - 1) // MOE_BLOCK * MOE_BLOCK
    ends = jnp.cumsum(padded)
    slot = (ends - padded)[e_sorted] + jnp.arange(n_tok * TOP_K) - (jnp.cumsum(counts) - counts)[e_sorted]
    n_blocks = n_tok * TOP_K // MOE_BLOCK + N_EXPERTS
    slot_tok = jnp.zeros((n_blocks * MOE_BLOCK,), jnp.int32).at[slot].set((order // TOP_K).astype(jnp.int32))
    slot_w = jnp.zeros((n_blocks * MOE_BLOCK,), jnp.float32).at[slot].set(top_w.reshape(-1)[order])
    block_e = jnp.minimum(jnp.searchsorted(ends, jnp.arange(n_blocks) * MOE_BLOCK, side='right'), N_EXPERTS - 1)

    def block(acc, inp):
        e, rows_idx, w = inp
        gu = tok[rows_idx] @ w_gu[e] + b_gu[e]
        glu = jnp.minimum(gu[:, 0::2], SWIGLU_LIMIT)
        lin = jnp.clip(gu[:, 1::2], -SWIGLU_LIMIT, SWIGLU_LIMIT)
        y = (glu * jax.nn.sigmoid(SWIGLU_ALPHA * glu) * (lin + 1.0)) @ w_dn[e] + b_dn[e]
        return acc.at[rows_idx].add(y.astype(jnp.float32) * w[:, None]), None

    out, _ = lax.scan(block, jnp.zeros((n_tok, d_), jnp.float32),
                      (block_e, slot_tok.reshape(n_blocks, MOE_BLOCK), slot_w.reshape(n_blocks, MOE_BLOCK)))
    return out.reshape(b_, l_, d_).astype(h.dtype)


def setup_inputs(seed: int = 0) -> dict:
    key = jax.random.key(seed)
    keys = iter(jax.random.split(key, 48))

    def nrm(shape, scale):
        return scale * jax.random.normal(next(keys), shape, dtype=jnp.float32)

    def gain(shape):
        return 1.0 + nrm(shape, 0.02)

    nl = DEPTH
    fan_d = D_MODEL ** -0.5
    mlstm_gate_bias = jnp.concatenate(
        [nrm((nl, 2, 1, H_A), 0.1),
         jnp.linspace(3.0, 6.0, H_A, dtype=jnp.float32) + nrm((nl, 2, 1, H_A), 0.1)], axis=2)
    return {
        'x': nrm((BATCH, SEQ, D_MODEL), 1.0),
        'c': nrm((BATCH, D_MODEL), 1.0),
        'ctx': nrm((BATCH, CTX_LEN, D_MODEL), 1.0),
        'c_ctx': nrm((D_MODEL,), 1.0),
        'ada_w': nrm((nl, D_MODEL, 6 * D_MODEL), fan_d),
        'ada_b': nrm((nl, 6 * D_MODEL), 0.02),
        'norm_mix': gain((nl, D_MODEL)),
        'norm_moe': gain((nl, D_MODEL)),
        'w_in': nrm((nl, D_MODEL, N_IN), fan_d),
        'mlstm_gate_bias': mlstm_gate_bias,
        'mlstm_norm': gain((nl, D_A)),
        'hyena_conv_w': nrm((nl, SHORT_W, N_B), 0.5),
        'hyena_conv_b': nrm((nl, N_B), 0.02),
        'hyena_ffn_w1': nrm((nl, EMB_DIM, FILTER_ORDER), EMB_DIM ** -0.5),
        'hyena_ffn_b1': nrm((nl, FILTER_ORDER), 0.1),
        'hyena_ffn_w2': nrm((nl, FILTER_ORDER, FILTER_ORDER), FILTER_ORDER ** -0.5),
        'hyena_ffn_b2': nrm((nl, FILTER_ORDER), 0.1),
        'hyena_ffn_w3': nrm((nl, FILTER_ORDER, 2 * HYENA_ORDER * D_B), FILTER_ORDER ** -0.5),
        'hyena_freq': 1.0 + nrm((nl, FILTER_ORDER), 0.1),
        'hyena_skip': nrm((nl, HYENA_ORDER, D_B), 0.1),
        'rwkv_mu': jax.random.uniform(next(keys), (nl, N_C), dtype=jnp.float32),
        'rwkv_w0': -2.0 + nrm((nl, 2, D_C), 0.5),
        'rwkv_w2': nrm((nl, 2, DECAY_LORA, D_C), DECAY_LORA ** -0.5),
        'rwkv_a0': nrm((nl, 2, D_C), 0.1),
        'rwkv_a2': nrm((nl, 2, AAA_LORA, D_C), AAA_LORA ** -0.5),
        'rwkv_g2': nrm((nl, GATE_LORA, D_C), GATE_LORA ** -0.5),
        'rwkv_k_k': 0.85 + nrm((nl, D_C), 0.02),
        'rwkv_k_a': gain((nl, D_C)),
        'rwkv_r_k': nrm((nl, D_C), 0.1),
        'rwkv_ln_w': gain((nl, D_C)),
        'rwkv_ln_b': nrm((nl, D_C), 0.02),
        'w_branch': nrm((nl, N_BRANCH, D_BRANCH, D_MODEL), D_BRANCH ** -0.5),
        'w_out': nrm((nl, D_MODEL, D_MODEL), fan_d),
        'router_w': nrm((nl, D_MODEL, N_EXPERTS), fan_d),
        'router_b': nrm((nl, N_EXPERTS), 0.01),
        'expert_w_gu': nrm((nl, N_EXPERTS, D_MODEL, 2 * D_EXPERT), fan_d),
        'expert_b_gu': nrm((nl, N_EXPERTS, 2 * D_EXPERT), 0.01),
        'expert_w_down': nrm((nl, N_EXPERTS, D_EXPERT, D_MODEL), D_EXPERT ** -0.5),
        'expert_b_down': nrm((nl, N_EXPERTS, D_MODEL), 0.01),
        'norm_final': gain((D_MODEL,)),
    }


def reference(x, c, ctx, c_ctx, ada_w, ada_b, norm_mix, norm_moe, w_in, mlstm_gate_bias, mlstm_norm,
              hyena_conv_w, hyena_conv_b, hyena_ffn_w1, hyena_ffn_b1, hyena_ffn_w2, hyena_ffn_b2, hyena_ffn_w3,
              hyena_freq, hyena_skip, rwkv_mu, rwkv_w0, rwkv_w2, rwkv_a0, rwkv_a2, rwkv_g2, rwkv_k_k, rwkv_k_a,
              rwkv_r_k, rwkv_ln_w, rwkv_ln_b, w_branch, w_out, router_w, router_b, expert_w_gu, expert_b_gu,
              expert_w_down, expert_b_down, norm_final):
    batch = x.shape[0]
    rows = x.shape[1] // GRID_W
    for l in range(DEPTH):
        sh1x, sc1x, g1x, sh2x, sc2x, g2x = jnp.split((jax.nn.silu(c) @ ada_w[l] + ada_b[l])[:, None, :], 6, axis=-1)
        sh1c, sc1c, g1c, sh2c, sc2c, g2c = jnp.split(jax.nn.silu(c_ctx) @ ada_w[l] + ada_b[l], 6, axis=-1)
        zx = _modulate(x, norm_mix[l], sh1x, sc1x) @ w_in[l]
        zc = _modulate(ctx, norm_mix[l], sh1c, sc1c) @ w_in[l]
        xa, xb, xr, xg = jnp.split(zx, IN_SPLITS, axis=-1)
        ca, cb, cr, cg = jnp.split(zc, IN_SPLITS, axis=-1)
        ya_c, st_a = _mlstm(ca, mlstm_gate_bias[l], mlstm_norm[l], _mlstm_zero_state(batch))
        ya_x, _ = _mlstm(xa, mlstm_gate_bias[l], mlstm_norm[l], st_a)
        rw = (rwkv_mu[l], rwkv_w0[l], rwkv_w2[l], rwkv_a0[l], rwkv_a2[l], rwkv_g2[l], rwkv_k_k[l], rwkv_k_a[l],
              rwkv_r_k[l], rwkv_ln_w[l], rwkv_ln_b[l])
        yr_c, st_r = _rwkv(cr, rw, _rwkv_zero_state(batch))
        yr_x, _ = _rwkv(_to_colmajor(xr, rows), rw, st_r)
        yr_x = _from_colmajor(yr_x, rows)
        hy = (hyena_conv_w[l], hyena_conv_b[l], hyena_ffn_w1[l], hyena_ffn_b1[l], hyena_ffn_w2[l], hyena_ffn_b2[l],
              hyena_ffn_w3[l], hyena_freq[l], hyena_skip[l])
        yb_x = _hyena(xb, hy)
        moe_p = (router_w[l], router_b[l], expert_w_gu[l], expert_b_gu[l], expert_w_down[l], expert_b_down[l])
        x = x + g1x * _merge(xg, (ya_x, yb_x, yr_x), w_branch[l], w_out[l])
        x = x + g2x * _moe(_modulate(x, norm_moe[l], sh2x, sc2x), moe_p)
        if l < DEPTH - 1:
            yb_c = _hyena(cb, hy)
            ctx = ctx + g1c * _merge(cg, (ya_c, yb_c, yr_c), w_branch[l], w_out[l])
            ctx = ctx + g2c * _moe(_modulate(ctx, norm_moe[l], sh2c, sc2c), moe_p)
    return _rmsnorm(x, norm_final)
```

```cpp
#include <hip/hip_runtime.h>
#include <cstdio>
#include <cstdint>

#define GAS __attribute__((address_space(1)))
#define LAS __attribute__((address_space(3)))
typedef unsigned short bf16;
typedef short bf16x8 __attribute__((ext_vector_type(8)));
typedef float f32x4 __attribute__((ext_vector_type(4)));
typedef float f32x2 __attribute__((ext_vector_type(2)));
typedef unsigned u32x4 __attribute__((ext_vector_type(4)));
typedef unsigned u32x2 __attribute__((ext_vector_type(2)));
typedef _Float16 f16x8 __attribute__((ext_vector_type(8)));
#define DI __device__ __forceinline__

#ifndef EN_MLSTM
#define EN_MLSTM 1
#endif
#ifndef EN_RWKV
#define EN_RWKV 1
#endif
#ifndef EN_MOE
#define EN_MOE 1
#endif
#ifndef MK_MULTI
#define MK_MULTI 0
#endif

constexpr int D = 4096, SEQ = 16384, CTX = 256, ROWS = SEQ + CTX, NL = 2, NPAN = ROWS / 256;
constexpr int DBR = 1024;
constexpr int NA = 3104, NB = 3072, NC = 3488, NG = 12288, NIN = NA + NB + NC + NG;
constexpr int NA_P = 3328, NC_P = 3584;
constexpr int NAC = NA + NC, NAC_P = 6656;
constexpr int ROW_B = NAC_P, ROW_G = ROW_B + NB, NIN_P = ROW_G + NG;
constexpr int TAC = NAC_P / 256, TB = NB / 256, TG = NG / 256, NT_IN = TAC + TB + TG;
constexpr int NEXP = 32, DEXP = 512;
constexpr float NORM_EPS = 1e-6f;
constexpr int NTHR = 512, NWAVES = 8;

constexpr size_t MiB = 1u << 20;
constexpr size_t WS_CTL = 0, CTL_ZERO_BYTES = 1 * MiB;
constexpr size_t WS_MOD = 1 * MiB;
constexpr size_t WS_MODP = 2 * MiB;
constexpr size_t WS_HDN = 15 * MiB;
constexpr size_t WS_WIN = 24 * MiB;
constexpr size_t WIN_L = (size_t)NIN_P * D * 2;
constexpr size_t WS_WBR = WS_WIN + 2 * 174 * MiB;
constexpr size_t WBR_L = (size_t)3 * D * DBR * 2;
constexpr size_t WS_WOUT = WS_WBR + 48 * MiB;
constexpr size_t WOUT_L = (size_t)D * D * 2;
constexpr size_t WS_WGU = WS_WOUT + 64 * MiB;
constexpr size_t WGU_L = (size_t)NEXP * 1024 * D;
constexpr size_t WS_H8 = WS_WGU + 256 * MiB;
constexpr size_t WS_WIN8 = WS_H8 + 66 * MiB;
constexpr size_t WS_YS8 = WS_WIN8 + 116 * MiB;
constexpr size_t WS_WBR8 = WS_YS8 + 34 * MiB;
constexpr size_t WS_LORAT = WS_WBR8 + 16 * MiB;
constexpr int LORAT_L = 2 * 1024 * 64 * 2 + 1024 * 160, LORAT_A = 2 * 1024 * 64, LORAT_G = 4 * 1024 * 64;
constexpr int NF8 = 6656 + 4096 + 4096, TF8 = NF8 / 256;
constexpr size_t WIN8_L = (size_t)NF8 * D;
static_assert(WS_WIN8 + 2 * WIN8_L <= WS_YS8 && WS_LORAT + 2 * MiB <= WS_WGU + 512 * MiB, "fp8 buffers");
constexpr int N16 = 3072 + 4096, T16 = N16 / 256;
constexpr size_t WS_WDN = WS_WGU + 512 * MiB;
constexpr size_t WDN_L = (size_t)NEXP * D * DEXP;
constexpr size_t WS_XRES = WS_WDN + 256 * MiB;
constexpr size_t WS_H = WS_XRES + 260 * MiB;
constexpr size_t WS_ZA = WS_H + 130 * MiB;
constexpr size_t WS_GATES = WS_ZA + 106 * MiB;
constexpr size_t WS_ZBT = WS_GATES + 3 * MiB;
constexpr size_t WS_ZC = WS_ZBT + 195 * MiB;
constexpr size_t WS_SG = WS_ZC + 228 * MiB;
constexpr size_t WS_YS = WS_SG + 390 * MiB;
constexpr size_t WS_MERGED = WS_YS + 98 * MiB;
constexpr size_t WS_YBT = WS_MERGED + 130 * MiB;
constexpr size_t WS_HSCR = WS_YBT + 65 * MiB;
constexpr size_t HSCR_WG = 336 * 1024;
constexpr size_t WS_STREAM = WS_HSCR + 84 * MiB;
constexpr size_t WS_RV = WS_STREAM + 650 * MiB;
constexpr size_t WS_RSCAL = WS_RV + 65 * MiB;
constexpr size_t WS_RG = WS_RSCAL + 9 * MiB;
constexpr size_t WS_RBON = WS_RG + 65 * MiB;
constexpr size_t WS_RY = WS_RBON + 65 * MiB;
constexpr size_t WS_HDIR = WS_RY + 130 * MiB;
constexpr size_t WS_MOE = WS_HDIR + 130 * MiB;
constexpr size_t WS_WRT = WS_MOE + 2 * MiB;
constexpr size_t WS_END0 = WS_WRT + 1 * MiB;
constexpr int NSLOT = ROWS * 4 + NEXP * 256;
constexpr size_t MOE_EIDX = 0, MOE_EW = (size_t)ROWS * 16, MOE_TOKSLOT = (size_t)ROWS * 32, MOE_SLOTTOK = (size_t)ROWS * 48, MOE_TILEE = MOE_SLOTTOK + (size_t)NSLOT * 4;
constexpr size_t MOE_CNTW = MOE_TILEE + 2048;
static_assert(MOE_CNTW + 256 * 32 * 4 <= 2 * MiB, "moe tables");
constexpr size_t WS_MRG32 = WS_ZBT;
constexpr size_t WS_YSLOT = WS_ZBT;
constexpr size_t WS_ACT = WS_YSLOT + 584 * MiB;
static_assert(WS_ACT + 73 * MiB <= WS_YS, "moe overlay");
constexpr int CW_HQ = 20480;
constexpr int CW_CNT = 16384, CW_CUR = 16384 + 64;
static_assert(WS_END0 <= (size_t)4096 * MiB, "workspace map exceeds 4 GiB");

constexpr int RING_BYTES = 131072;
constexpr int LDSCTL_OFF = 139264, MISC_OFF = LDSCTL_OFF + 320;
constexpr int LDS_SMALL = LDSCTL_OFF + 1024;
constexpr int LDS_BYTES = 147456;
static_assert(8 * 16640 <= LDSCTL_OFF && LDS_SMALL + 4096 <= LDS_BYTES, "LDS map");

typedef __bf16 bf16v2 __attribute__((ext_vector_type(2)));
DI unsigned cvt_pk_bf16(float lo, float hi) { const bf16v2 v = __builtin_convertvector((f32x2){lo, hi}, bf16v2); return __builtin_bit_cast(unsigned, v); }
DI u32x4 pack8(f32x4 a, f32x4 b) { u32x4 w; w.x = cvt_pk_bf16(a[0], a[1]); w.y = cvt_pk_bf16(a[2], a[3]); w.z = cvt_pk_bf16(b[0], b[1]); w.w = cvt_pk_bf16(b[2], b[3]); return w; }
DI unsigned pk4_fp8(float a, float b, float c, float d) {
    a = fminf(fmaxf(a, -448.f), 448.f); b = fminf(fmaxf(b, -448.f), 448.f); c = fminf(fmaxf(c, -448.f), 448.f); d = fminf(fmaxf(d, -448.f), 448.f);
    int w = __builtin_amdgcn_cvt_pk_fp8_f32(a, b, 0, false); w = __builtin_amdgcn_cvt_pk_fp8_f32(c, d, w, true); return (unsigned)w; }
DI void unpack8(u32x4 w, f32x4& a, f32x4& b) { a[0] = __uint_as_float(w.x << 16); a[1] = __uint_as_float(w.x & 0xffff0000u); a[2] = __uint_as_float(w.y << 16); a[3] = __uint_as_float(w.y & 0xffff0000u);
    b[0] = __uint_as_float(w.z << 16); b[1] = __uint_as_float(w.z & 0xffff0000u); b[2] = __uint_as_float(w.w << 16); b[3] = __uint_as_float(w.w & 0xffff0000u); }
DI f32x4 unpack4(u32x2 w) { return (f32x4){__uint_as_float(w.x << 16), __uint_as_float(w.x & 0xffff0000u), __uint_as_float(w.y << 16), __uint_as_float(w.y & 0xffff0000u)}; }
DI float bf2f(unsigned short b) { return __uint_as_float(((unsigned)b) << 16); }
DI float sigmoidf_(float x) { return __builtin_amdgcn_rcpf(1.f + __expf(-x)); }
DI int otid() { int t = threadIdx.x; asm volatile("" : "+v"(t)); return t; }
template <int CTRL> DI float dpp_add(float x) { return x + __builtin_bit_cast(float, __builtin_amdgcn_update_dpp(0, __builtin_bit_cast(int, x), CTRL, 0xf, 0xf, true)); }
DI float rowsum16(float x) { x = dpp_add<0xB1>(x); x = dpp_add<0x4E>(x); x = dpp_add<0x141>(x); x = dpp_add<0x140>(x); return x; }
DI float wave_sum(float v) {
    v = rowsum16(v);
    v += __builtin_bit_cast(float, __builtin_amdgcn_update_dpp(0, __builtin_bit_cast(int, v), 0x142, 0xA, 0xF, false));
    v += __builtin_bit_cast(float, __builtin_amdgcn_update_dpp(0, __builtin_bit_cast(int, v), 0x143, 0xC, 0xF, false));
    return __builtin_bit_cast(float, __builtin_amdgcn_readlane(__builtin_bit_cast(int, v), 63));
}

#define XB_TMO      128
#define XB_XCNT(j)  (256  + 64 * (j))
#define XB_XSUB(j)  (1280 + 64 * (j))
#define XB_XGEN(j)  (2304 + 64 * (j))
#define XB_TOP      3328
#define XB_TOPGEN   3392
#define XCD_BAR_WORDS 3456
#define XB_SPIN_CAP (1u << 22)
DI unsigned xb_ld(unsigned* p)              { return __hip_atomic_load(p, __ATOMIC_RELAXED, __HIP_MEMORY_SCOPE_AGENT); }
DI unsigned xb_add(unsigned* p, unsigned v) { return __hip_atomic_fetch_add(p, v, __ATOMIC_RELAXED, __HIP_MEMORY_SCOPE_AGENT); }
DI unsigned xb_xcc_id() { return (unsigned)__builtin_amdgcn_s_getreg((3 << 11) | 20) & 0xFu; }
#define XB_SPIN(cond, bar) do { unsigned _sp = 0; while (cond) { __builtin_amdgcn_s_sleep(1); \
    if ((++_sp & 255u) == 0u) { if (xb_ld(&(bar)[XB_TMO])) break; if (_sp > XB_SPIN_CAP) { atomicAdd(&(bar)[XB_TMO], 1u); break; } } } } while (0)
struct XcdBarrier { unsigned* bar; unsigned x; volatile LAS unsigned* st; };
DI XcdBarrier xcd_barrier_post(unsigned* bar, volatile LAS unsigned* st) {
    XcdBarrier b; b.bar = bar; b.x = xb_xcc_id(); b.st = st;
    if (threadIdx.x == 0) (void)xb_add(&bar[XB_XCNT(b.x)], 1u);
    return b;
}
DI void xcd_barrier_complete(unsigned* bar, unsigned x, unsigned& nloc, unsigned& nx) {
    const unsigned G = gridDim.x * gridDim.y * gridDim.z;
    unsigned sum, cnt, mine, sp = 0u;
    for (;;) {
        sum = 0u; cnt = 0u; mine = 0u;
#pragma unroll
        for (unsigned j = 0; j < 16; ++j) { const unsigned c = xb_ld(&bar[XB_XCNT(j)]); sum += c; cnt += (c > 0u) ? 1u : 0u; mine = (j == x) ? c : mine; }
        if (sum == G) break;
        __builtin_amdgcn_s_sleep(1);
        if ((++sp & 255u) == 0u) { if (xb_ld(&bar[XB_TMO])) break; if (sp > XB_SPIN_CAP) { atomicAdd(&bar[XB_TMO], 1u); break; } }
    }
    nloc = mine > 0u ? mine : 1u; nx = cnt > 0u ? cnt : 1u;
}
DI void xcd_barrier(const XcdBarrier& b) {
    asm volatile("s_waitcnt vmcnt(0)" ::: "memory");
    __syncthreads();
    if (threadIdx.x == 0) {
        unsigned* bar = b.bar;
        __builtin_amdgcn_s_waitcnt(0);
        unsigned nloc = b.st[0], nx = b.st[1];
        if (nloc == 0u) { xcd_barrier_complete(bar, b.x, nloc, nx); b.st[0] = nloc; b.st[1] = nx; }
        const unsigned old = xb_add(&bar[XB_XSUB(b.x)], 1u);
        const unsigned gen = old / nloc;
        if (old + 1u == (gen + 1u) * nloc) {
            __builtin_amdgcn_fence(__ATOMIC_RELEASE, "agent");
            asm volatile("s_waitcnt vmcnt(0)" ::: "memory");
            const unsigned og = xb_add(&bar[XB_TOP], 1u);
            const unsigned tg = og / nx;
            if (og + 1u == (tg + 1u) * nx) xb_add(&bar[XB_TOPGEN], 1u);
            else XB_SPIN(xb_ld(&bar[XB_TOPGEN]) == tg, bar);
            __builtin_amdgcn_fence(__ATOMIC_ACQUIRE, "agent");
            xb_add(&bar[XB_XGEN(b.x)], 1u);
            asm volatile("s_waitcnt vmcnt(0)" ::: "memory");
        } else {
            XB_SPIN(xb_ld(&bar[XB_XGEN(b.x)]) == gen, bar);
            __builtin_amdgcn_fence(__ATOMIC_ACQUIRE, "agent");
            asm volatile("s_waitcnt vmcnt(0)" ::: "memory");
        }
    }
    __syncthreads();
}

namespace pg8 {
constexpr int BM = 256, BK = 64, HALF = 128, HTB = HALF * BK * 2, NXCD = 8, WGM = 4;
DI int lds_byte(int r, int c) { const int st = (r >> 4) * 2 + (c >> 5), rr = r & 15, cc = c & 31, ob = rr * 64 + cc * 2; return st * 1024 + (ob ^ (((ob >> 9) & 1) << 5)); }
DI void stage_rc(int b, int& R, int& C) { const int st = b / 1024, sb = b % 1024, swz = sb ^ (((sb >> 9) & 1) << 5); R = (st >> 1) * 16 + swz / 64; C = (st & 1) * 32 + (swz % 64) / 2; }
DI int perm32(int rho) { const int n = rho >> 4, i = rho & 15; return 8 * (i >> 2) + 4 * n + (i & 3); }
struct Unit { int pm, pn, aux; };
typedef int v8i __attribute__((ext_vector_type(8)));
DI v8i cat8(bf16x8 lo, bf16x8 hi) { typedef int v4i __attribute__((ext_vector_type(4))); const v4i a = __builtin_bit_cast(v4i, lo), b = __builtin_bit_cast(v4i, hi); return (v8i){a[0], a[1], a[2], a[3], b[0], b[1], b[2], b[3]}; }
DI void tile_of(int L, int nM, int nN, int& pm, int& pn) {
    const int nwg = nM * nN; int wgid = L;
    { const int q = nwg / NXCD, r = nwg % NXCD, xcd = wgid % NXCD, off = wgid / NXCD; wgid = (xcd < r ? xcd * (q + 1) : r * (q + 1) + (xcd - r) * q) + off; }
    const int nig = WGM * nN, gid = wgid / nig, fm = gid * WGM, gsz = (nM - fm) < WGM ? (nM - fm) : WGM;
    pm = fm + ((wgid % nig) % gsz); pn = (wgid % nig) / gsz;
}
#define EPI_LOOP(...) \
    _Pragma("unroll") for (int ai = 0; ai < 2; ++ai) _Pragma("unroll") for (int m = 0; m < 4; ++m) { const int rl = ai * 128 + wr * 64 + m * 16 + fr; \
    _Pragma("unroll") for (int bj = 0; bj < 2; ++bj) { const int cl = bj * 128 + wc * 32 + 8 * fq; const f32x4 v0 = acc[ai][bj][m][0], v1 = acc[ai][bj][m][1]; __VA_ARGS__ } }

#define EPI_GROUPS(ai, ...) \
    _Pragma("unroll") for (int mm = 0; mm < 2; ++mm) { const int m = 2 * mh + mm; const int rl = (ai) * 128 + wr * 64 + m * 16 + fr; \
    _Pragma("unroll") for (int bj = 0; bj < 2; ++bj) { const int cl = bj * 128 + wc * 32 + 8 * fq; __VA_ARGS__ } }

template <class P>
DI void gemm_phase(LAS unsigned char* lds, const P& S) {
    int tid_ = threadIdx.x; asm volatile("" : "+v"(tid_));
    const int tid = tid_, wid = __builtin_amdgcn_readfirstlane(tid >> 6), lane = tid & 63, wr = wid >> 2, wc = wid & 3, fr = lane & 15, fq = lane >> 4;
    constexpr int EB = P::FP8 ? 1 : 2;
    const int K = S.K, KB = K * EB, nt = KB / (BK * 2);
    const size_t kstep = (size_t)(BK * 2);
    const size_t hstep = (size_t)HALF * KB;
    unsigned voB[2][2], voA[2][2], voAn[2][2]; int RA[2], CA[2];
#pragma unroll
    for (int i = 0; i < 2; ++i) { int R, C; stage_rc(tid * 16 + i * 8192, R, C); const int Rb = (R & ~31) + perm32(R & 31); RA[i] = R; CA[i] = C;
#pragma unroll
        for (int h = 0; h < 2; ++h) { voA[h][i] = (unsigned)(R * KB + C * 2) + (unsigned)(h * hstep); voAn[h][i] = voA[h][i]; voB[h][i] = (unsigned)(Rb * KB + C * 2) + (unsigned)(h * hstep); } }
    const unsigned ldsw = (unsigned)wid * 1024u;
    const int aoff = lds_byte(wr * 64 + fr, fq * 8), boff = lds_byte(wc * 32 + fr, fq * 8);
#define PG8_SA(b, h) (((b) * 2 + (h)) * HTB)
#define PG8_SB(b, h) ((4 + (b) * 2 + (h)) * HTB)
#define PG8_STAGE(bufoff, gbase, voff) do { _Pragma("unroll") for (int _i = 0; _i < 2; ++_i) \
        __builtin_amdgcn_global_load_lds((const unsigned*)((const char*)(gbase) + (voff)[_i]), (LAS unsigned*)(lds + (bufoff) + ldsw + _i * 8192), 16, 0, 0); } while (0)
#define PG8_LD16(off) (*(const LAS bf16x8*)(lds + (off)))
#define PG8_LDA(dst, b, h) do { _Pragma("unroll") for (int m = 0; m < 4; ++m) { \
        if constexpr (P::FP8) dst##8[m] = cat8(PG8_LD16(PG8_SA(b, h) + aoff + m * 2048), PG8_LD16(PG8_SA(b, h) + aoff + m * 2048 + 1024)); \
        else { _Pragma("unroll") for (int k = 0; k < 2; ++k) dst[m][k] = PG8_LD16(PG8_SA(b, h) + aoff + m * 2048 + k * 1024); } } } while (0)
#define PG8_LDB(dst, b, h) do { _Pragma("unroll") for (int n = 0; n < 2; ++n) { \
        if constexpr (P::FP8) dst##8[n] = cat8(PG8_LD16(PG8_SB(b, h) + boff + n * 2048), PG8_LD16(PG8_SB(b, h) + boff + n * 2048 + 1024)); \
        else { _Pragma("unroll") for (int k = 0; k < 2; ++k) dst[n][k] = PG8_LD16(PG8_SB(b, h) + boff + n * 2048 + k * 1024); } } } while (0)
#define PG8_MMA(ai, bj, At, Bt) do { __builtin_amdgcn_s_setprio(1); _Pragma("unroll") for (int m = 0; m < 4; ++m) _Pragma("unroll") for (int n = 0; n < 2; ++n) { \
        if constexpr (P::FP8) asm volatile("v_mfma_scale_f32_16x16x128_f8f6f4 %0, %1, %2, %0, %3, %3 op_sel_hi:[0,0,0]" : "+v"(acc[ai][bj][m][n]) : "v"(Bt##8[n]), "v"(At##8[m]), "v"(sc127));   \
        else { _Pragma("unroll") for (int k = 0; k < 2; ++k) acc[ai][bj][m][n] = __builtin_amdgcn_mfma_f32_16x16x32_bf16(Bt[n][k], At[m][k], acc[ai][bj][m][n], 0, 0, 0); } } \
        __builtin_amdgcn_s_setprio(0); } while (0)
#define PG8_WAIT_V(n) asm volatile("s_waitcnt vmcnt(" #n ")" ::: "memory")
#define PG8_WAIT_L(n) asm volatile("s_waitcnt lgkmcnt(" #n ")" ::: "memory")
#define PG8_BAR __builtin_amdgcn_s_barrier()
#define PG8_SCHED __builtin_amdgcn_sched_barrier(0)
    Unit cur, nxt; int ui = 0;
    if (!S.next(0, cur)) return;
    f32x4 acc[2][2][4][2];
#pragma unroll
    for (int a = 0; a < 2; ++a)
#pragma unroll
        for (int b = 0; b < 2; ++b)
#pragma unroll
            for (int m = 0; m < 4; ++m)
#pragma unroll
                for (int n = 0; n < 2; ++n) acc[a][b][m][n] = (f32x4){0.f, 0.f, 0.f, 0.f};
    const int sc127 = 127;
    bf16x8 At[4][2], B0[2][2], B1[2][2]; v8i At8[4], B08[2], B18[2];
    const char* cA = S.a_ptr(cur); const char* cB = S.b_ptr(cur);
    if constexpr (P::GATHER) {
#pragma unroll
        for (int h = 0; h < 2; ++h)
#pragma unroll
            for (int i = 0; i < 2; ++i) { int R_, C_; stage_rc(tid * 16 + i * 8192, R_, C_); voA[h][i] = S.a_row_off(cur, h * 128 + R_) + (unsigned)C_ * 2u; }
    }
    PG8_STAGE(PG8_SB(0, 0), cB, voB[0]); PG8_STAGE(PG8_SB(0, 1), cB + hstep, voB[0]); PG8_STAGE(PG8_SA(0, 0), cA, voA[0]); PG8_STAGE(PG8_SA(0, 1), cA, voA[1]);
    if (wr == 1) PG8_BAR;
    PG8_WAIT_V(2); PG8_BAR;
    PG8_STAGE(PG8_SB(1, 0), cB + kstep, voB[0]); PG8_STAGE(PG8_SA(1, 0), cA + kstep, voA[0]); PG8_STAGE(PG8_SB(1, 1), cB + hstep + kstep, voB[0]);
    PG8_WAIT_V(6); PG8_BAR;
    for (;;) {
        const bool has_next = S.next(ui + 1, nxt);
        const char* nA = has_next ? S.a_ptr(nxt) : cA; const char* nB = has_next ? S.b_ptr(nxt) : cB;
        if constexpr (P::GATHER) {
#pragma unroll
            for (int h = 0; h < 2; ++h)
#pragma unroll
                for (int i = 0; i < 2; ++i) { int R_, C_; stage_rc(tid * 16 + i * 8192, R_, C_); voAn[h][i] = has_next ? (S.a_row_off(nxt, h * 128 + R_) + (unsigned)C_ * 2u) : voA[h][i]; }
        }
        for (int t = 0; t < nt; t += 2) {
            const bool last = (t == nt - 2);
            const char* a1 = cA + (size_t)(t + 1) * kstep;
            const char* a2 = last ? nA : cA + (size_t)(t + 2) * kstep; const char* b2 = last ? nB : cB + (size_t)(t + 2) * kstep;
            const char* a3 = a2 + kstep; const char* b3 = b2 + kstep;
            unsigned vo2[2][2];
#pragma unroll
            for (int h = 0; h < 2; ++h)
#pragma unroll
                for (int i = 0; i < 2; ++i) { if constexpr (P::GATHER) vo2[h][i] = last ? voAn[h][i] : voA[h][i]; else vo2[h][i] = voA[h][i]; }
            PG8_LDB(B0, 0, 0); PG8_LDB(B1, 0, 1); PG8_SCHED; PG8_LDA(At, 0, 0); PG8_STAGE(PG8_SA(1, 1), a1, voA[1]);
            PG8_WAIT_V(8); PG8_WAIT_L(0); PG8_BAR; PG8_MMA(0, 0, At, B0); PG8_MMA(0, 1, At, B1); PG8_BAR; PG8_SCHED;
            PG8_LDA(At, 0, 1); PG8_STAGE(PG8_SB(0, 0), b2, voB[0]); PG8_STAGE(PG8_SB(0, 1), b2 + hstep, voB[0]); PG8_STAGE(PG8_SA(0, 0), a2, vo2[0]);
            PG8_WAIT_V(8); PG8_WAIT_L(0); PG8_BAR; PG8_MMA(1, 0, At, B0); PG8_MMA(1, 1, At, B1); PG8_BAR; PG8_SCHED;
            PG8_LDB(B0, 1, 0); PG8_LDB(B1, 1, 1); PG8_SCHED; PG8_LDA(At, 1, 0); PG8_STAGE(PG8_SA(0, 1), a2, vo2[1]);
            PG8_WAIT_V(8); PG8_WAIT_L(0); PG8_BAR; PG8_MMA(0, 0, At, B0); PG8_MMA(0, 1, At, B1); PG8_BAR; PG8_SCHED;
            PG8_LDA(At, 1, 1); PG8_STAGE(PG8_SB(1, 0), b3, voB[0]); PG8_STAGE(PG8_SB(1, 1), b3 + hstep, voB[0]); PG8_STAGE(PG8_SA(1, 0), a3, vo2[0]);
            PG8_WAIT_V(8); PG8_WAIT_L(0); PG8_BAR; PG8_MMA(1, 0, At, B0); PG8_MMA(1, 1, At, B1); PG8_BAR; PG8_SCHED;
        }
        if (wr == 0) PG8_BAR;
        if constexpr (P::FP8) { asm volatile("s_nop 15\n\ts_nop 7" ::: "memory");
            const int ln_ = (int)__builtin_amdgcn_mbcnt_hi(~0u, __builtin_amdgcn_mbcnt_lo(~0u, 0u)); S.epi(acc, cur, wr, wc, ln_ & 15, ln_ >> 4); }
        else S.epi(acc, cur, wr, wc, fr, fq);
        if (!has_next) break;
#pragma unroll
        for (int a = 0; a < 2; ++a)
#pragma unroll
            for (int b = 0; b < 2; ++b)
#pragma unroll
                for (int m = 0; m < 4; ++m)
#pragma unroll
                    for (int n = 0; n < 2; ++n) acc[a][b][m][n] = (f32x4){0.f, 0.f, 0.f, 0.f};
        cur = nxt; cA = nA; cB = nB; ++ui;
        if constexpr (P::GATHER) {
#pragma unroll
            for (int h = 0; h < 2; ++h)
#pragma unroll
                for (int i = 0; i < 2; ++i) voA[h][i] = voAn[h][i];
        }
        if (wr == 1) PG8_BAR;
    }
    PG8_WAIT_V(0);
    PG8_BAR;
#undef PG8_SA
#undef PG8_SB
#undef PG8_STAGE
#undef PG8_LDA
#undef PG8_LD16
#undef PG8_LDB
#undef PG8_MMA
#undef PG8_WAIT_V
#undef PG8_WAIT_L
#undef PG8_BAR
#undef PG8_SCHED
}
}
using pg8::Unit;

struct Args { const float* in[40]; float* out; unsigned char* ws; int ph_lo, ph_hi; };
#define CAS __attribute__((address_space(4)))
typedef const CAS Args* AP;
enum { I_X = 0, I_C, I_CTX, I_CCTX, I_ADAW, I_ADAB, I_NMIX, I_NMOE, I_WIN, I_MGB, I_MNORM, I_HCW, I_HCB, I_HW1, I_HB1, I_HW2, I_HB2, I_HW3, I_HFREQ, I_HSKIP,
       I_RMU, I_RW0, I_RW2, I_RA0, I_RA2, I_RG2, I_RKK, I_RKA, I_RRK, I_RLNW, I_RLNB, I_WBR, I_WOUT, I_RTW, I_RTB, I_EGU, I_EBGU, I_EDN, I_EBDN, I_NFIN };

DI void transpose_tile(const float* W, int N, int k0, int n0, bf16* dst, int Kd, LAS float* scr, int lane) {
#pragma unroll
    for (int i = 0; i < 16; ++i) { const int kk = 4 * i + (lane >> 4), nn = 4 * (lane & 15);
        const f32x4 v = *(const f32x4*)(W + (size_t)(k0 + kk) * N + n0 + nn);
        scr[kk * 65 + nn] = v[0]; scr[kk * 65 + nn + 1] = v[1]; scr[kk * 65 + nn + 2] = v[2]; scr[kk * 65 + nn + 3] = v[3]; }
    asm volatile("s_waitcnt lgkmcnt(0)" ::: "memory");
    const int c = lane & 7;
#pragma unroll
    for (int j = 0; j < 8; ++j) { const int n = (lane >> 3) + 8 * j; const LAS float* s = scr + (8 * c) * 65 + n;
        u32x4 o; o.x = cvt_pk_bf16(s[0], s[65]); o.y = cvt_pk_bf16(s[2 * 65], s[3 * 65]); o.z = cvt_pk_bf16(s[4 * 65], s[5 * 65]); o.w = cvt_pk_bf16(s[6 * 65], s[7 * 65]);
        *(u32x4*)(dst + (size_t)(n0 + n) * Kd + k0 + 8 * c) = o; }
    asm volatile("s_waitcnt lgkmcnt(0)" ::: "memory");
}
DI void transpose_tile8(const float* W, int N, int k0, int n0, unsigned char* dst, int Kd, LAS float* scr, int lane, float sc) {
#pragma unroll
    for (int i = 0; i < 16; ++i) { const int kk = 4 * i + (lane >> 4), nn = 4 * (lane & 15);
        const f32x4 v = *(const f32x4*)(W + (size_t)(k0 + kk) * N + n0 + nn);
        scr[kk * 65 + nn] = v[0]; scr[kk * 65 + nn + 1] = v[1]; scr[kk * 65 + nn + 2] = v[2]; scr[kk * 65 + nn + 3] = v[3]; }
    asm volatile("s_waitcnt lgkmcnt(0)" ::: "memory");
    const int c = lane & 7;
#pragma unroll
    for (int j = 0; j < 8; ++j) { const int n = (lane >> 3) + 8 * j; const LAS float* s = scr + (8 * c) * 65 + n;
        u32x2 o; o.x = pk4_fp8(s[0] * sc, s[65] * sc, s[2 * 65] * sc, s[3 * 65] * sc); o.y = pk4_fp8(s[4 * 65] * sc, s[5 * 65] * sc, s[6 * 65] * sc, s[7 * 65] * sc);
        *(u32x2*)(dst + (size_t)(n0 + n) * Kd + k0 + 8 * c) = o; }
    asm volatile("s_waitcnt lgkmcnt(0)" ::: "memory");
}
DI int win_map(int n) {
    if (n < NA) return (n << 1) | 1;
    if (n < NA + NB) return (n - NA) << 1;
    if (n < NA + NB + NC) return ((NA + n - NA - NB) << 1) | 1;
    const int g = n - (NA + NB + NC);
    if (g < D) return ((NAC_P + g) << 1) | 1;
    if (g < 2 * D) return (NB + (g - D)) << 1;
    return ((NAC_P + D + (g - 2 * D)) << 1) | 1; }

constexpr int CV_TIN = 64 * (NIN / 64), CV_TBR = 3 * 16 * 64, CV_TOUT = 64 * 64, CV_TGU = NEXP * 64 * 16, CV_TDN = NEXP * 8 * 64;
constexpr int CV_TL = CV_TIN + CV_TBR + CV_TOUT + CV_TGU + CV_TDN;
struct CvJob { const float* src; unsigned char* dst; int N, Kd, kind; float sc; int l, kb, n0; };
DI CvJob cv_job(AP a, int l, int r) {
    unsigned char* ws = a->ws; CvJob j; j.l = l; j.kb = 0; j.n0 = 0; j.sc = 1.f;
    if (r < CV_TIN) { const int kb = r / (NIN / 64), nb = r % (NIN / 64), n0 = nb * 64;
        const int m0 = win_map(n0), m1 = win_map(n0 + 32);
        j.src = a->in[I_WIN] + (size_t)l * D * NIN + (size_t)kb * 64 * NIN + n0; j.N = NIN; j.Kd = D; j.kb = kb; j.n0 = n0;
        if ((m0 & 1) == (m1 & 1) && (m0 >> 1) - n0 == (m1 >> 1) - (n0 + 32)) {
            if (m0 & 1) { j.kind = 1; j.sc = 512.f; j.dst = ws + WS_WIN8 + l * WIN8_L + (size_t)(m0 >> 1) * D + kb * 64; }
            else { j.kind = 0; j.dst = ws + WS_WIN + l * WIN_L + ((size_t)(m0 >> 1) * D + kb * 64) * 2; } }
        else { j.kind = 2; j.dst = ws; }
        return j; }
    r -= CV_TIN;
    if (r < CV_TBR) { const int i = r / (16 * 64), q = r % (16 * 64), kb = q / 64, nb = q % 64;
        j.src = a->in[I_WBR] + ((size_t)l * 3 + i) * DBR * D + (size_t)kb * 64 * D + nb * 64; j.N = D; j.Kd = DBR;
        if (i == 1) { j.kind = 0; j.dst = ws + WS_WBR + l * WBR_L + ((size_t)i * D * DBR + (size_t)nb * 64 * DBR + kb * 64) * 2; }
        else { j.kind = 1; j.sc = 256.f; j.dst = ws + WS_WBR8 + ((size_t)l * 2 + (i >> 1)) * D * DBR + (size_t)nb * 64 * DBR + kb * 64; }
        return j; }
    r -= CV_TBR;
    if (r < CV_TOUT) { const int kb = r / 64, nb = r % 64;
        j.src = a->in[I_WOUT] + (size_t)l * D * D + (size_t)kb * 64 * D + nb * 64; j.N = D; j.Kd = D; j.kind = 0; j.dst = ws + WS_WOUT + l * WOUT_L + ((size_t)nb * 64 * D + kb * 64) * 2; return j; }
    r -= CV_TOUT;
    if (r < CV_TGU) { const int e = r / (64 * 16), q = r % (64 * 16), kb = q / 16, nb = q % 16;
        j.src = a->in[I_EGU] + ((size_t)l * NEXP + e) * D * 1024 + (size_t)kb * 64 * 1024 + nb * 64; j.N = 1024; j.Kd = D; j.kind = 1; j.sc = 512.f;
        j.dst = ws + WS_WGU + l * WGU_L + (size_t)e * 1024 * D + (size_t)nb * 64 * D + kb * 64; return j; }
    r -= CV_TGU;
    { const int e = r / (8 * 64), q = r % (8 * 64), kb = q / 64, nb = q % 64;
        j.src = a->in[I_EDN] + ((size_t)l * NEXP + e) * DEXP * D + (size_t)kb * 64 * D + nb * 64; j.N = D; j.Kd = DEXP; j.kind = 1; j.sc = 256.f;
        j.dst = ws + WS_WDN + l * WDN_L + (size_t)e * D * DEXP + (size_t)nb * 64 * DEXP + kb * 64; }
    return j;
}
DI void cv_load(const CvJob& j, f32x4 (&v)[16], int lane) {
#pragma unroll
    for (int i = 0; i < 16; ++i) v[i] = (f32x4){0.f, 0.f, 0.f, 0.f};
    if (j.kind != 2) {
#pragma unroll
        for (int i = 0; i < 16; ++i) v[i] = *(const f32x4*)(j.src + (size_t)(4 * i + (lane >> 4)) * j.N + 4 * (lane & 15)); }
}
DI void cv_store(AP a, const CvJob& j, const f32x4 (&v)[16], LAS float* scr, int lane) {
    if (j.kind == 2) {
        const float* W = a->in[I_WIN] + (size_t)j.l * D * NIN; bf16* d16 = (bf16*)(a->ws + WS_WIN + j.l * WIN_L); unsigned char* d8 = a->ws + WS_WIN8 + j.l * WIN8_L;
        for (int e = lane; e < 64 * 64; e += 64) { const int kk = e >> 6, nn = e & 63; const float x = W[(size_t)(j.kb * 64 + kk) * NIN + j.n0 + nn]; const int mm = win_map(j.n0 + nn);
            if (mm & 1) d8[(size_t)(mm >> 1) * D + j.kb * 64 + kk] = (unsigned char)(pk4_fp8(x * 512.f, 0.f, 0.f, 0.f) & 0xffu);
            else d16[(size_t)(mm >> 1) * D + j.kb * 64 + kk] = (bf16)(cvt_pk_bf16(x, 0.f) & 0xffffu); }
        return; }
#pragma unroll
    for (int i = 0; i < 16; ++i) { const int kk = 4 * i + (lane >> 4), nn = 4 * (lane & 15);
        scr[kk * 65 + nn] = v[i][0]; scr[kk * 65 + nn + 1] = v[i][1]; scr[kk * 65 + nn + 2] = v[i][2]; scr[kk * 65 + nn + 3] = v[i][3]; }
    asm volatile("s_waitcnt lgkmcnt(0)" ::: "memory");
    const int c = lane & 7;
    if (j.kind == 0) {
#pragma unroll
        for (int jj = 0; jj < 8; ++jj) { const int n = (lane >> 3) + 8 * jj; const LAS float* s = scr + (8 * c) * 65 + n;
            u32x4 o; o.x = cvt_pk_bf16(s[0], s[65]); o.y = cvt_pk_bf16(s[2 * 65], s[3 * 65]); o.z = cvt_pk_bf16(s[4 * 65], s[5 * 65]); o.w = cvt_pk_bf16(s[6 * 65], s[7 * 65]);
            *(u32x4*)(j.dst + ((size_t)n * j.Kd + 8 * c) * 2) = o; } }
    else { const float sc = j.sc;
#pragma unroll
        for (int jj = 0; jj < 8; ++jj) { const int n = (lane >> 3) + 8 * jj; const LAS float* s = scr + (8 * c) * 65 + n;
            u32x2 o; o.x = pk4_fp8(s[0] * sc, s[65] * sc, s[2 * 65] * sc, s[3 * 65] * sc); o.y = pk4_fp8(s[4 * 65] * sc, s[5 * 65] * sc, s[6 * 65] * sc, s[7 * 65] * sc);
            *(u32x2*)(j.dst + (size_t)n * j.Kd + 8 * c) = o; } }
    asm volatile("s_waitcnt lgkmcnt(0)" ::: "memory");
}
constexpr int cvq_nt(int l) { return (CV_TL - CV_TIN) + (l + 1 < NL ? CV_TIN : 0); }
constexpr int cvq_nch(int l) { return (cvq_nt(l) + 63) / 64; }
constexpr int CVQ_R = 1;
constexpr int cvq_q(int l) { return (cvq_nch(l) + CVQ_R - 1) / CVQ_R; }
DI CvJob cvq_job(AP a, int t, int l) { if (t < CV_TL - CV_TIN) return cv_job(a, l, CV_TIN + t); return cv_job(a, l + 1, t - (CV_TL - CV_TIN)); }
DI void conv_chunk(AP a, int cc, LAS unsigned char* lds, int l) {
    const int CVQ_NT = cvq_nt(l);
    const int tid = otid(), lane = tid & 63, wave = tid >> 6;
    LAS float* scr = (LAS float*)(lds + wave * 16640);
    CvJob jc, jn; f32x4 vc[16], vn[16];
    const int t0 = cc * 64 + wave; bool have = t0 < CVQ_NT;
    jc = cvq_job(a, have ? t0 : 0, l); jn = jc;
    if (have) cv_load(jc, vc, lane);
#pragma unroll 2
    for (int j = 0; j < 8; ++j) { const int tn = t0 + (j + 1) * 8; const bool hn = (j + 1 < 8) && tn < CVQ_NT;
        if (hn) { jn = cvq_job(a, tn, l); cv_load(jn, vn, lane); }
        if (have) cv_store(a, jc, vc, scr, lane);
        jc = jn; have = hn;
#pragma unroll
        for (int i = 0; i < 16; ++i) vc[i] = vn[i]; }
}

DI void phase_prologue(AP a, LAS unsigned char* lds, int bid, int G) {
    const int tid = otid(), lane = tid & 63, wave = tid >> 6;
    unsigned char* ws = a->ws;
    {
        LAS float* scr = (LAS float*)(lds + wave * 16640);
        const int gw = bid * NWAVES + wave, NGW = G * NWAVES;
        CvJob jc, jn; f32x4 vc[16], vn[16];
        bool have = gw < CV_TIN; jc = cv_job(a, 0, have ? gw : 0); jn = jc;
        if (have) cv_load(jc, vc, lane);
#pragma unroll 2
        for (int it = gw; it < CV_TIN; it += NGW) { const bool hn = it + NGW < CV_TIN;
            if (hn) { jn = cv_job(a, 0, it + NGW); cv_load(jn, vn, lane); }
            cv_store(a, jc, vc, scr, lane);
            jc = jn;
#pragma unroll
            for (int i = 0; i < 16; ++i) vc[i] = vn[i]; }
        for (int l = 0; l < NL; ++l) { unsigned char* d8 = ws + WS_WIN8 + l * WIN8_L + (size_t)NAC * D;
            const size_t n1 = (size_t)(NAC_P - NAC) * D / 16;
            for (size_t i = (size_t)bid * NTHR + tid; i < n1; i += (size_t)G * NTHR) ((u32x4*)d8)[i] = (u32x4){0u, 0u, 0u, 0u}; }
    }
    __syncthreads();
    for (int i = bid * NTHR + tid; i < NL * NEXP * D; i += G * NTHR) { const int l = i / (NEXP * D), e = (i / D) % NEXP, k = i % D;
        ((float*)(ws + WS_WRT))[i] = a->in[I_RTW][((size_t)l * D + k) * NEXP + e]; }
    for (int i = bid * NTHR + tid; i < NL * LORAT_L; i += G * NTHR) { const int l = i / LORAT_L, q = i % LORAT_L; float v;
        if (q < LORAT_G) { const int which = q >= LORAT_A, qq = q - which * LORAT_A, d = qq / (1024 * 64), c = (qq / 64) % 1024, j = qq % 64;
            v = (which ? a->in[I_RA2] : a->in[I_RW2])[(((size_t)l * 2 + d) * 64 + j) * DBR + c]; }
        else { const int qq = q - LORAT_G, c = qq / 160, j = qq % 160; v = a->in[I_RG2][((size_t)l * 160 + j) * DBR + c]; }
        ((bf16*)(ws + WS_LORAT))[i] = (bf16)(cvt_pk_bf16(v, 0.f) & 0xffffu); }
    {
        LAS float* sv = (LAS float*)lds;
        for (int it = bid; it < NL * 12 * 32; it += G) {
            const int l = it / (12 * 32), q = it % (12 * 32), cb = q / 32, ks = q % 32;
            __syncthreads();
            if (tid < 256) { const int w = tid >> 7, k = ks * 128 + (tid & 127); const float v = (w ? a->in[I_CCTX] : a->in[I_C])[k]; sv[tid] = v / (1.f + __expf(-v)); }
            __syncthreads();
            const float* W = a->in[I_ADAW] + (size_t)l * D * 6 * D + (size_t)(ks * 128) * 6 * D + cb * 2048 + tid * 4;
            f32x4 ax = {0.f, 0.f, 0.f, 0.f}, ac = {0.f, 0.f, 0.f, 0.f};
#pragma unroll 8
            for (int k = 0; k < 128; ++k) { const f32x4 w = *(const f32x4*)(W + (size_t)k * 6 * D); ax += w * sv[k]; ac += w * sv[128 + k]; }
            float* P = (float*)(ws + WS_MODP) + (((size_t)l * 32 + ks) * 2) * 6 * D + cb * 2048 + tid * 4;
            *(f32x4*)P = ax; *(f32x4*)(P + 6 * D) = ac;
        }
    }
    __syncthreads();
    {
        LAS float* zf = (LAS float*)lds;
        LAS float* h1 = zf + 32 * 36;
        for (int it = bid; it < NL * (ROWS / 32); it += G) {
            const int l = it / (ROWS / 32), pg = it % (ROWS / 32);
            __syncthreads();
            for (int e = tid; e < 32 * 33; e += NTHR) { const int p = e / 33, j = e % 33; const int gp = pg * 32 + p; const int L = gp < SEQ ? SEQ : CTX; const int pos = gp < SEQ ? gp : gp - SEQ;
                const float fpos = (float)pos; float v;
                if (j == 0) v = fpos / (float)(L - 1);
                else { const int bi = (j - 1) & 15; const float band = 1e-4f + (float)bi * ((15.f - 1e-4f) / 15.f); const float ang = (6.283185307179586f / (float)L) * fpos;
                    v = (j <= 16) ? cosf(ang * band) : -sinf(ang * band); }
                zf[p * 36 + j] = v; }
            __syncthreads();
            const int p8 = tid >> 6, m = tid & 63; const float fq = a->in[I_HFREQ][l * 64 + m];
            { const float* w1 = a->in[I_HW1] + (size_t)l * 33 * 64; const float b = a->in[I_HB1][l * 64 + m]; float s[4] = {b, b, b, b};
#pragma unroll
              for (int j = 0; j < 33; ++j) { const float w = w1[j * 64 + m];
#pragma unroll
                  for (int q = 0; q < 4; ++q) s[q] += zf[(p8 + 8 * q) * 36 + j] * w; }
#pragma unroll
              for (int q = 0; q < 4; ++q) h1[(p8 + 8 * q) * 64 + m] = sinf(fq * s[q]); }
            __syncthreads();
            { const float* w2 = a->in[I_HW2] + (size_t)l * 64 * 64; const float b = a->in[I_HB2][l * 64 + m]; float s[4] = {b, b, b, b};
#pragma unroll 8
              for (int j = 0; j < 64; ++j) { const float w = w2[j * 64 + m];
#pragma unroll
                  for (int q = 0; q < 4; ++q) s[q] += h1[(p8 + 8 * q) * 64 + j] * w; }
#pragma unroll
              for (int q = 0; q < 4; ++q) ((_Float16*)(ws + WS_HDN))[((size_t)l * ROWS + pg * 32 + p8 + 8 * q) * 64 + m] = (_Float16)sinf(fq * s[q]); }
        }
    }
    __syncthreads();
}
DI void phase_mod_reduce(AP a, int bid, int G) {
    const float* P = (const float*)(a->ws + WS_MODP); float* M = (float*)(a->ws + WS_MOD);
    const int tid = otid();
    for (int i = bid * NTHR + tid; i < NL * 2 * 6 * D; i += G * NTHR) {
        const int l = i / (2 * 6 * D), w = (i / (6 * D)) & 1, n = i % (6 * D);
        float s = a->in[I_ADAB][(size_t)l * 6 * D + n];
        for (int ks = 0; ks < 32; ++ks) s += P[(((size_t)l * 32 + ks) * 2 + w) * 6 * D + n];
        M[i] = s; }
}
DI void phase_norm_mod(AP a, int l, int which  , bool from_input, int bid, int G) {
    const int tid_o = otid(), lane = tid_o & 63, wave = tid_o >> 6;
    const float* gn = a->in[which ? I_NMOE : I_NMIX] + (size_t)l * D;
    const bf16* XR = (const bf16*)(a->ws + WS_XRES); bf16* H = (bf16*)(a->ws + WS_H); unsigned char* H8 = a->ws + WS_H8;
    for (int row = bid * NWAVES + wave; row < ROWS; row += G * NWAVES) {
        const int isc = row >= SEQ;
        const float* src = isc ? a->in[I_CTX] + (size_t)(row - SEQ) * D : a->in[I_X] + (size_t)row * D;
        const float* mod = (const float*)(a->ws + WS_MOD) + ((size_t)l * 2 + isc) * 6 * D + (which ? 3 * D : 0);
        f32x4 v[16]; float ss = 0.f;
#pragma unroll
        for (int j = 0; j < 16; ++j) { v[j] = from_input ? *(const f32x4*)(src + 4 * (lane + 64 * j)) : unpack4(*(const u32x2*)(XR + (size_t)row * D + 4 * (lane + 64 * j))); ss += v[j][0] * v[j][0] + v[j][1] * v[j][1] + v[j][2] * v[j][2] + v[j][3] * v[j][3]; }
        const float rs = rsqrtf(wave_sum(ss) * (1.f / D) + NORM_EPS);
#pragma unroll
        for (int jb = 0; jb < 4; ++jb) {
            f32x4 g[4], sh[4], sc[4];
#pragma unroll
            for (int jj = 0; jj < 4; ++jj) { const int c = 4 * (lane + 64 * (4 * jb + jj)); g[jj] = *(const f32x4*)(gn + c); sh[jj] = *(const f32x4*)(mod + c); sc[jj] = *(const f32x4*)(mod + D + c); }
#pragma unroll
            for (int jj = 0; jj < 4; ++jj) { const int j = 4 * jb + jj; const int c = 4 * (lane + 64 * j);
                const f32x4 o = (v[j] * rs) * g[jj] * (sc[jj] + 1.f) + sh[jj];
                u32x2 w; w.x = cvt_pk_bf16(o[0], o[1]); w.y = cvt_pk_bf16(o[2], o[3]);
                *(u32x2*)(H + (size_t)row * D + c) = w;
                *(unsigned*)(H8 + (size_t)row * D + c) = pk4_fp8(o[0] * 4.f, o[1] * 4.f, o[2] * 4.f, o[3] * 4.f); } }
    }
}
DI void phase_final_norm(AP a, int bid, int G) {
    const int tid_o = otid(), lane = tid_o & 63, wave = tid_o >> 6;
    const bf16* XR = (const bf16*)(a->ws + WS_XRES); const float* gn = a->in[I_NFIN];
    for (int row = bid * NWAVES + wave; row < SEQ; row += G * NWAVES) {
        f32x4 v[16]; float ss = 0.f;
#pragma unroll
        for (int j = 0; j < 16; ++j) { v[j] = unpack4(*(const u32x2*)(XR + (size_t)row * D + 4 * (lane + 64 * j))); ss += v[j][0] * v[j][0] + v[j][1] * v[j][1] + v[j][2] * v[j][2] + v[j][3] * v[j][3]; }
        const float rs = rsqrtf(wave_sum(ss) * (1.f / D) + NORM_EPS);
#pragma unroll
        for (int j = 0; j < 16; ++j) { const int c = 4 * (lane + 64 * j); *(f32x4*)(a->out + (size_t)row * D + c) = (v[j] * rs) * *(const f32x4*)(gn + c); }
    }
}

struct InProj8 {
    static constexpr bool GATHER = false, FP8 = true;
    int K, G, c, lastl; const char* Hb; const char* Wb; bf16* ZA; float* GATES; bf16* ZC; bf16* SGp;
    DI bool next(int i, Unit& u) const { const long L = (long)i * G + c;
        if (!lastl) { if (L >= NPAN * TF8) return false; pg8::tile_of((int)L, NPAN, TF8, u.pm, u.pn); }
        else { if (L >= (NPAN - 1) * TF8 + TAC) return false;
            if (L < (NPAN - 1) * TF8) pg8::tile_of((int)L, NPAN - 1, TF8, u.pm, u.pn); else { u.pm = NPAN - 1; u.pn = (int)L - (NPAN - 1) * TF8; } }
        u.aux = 0; return true; }
    DI const char* a_ptr(const Unit& u) const { return Hb + (size_t)u.pm * 256 * D; }
    DI const char* b_ptr(const Unit& u) const { return Wb + (size_t)u.pn * 256 * D; }
    DI unsigned a_row_off(const Unit&, int) const { return 0u; }
    DI void epi(const f32x4 (&acc)[2][2][4][2], const Unit& u, int wr, int wc, int fr, int fq) const {
        const int pn = u.pn, r0 = u.pm * 256; const float ds = 1.f / 2048.f;
        if (pn < TAC) {
            EPI_LOOP({ const int gc = pn * 256 + cl; const f32x4 x0 = v0 * ds, x1 = v1 * ds;
                       if (gc < NA) { bf16* p = ZA + (size_t)(r0 + rl) * NA_P + gc; *(u32x4*)p = pack8(x0, x1);
                           if (gc >= 3072) { float* g = GATES + (size_t)(r0 + rl) * 32 + (gc - 3072); *(f32x4*)g = x0; *(f32x4*)(g + 4) = x1; } }
                       else if (gc < NAC) { bf16* p = ZC + (size_t)(r0 + rl) * NC_P + (gc - NA); *(u32x4*)p = pack8(x0, x1); } })
        } else {
            const int gcol = (pn - TAC) * 256 + ((pn - TAC) >= 16 ? D : 0);
            EPI_LOOP({ bf16* p = SGp + (size_t)(r0 + rl) * NG + gcol + cl;
                       f32x4 s0, s1;
                       _Pragma("unroll") for (int e = 0; e < 4; ++e) { s0[e] = sigmoidf_(v0[e] * ds); s1[e] = sigmoidf_(v1[e] * ds); }
                       *(u32x4*)p = pack8(s0, s1); })
        }
    }
};
struct InProj16 {
    static constexpr bool GATHER = false, FP8 = false;
    int K, G, c, nM; const char* Hb; const char* Wb; float* ZBT; bf16* SGp;
    DI bool next(int i, Unit& u) const { const long L = (long)i * G + c; if (L >= nM * T16) return false; pg8::tile_of((int)L, nM, T16, u.pm, u.pn); u.aux = (u.pn < TB); return true; }
    DI const char* a_ptr(const Unit& u) const { return u.aux ? Wb + (size_t)u.pn * 256 * D * 2 : Hb + (size_t)u.pm * 256 * D * 2; }
    DI const char* b_ptr(const Unit& u) const { return u.aux ? Hb + (size_t)u.pm * 256 * D * 2 : Wb + (size_t)u.pn * 256 * D * 2; }
    DI unsigned a_row_off(const Unit&, int) const { return 0u; }
    DI void epi(const f32x4 (&acc)[2][2][4][2], const Unit& u, int wr, int wc, int fr, int fq) const {
        const int pn = u.pn, r0 = u.pm * 256;
        if (pn < TB) {
            EPI_LOOP({ float* p = ZBT + (size_t)(pn * 256 + rl) * ROWS + r0 + cl; *(f32x4*)p = v0; *(f32x4*)(p + 4) = v1; })
        } else {
            EPI_LOOP({ bf16* p = SGp + (size_t)(r0 + rl) * NG + D + (pn - TB) * 256 + cl;
                       f32x4 s0, s1;
                       _Pragma("unroll") for (int e = 0; e < 4; ++e) { s0[e] = sigmoidf_(v0[e]); s1[e] = sigmoidf_(v1[e]); }
                       *(u32x4*)p = pack8(s0, s1); })
        }
    }
};
struct BranchProj8 {
    static constexpr bool GATHER = false, FP8 = true;
    int K, G, c, nM; const char* YS; const char* Wb; const bf16* SGp; bf16* M32;
    DI bool next(int i, Unit& u) const { const int j = i >> 1, bi = i & 1; const long L = (long)j * G + c; if (L >= nM * 16) return false; pg8::tile_of((int)L, nM, 16, u.pm, u.pn); u.aux = bi; return true; }
    DI const char* a_ptr(const Unit& u) const { return YS + ((size_t)u.aux * ROWS + (size_t)u.pm * 256) * DBR; }
    DI const char* b_ptr(const Unit& u) const { return Wb + ((size_t)u.aux * D + (size_t)u.pn * 256) * DBR; }
    DI unsigned a_row_off(const Unit&, int) const { return 0u; }
    DI void epi(const f32x4 (&acc)[2][2][4][2], const Unit& u, int wr, int wc, int fr, int fq) const {
        const int r0 = u.pm * 256, c0 = u.pn * 256, br = 2 * u.aux; const bool first = u.aux == 0; const float ds = 1.f / 2048.f;
        _Pragma("unroll") for (int ai = 0; ai < 2; ++ai) _Pragma("unroll") for (int mh = 0; mh < 2; ++mh) {
            u32x4 gwv[2][2], mv[2][2];
            EPI_GROUPS(ai, { const size_t row = (size_t)(r0 + rl); const int col = c0 + cl;
                             gwv[mm][bj] = *(const u32x4*)(SGp + row * NG + br * D + col); mv[mm][bj] = first ? (u32x4){0u, 0u, 0u, 0u} : *(const u32x4*)(M32 + row * D + col); })
            EPI_GROUPS(ai, { const size_t row = (size_t)(r0 + rl); const int col = c0 + cl; const f32x4 v0 = acc[ai][bj][m][0], v1 = acc[ai][bj][m][1];
                             f32x4 g0, g1, m0, m1; unpack8(gwv[mm][bj], g0, g1); unpack8(mv[mm][bj], m0, m1);
                             *(u32x4*)(M32 + row * D + col) = pack8(v0 * g0 * ds + m0, v1 * g1 * ds + m1); }) }
    }
};
struct BranchProj16 {
    static constexpr bool GATHER = false, FP8 = false;
    int K, G, c, nM; const char* YS; const char* Wb; const bf16* SGp; const bf16* M32; bf16* MERGED;
    DI bool next(int i, Unit& u) const { const long L = (long)i * G + c; if (L >= nM * 16) return false; pg8::tile_of((int)L, nM, 16, u.pm, u.pn); u.aux = 0; return true; }
    DI const char* a_ptr(const Unit& u) const { return YS + ((size_t)ROWS + (size_t)u.pm * 256) * DBR * 2; }
    DI const char* b_ptr(const Unit& u) const { return Wb + ((size_t)D + (size_t)u.pn * 256) * DBR * 2; }
    DI unsigned a_row_off(const Unit&, int) const { return 0u; }
    DI void epi(const f32x4 (&acc)[2][2][4][2], const Unit& u, int wr, int wc, int fr, int fq) const {
        const int r0 = u.pm * 256, c0 = u.pn * 256;
        _Pragma("unroll") for (int ai = 0; ai < 2; ++ai) _Pragma("unroll") for (int mh = 0; mh < 2; ++mh) {
            u32x4 gwv[2][2], mv[2][2];
            EPI_GROUPS(ai, { const size_t row = (size_t)(r0 + rl); const int col = c0 + cl;
                             gwv[mm][bj] = *(const u32x4*)(SGp + row * NG + D + col); mv[mm][bj] = *(const u32x4*)(M32 + row * D + col); })
            EPI_GROUPS(ai, { const size_t row = (size_t)(r0 + rl); const int col = c0 + cl; const f32x4 v0 = acc[ai][bj][m][0], v1 = acc[ai][bj][m][1];
                             f32x4 g0, g1, m0, m1; unpack8(gwv[mm][bj], g0, g1); unpack8(mv[mm][bj], m0, m1);
                             *(u32x4*)(MERGED + row * D + col) = pack8(v0 * g0 + m0, v1 * g1 + m1); }) }
    }
};
struct OutProj {
    static constexpr bool GATHER = false, FP8 = false;
    int K, G, c; const char* Ab; const char* Wb; bf16* XR; const float* gate;
    const float* xin; const float* cin;
    int nM;
    DI bool next(int i, Unit& u) const { const long L = (long)i * G + c; if (L >= nM * 16) return false; pg8::tile_of((int)L, nM, 16, u.pm, u.pn); u.aux = 0; return true; }
    DI const char* a_ptr(const Unit& u) const { return Ab + (size_t)u.pm * 256 * D * 2; }
    DI const char* b_ptr(const Unit& u) const { return Wb + (size_t)u.pn * 256 * D * 2; }
    DI unsigned a_row_off(const Unit&, int) const { return 0u; }
    DI void epi(const f32x4 (&acc)[2][2][4][2], const Unit& u, int wr, int wc, int fr, int fq) const {
        const int r0 = u.pm * 256, c0 = u.pn * 256; const float* g = gate + (u.pm == NPAN - 1 ? 6 * D : 0);
        const float* srcb = (u.pm == NPAN - 1) ? cin - (size_t)SEQ * D : xin; const bool fin = xin != nullptr;
        f32x4 gv[2][2];
        _Pragma("unroll") for (int bj = 0; bj < 2; ++bj) { const int col = c0 + bj * 128 + wc * 32 + 8 * fq; gv[bj][0] = *(const f32x4*)(g + col); gv[bj][1] = *(const f32x4*)(g + col + 4); }
        _Pragma("unroll") for (int ai = 0; ai < 2; ++ai) _Pragma("unroll") for (int mh = 0; mh < 2; ++mh) {
            f32x4 qa[2][2], qb[2][2];
            EPI_GROUPS(ai, { const int col = c0 + cl;
                             if (fin) { const float* q = srcb + (size_t)(r0 + rl) * D + col; qa[mm][bj] = *(const f32x4*)q; qb[mm][bj] = *(const f32x4*)(q + 4); }
                             else unpack8(*(const u32x4*)(XR + (size_t)(r0 + rl) * D + col), qa[mm][bj], qb[mm][bj]); })
            EPI_GROUPS(ai, { const int col = c0 + cl; const f32x4 v0 = acc[ai][bj][m][0], v1 = acc[ai][bj][m][1];
                             *(u32x4*)(XR + (size_t)(r0 + rl) * D + col) = pack8(qa[mm][bj] + gv[bj][0] * v0, qb[mm][bj] + gv[bj][1] * v1); }) }
    }
};

DI f32x4 mfma16h(f16x8 a, f16x8 b, f32x4 c) { return __builtin_amdgcn_mfma_f32_16x16x32_f16(a, b, c, 0, 0, 0); }
DI f32x2 cmul(f32x2 a, f32x2 b) { return (f32x2){a.x * b.x - a.y * b.y, a.x * b.y + a.y * b.x}; }
DI f32x2 cconj(f32x2 a) { return (f32x2){a.x, -a.y}; }
DI int sw(int i) { return i ^ ((i >> 5) & 31); }
DI f32x2 twid_r(float r) { return (f32x2){__builtin_amdgcn_cosf(r), -__builtin_amdgcn_sinf(r)}; }
template <int S, bool INV, int NBF> DI void fft_pass(LAS f32x2* Dm, int L, int lb, int tid) {
    constexpr int P = 1 << S;
    const int lh = lb - S, h = 1 << lh, nbt = L >> S; const float invB = 1.0f / (float)(1 << lb);
    constexpr float TC[8] = {1.f, 0.92387953251f, 0.70710678119f, 0.38268343236f, 0.f, -0.38268343236f, -0.70710678119f, -0.92387953251f};
    constexpr float TS[8] = {0.f, 0.38268343236f, 0.70710678119f, 0.92387953251f, 1.f, 0.92387953251f, 0.70710678119f, 0.38268343236f};
    for (int i0 = tid; i0 < nbt; i0 += NBF * NTHR) {
        f32x2 x[NBF][P]; int base[NBF]; float rr[NBF];
#pragma unroll
        for (int u = 0; u < NBF; ++u) { const int idx = i0 + u * NTHR; const int blk = idx >> lh, j = idx & (h - 1); base[u] = (blk << lb) + j; rr[u] = (float)j * invB;
            if (idx < nbt) {
#pragma unroll
                for (int k = 0; k < P; ++k) x[u][k] = Dm[sw(base[u] + k * h)]; } }
#pragma unroll
        for (int u = 0; u < NBF; ++u) { const int idx = i0 + u * NTHR;
            if (idx < nbt) {
                f32x2 wp[S]; wp[0] = twid_r(rr[u]); if (INV) wp[0] = cconj(wp[0]);
#pragma unroll
                for (int t = 1; t < S; ++t) wp[t] = cmul(wp[t - 1], wp[t - 1]);
#pragma unroll
                for (int ss = 0; ss < S; ++ss) { const int st = INV ? S - 1 - ss : ss; const int grp = 1 << (S - st), half = grp >> 1;
#pragma unroll
                    for (int kp = 0; kp < half; ++kp) { const int ci = kp << (4 - S + st);
                        const f32x2 cst = {TC[ci], INV ? TS[ci] : -TS[ci]};
                        const f32x2 tw = (ci == 0) ? wp[st] : cmul(wp[st], cst);
#pragma unroll
                        for (int g = 0; g < (1 << st); ++g) { const int ia = g * grp + kp, ib = ia + half;
                            if (!INV) { const f32x2 uu = x[u][ia] + x[u][ib], vv = cmul(x[u][ia] - x[u][ib], tw); x[u][ia] = uu; x[u][ib] = vv; }
                            else { const f32x2 tt = cmul(x[u][ib], tw); const f32x2 xa = x[u][ia]; x[u][ia] = xa + tt; x[u][ib] = xa - tt; } } } }
#pragma unroll
                for (int k = 0; k < P; ++k) Dm[sw(base[u] + k * h)] = x[u][k]; } }
    }
    __syncthreads();
}
DI void fft_fwd(LAS f32x2* Dm, int L, int lg, int tid) {
    int lb = lg;
    for (; lb >= 4; lb -= 4) fft_pass<4, false, 2>(Dm, L, lb, tid);
    if (lb == 2) fft_pass<2, false, 8>(Dm, L, 2, tid);
}
DI void fft_inv(LAS f32x2* Dm, int L, int lg, int tid) {
    const int rem = lg & 3;
    if (rem == 2) fft_pass<2, true, 8>(Dm, L, 2, tid);
    for (int lb = rem + 4; lb <= lg; lb += 4) fft_pass<4, true, 2>(Dm, L, lb, tid);
}
DI void fwd4(f32x2 (&x)[4]) { const f32x2 a0 = x[0] + x[2], a1 = x[1] + x[3], a2 = x[0] - x[2], d = x[1] - x[3]; const f32x2 a3 = {d.y, -d.x}; x[0] = a0 + a1; x[1] = a0 - a1; x[2] = a2 + a3; x[3] = a2 - a3; }
DI void inv4(f32x2 (&x)[4]) { const f32x2 b0 = x[0] + x[1], b1 = x[0] - x[1], b2 = x[2] + x[3], b3 = x[2] - x[3]; const f32x2 ib = {-b3.y, b3.x}; x[0] = b0 + b2; x[1] = b1 + ib; x[2] = b0 - b2; x[3] = b1 - ib; }
DI void fft_fwd3(LAS f32x2* Dm, int L, int tid) { int lb = 14; asm volatile("" : "+s"(lb)); for (; lb >= 6; lb -= 4) fft_pass<4, false, 2>(Dm, L, lb, tid); }
DI void fft_inv3(LAS f32x2* Dm, int L, int tid) { int lb = 6; asm volatile("" : "+s"(lb)); for (; lb <= 14; lb += 4) fft_pass<4, true, 2>(Dm, L, lb, tid); }
DI float block_sum(float v, LAS float* red, int tid) {
    v = wave_sum(v); __syncthreads(); if ((tid & 63) == 0) red[tid >> 6] = v; __syncthreads();
    float s = 0.f;
#pragma unroll
    for (int w = 0; w < NWAVES; ++w) s += red[w];
    return s;
}
DI void hyena_item(AP a, int l, int ch, int seq, LAS unsigned char* lds, unsigned char* scr_g) {
    const int tid = otid();
    const int L = seq ? CTX : SEQ, lg = seq ? 8 : 14, t0 = seq ? SEQ : 0, Lh = L >> 1;
    LAS f32x2* Dm = (LAS f32x2*)lds; LAS float* Df = (LAS float*)lds;
    LAS float* w3s = (LAS float*)(lds + LDS_SMALL);
    LAS float* red = w3s + 256;
    f32x4* G2 = (f32x4*)scr_g;
    float* Y1 = (float*)(scr_g + 131072 + 4096);
    float* K2 = (float*)(scr_g + 131072 + 4096 + 65536);
    const float* ZBT = (const float*)(a->ws + WS_ZBT);
        const float* cw = a->in[I_HCW] + (size_t)l * 3 * NB; const float* cb = a->in[I_HCB] + (size_t)l * NB;
    const float da = logf(1e-2f) / 1.5f, db = logf(1e-2f) / 0.3f;
    const float delta = fabsf(da + (float)ch * ((db - da) / 1023.f));
    const float invLm1 = 1.f / (float)(L - 1);
    __syncthreads();
    if (tid < 256) w3s[tid] = a->in[I_HW3][(size_t)l * 64 * 4096 + (size_t)(tid & 63) * 4096 + (tid >> 6) * 1024 + ch];
    __syncthreads();
    float ssq0 = 0.f, ssq1 = 0.f;
    if (tid == 0) { Df[2 * sw(Lh)] = 0.f; K2[2 * Lh] = 0.f; }
    {
        const int lane = tid & 63, wv = tid >> 6, r16 = lane & 15, q4 = lane >> 4;
        f16x8 wf[2];
#pragma unroll
        for (int ks = 0; ks < 2; ++ks)
#pragma unroll
            for (int e = 0; e < 8; ++e) wf[ks][e] = (_Float16)w3s[(r16 & 3) * 64 + 32 * ks + 8 * q4 + e];
        const _Float16* hb = (const _Float16*)(a->ws + WS_HDN) + ((size_t)l * ROWS + t0) * 64 + (size_t)r16 * 64 + 8 * q4;
        const int nblk = L >> 6;
        f16x8 cur[8], nxt[8];
        if (wv < nblk) {
#pragma unroll
            for (int j = 0; j < 8; ++j) cur[j] = *(const f16x8*)(hb + (size_t)(wv * 64 + (j >> 1) * 16) * 64 + 32 * (j & 1)); }
        for (int blk = wv; blk < nblk; blk += NWAVES) {
            if (blk + NWAVES < nblk) {
#pragma unroll
                for (int j = 0; j < 8; ++j) nxt[j] = *(const f16x8*)(hb + (size_t)((blk + NWAVES) * 64 + (j >> 1) * 16) * 64 + 32 * (j & 1)); }
            f32x4 sv = {0.f, 0.f, 0.f, 0.f};
#pragma unroll
            for (int g = 0; g < 4; ++g) { f32x4 acc = {0.f, 0.f, 0.f, 0.f};
                acc = mfma16h(wf[0], cur[2 * g], acc); acc = mfma16h(wf[1], cur[2 * g + 1], acc);
                sv = (q4 == g) ? acc : sv; }
            const int P = blk * 64 + lane; const float wd = expf(-(float)P * invLm1 * delta);
            const float kf1 = sv[0] * wd, kb1 = sv[1] * wd, kf2 = sv[2] * wd, kb2 = sv[3] * wd;
            Df[2 * sw(P >> 1) + (P & 1)] = kf1; K2[P] = kf2; ssq0 += kf1 * kf1; ssq1 += kf2 * kf2;
            if (P >= 1) { const int eb = 2 * L - P; Df[2 * sw(eb >> 1) + (eb & 1)] = kb1; K2[eb] = kb2; ssq0 += kb1 * kb1; ssq1 += kb2 * kb2; }
#pragma unroll
            for (int j = 0; j < 8; ++j) cur[j] = nxt[j];
        }
    }
    const float ksc0 = rsqrtf(block_sum(ssq0, red, tid)) / (float)L, ksc1 = rsqrtf(block_sum(ssq1, red, tid)) / (float)L;
    for (int cv = 0; cv < 2; ++cv) {
        const float kscale = cv ? ksc1 : ksc0;
        if (cv == 1) { __syncthreads(); for (int n = tid; n < L; n += NTHR) Dm[sw(n)] = *(const f32x2*)(K2 + 2 * n); __syncthreads(); }
        if (seq == 0) {
            fft_fwd3(Dm, L, tid);
#pragma unroll 1
            for (int it = 0; it < 4; ++it) { const int wq = it * NTHR + tid, r = (tid >> 6) + 8 * it, ln = tid & 63; const int kb = ((r >> 4) << 10) | ((ln >> 5) << 9) | ((ln & 31) << 4) | (r & 15);
                if (kb == 0) continue;
                const int g4 = 4 * (int)(__brev((unsigned)kb) >> 20), gp4 = 4 * (int)(__brev((unsigned)(4096 - kb)) >> 20);
                f32x2 y[4], yp[4];
#pragma unroll
                for (int i = 0; i < 4; ++i) { y[i] = Dm[sw(g4 + i)]; yp[i] = Dm[sw(gp4 + i)]; }
                fwd4(y); fwd4(yp);
                G2[4 * wq] = (f32x4){y[0].x, y[0].y, yp[3].x, yp[3].y}; G2[4 * wq + 1] = (f32x4){y[2].x, y[2].y, yp[1].x, yp[1].y};
                G2[4 * wq + 2] = (f32x4){yp[2].x, yp[2].y, y[1].x, y[1].y}; G2[4 * wq + 3] = (f32x4){yp[0].x, yp[0].y, y[3].x, y[3].y}; }
            if (tid == 0 || tid == 64) { const int g4 = tid ? 4 : 0; f32x2 y[4];
#pragma unroll
                for (int i = 0; i < 4; ++i) y[i] = Dm[sw(g4 + i)];
                fwd4(y);
                if (tid == 0) { G2[8192] = (f32x4){y[0].x, y[0].y, y[0].x, y[0].y}; G2[8193] = (f32x4){y[1].x, y[1].y, y[1].x, y[1].y}; G2[8194] = (f32x4){y[2].x, y[2].y, y[3].x, y[3].y}; }
                else { G2[8195] = (f32x4){y[0].x, y[0].y, y[3].x, y[3].y}; G2[8196] = (f32x4){y[2].x, y[2].y, y[1].x, y[1].y}; } }
        } else {
        fft_fwd(Dm, L, lg, tid);
        for (int k = tid; k <= Lh; k += NTHR) { const int mk = (L - k) & (L - 1);
            const int pk = (int)(__brev((unsigned)k) >> (32 - lg)), pm = (int)(__brev((unsigned)mk) >> (32 - lg));
            const f32x2 zk = Dm[sw(pk)], zkm = Dm[sw(pm)]; G2[k] = (f32x4){zk.x, zk.y, zkm.x, zkm.y}; }
        }
        __syncthreads();
        const float w0 = cw[ch], w1c = cw[NB + ch], w2c = cw[2 * NB + ch], bb = cb[ch];
        const float* zv = ZBT + (size_t)ch * ROWS + t0;
#pragma unroll 4
        for (int n = tid; n < L; n += NTHR) {
            f32x2 v = {0.f, 0.f};
            if (n < Lh) {
                if (cv == 0) { const int t = 2 * n; const float zm = t > 0 ? zv[t - 1] : 0.f, z2 = (t + 2 < L) ? zv[t + 2] : 0.f; const f32x2 z01 = *(const f32x2*)(zv + t);
                    v.x = zm * w0 + z01.x * w1c + z01.y * w2c + bb; v.y = z01.x * w0 + z01.y * w1c + z2 * w2c + bb; }
                else v = *(const f32x2*)(Y1 + 2 * n);
            }
            Dm[sw(n)] = v; }
        __syncthreads();
        if (seq == 0) {
            fft_fwd3(Dm, L, tid);
            auto spec = [&](int k, int slot, f32x2 zu, f32x2 zum, f32x2& ou, f32x2& om) {
                const f32x4 g = G2[slot]; const f32x2 zk = {g[0], g[1]}, zkm = {g[2], g[3]};
                const f32x2 ue = (zu + cconj(zum)) * 0.5f, du = zu - cconj(zum), uo = (f32x2){0.5f * du.y, -0.5f * du.x};
                const f32x2 ke = (zk + cconj(zkm)) * 0.5f, dk = zk - cconj(zkm), ko = (f32x2){0.5f * dk.y, -0.5f * dk.x};
                const f32x2 w = twid_r((float)k * (1.0f / 16384.f));
                const f32x2 ye = cmul(ue, ke) + cmul(w, cmul(uo, ko)), yo = cmul(ue, ko) + cmul(uo, ke);
                ou = (f32x2){ye.x - yo.y, ye.y + yo.x}; om = (f32x2){ye.x + yo.y, -ye.y + yo.x}; };
#pragma unroll 1
            for (int it = 0; it < 4; ++it) { const int wq = it * NTHR + tid, r = (tid >> 6) + 8 * it, ln = tid & 63; const int kb = ((r >> 4) << 10) | ((ln >> 5) << 9) | ((ln & 31) << 4) | (r & 15);
                if (kb == 0) continue;
                const int g4 = 4 * (int)(__brev((unsigned)kb) >> 20), gp4 = 4 * (int)(__brev((unsigned)(4096 - kb)) >> 20);
                f32x2 y[4], yp[4], o[4], op[4];
#pragma unroll
                for (int i = 0; i < 4; ++i) { y[i] = Dm[sw(g4 + i)]; yp[i] = Dm[sw(gp4 + i)]; }
                fwd4(y); fwd4(yp);
                spec(kb, 4 * wq, y[0], yp[3], o[0], op[3]); spec(kb + 4096, 4 * wq + 1, y[2], yp[1], o[2], op[1]); spec(8192 - kb, 4 * wq + 2, yp[2], y[1], op[2], o[1]); spec(4096 - kb, 4 * wq + 3, yp[0], y[3], op[0], o[3]);
                inv4(o); inv4(op);
#pragma unroll
                for (int i = 0; i < 4; ++i) { Dm[sw(g4 + i)] = o[i]; Dm[sw(gp4 + i)] = op[i]; } }
            if (tid == 0 || tid == 64) {
                const int g4 = tid ? 4 : 0; f32x2 y[4], o[4], dum;
#pragma unroll
                for (int i = 0; i < 4; ++i) y[i] = Dm[sw(g4 + i)];
                fwd4(y);
                if (tid == 0) { spec(0, 8192, y[0], y[0], o[0], dum); spec(8192, 8193, y[1], y[1], o[1], dum); spec(4096, 8194, y[2], y[3], o[2], o[3]); }
                else { spec(2048, 8195, y[0], y[3], o[0], o[3]); spec(6144, 8196, y[2], y[1], o[2], o[1]); }
                inv4(o);
#pragma unroll
                for (int i = 0; i < 4; ++i) Dm[sw(g4 + i)] = o[i]; }
            __syncthreads();
            fft_inv3(Dm, L, tid);
        } else {
        fft_fwd(Dm, L, lg, tid);
#pragma unroll 4
        for (int k = tid; k <= Lh; k += NTHR) {
            const int mk = (L - k) & (L - 1);
            const int pk = (int)(__brev((unsigned)k) >> (32 - lg)), pm = (int)(__brev((unsigned)mk) >> (32 - lg));
            const int spk = sw(pk), spm = sw(pm);
            const f32x4 g = G2[k]; const f32x2 zu = Dm[spk], zum = Dm[spm], zk = {g[0], g[1]}, zkm = {g[2], g[3]};
            const f32x2 ue = (zu + cconj(zum)) * 0.5f, du = zu - cconj(zum), uo = (f32x2){0.5f * du.y, -0.5f * du.x};
            const f32x2 ke = (zk + cconj(zkm)) * 0.5f, dk = zk - cconj(zkm), ko = (f32x2){0.5f * dk.y, -0.5f * dk.x};
            const f32x2 w = twid_r((float)k * (1.0f / (float)L));
            const f32x2 ye = cmul(ue, ke) + cmul(w, cmul(uo, ko)), yo = cmul(ue, ko) + cmul(uo, ke);
            Dm[spk] = (f32x2){ye.x - yo.y, ye.y + yo.x};
            if (pm != pk) Dm[spm] = (f32x2){ye.x + yo.y, -ye.y + yo.x}; }
        __syncthreads();
        fft_inv(Dm, L, lg, tid);
        }
        const float skip = a->in[I_HSKIP][(size_t)l * 2 * DBR + cv * DBR + ch];
        const int chg = (cv == 0 ? DBR : 2 * DBR) + ch;
        const float g0 = cw[chg], g1 = cw[NB + chg], g2 = cw[2 * NB + chg], gb = cb[chg];
        const float* zg = ZBT + (size_t)chg * ROWS + t0;
        float* YBT = (float*)(a->ws + WS_YBT) + (size_t)ch * ROWS + t0;
#pragma unroll 8
        for (int n = tid; n < Lh; n += NTHR) { const int t = 2 * n;
            const f32x2 c = Dm[sw(n)] * kscale;
            f32x2 s;
            if (cv == 0) { const float zm = t > 0 ? zv[t - 1] : 0.f, z2 = (t + 2 < L) ? zv[t + 2] : 0.f; const f32x2 z01 = *(const f32x2*)(zv + t);
                s.x = zm * w0 + z01.x * w1c + z01.y * w2c + bb; s.y = z01.x * w0 + z01.y * w1c + z2 * w2c + bb; }
            else s = *(const f32x2*)(Y1 + t);
            const float qm = t > 0 ? zg[t - 1] : 0.f, q2 = (t + 2 < L) ? zg[t + 2] : 0.f; const f32x2 q01 = *(const f32x2*)(zg + t);
            const f32x2 ug = {qm * g0 + q01.x * g1 + q01.y * g2 + gb, q01.x * g0 + q01.y * g1 + q2 * g2 + gb};
            const f32x2 o = ug * (c + s * skip);
            if (cv == 0) *(f32x2*)(Y1 + t) = o; else *(f32x2*)(YBT + t) = o; }
        __syncthreads();
    }
}
DI void phase_yb_transpose(AP a, LAS unsigned char* lds, int bid, int G, int ncol64) {
    const int tid_o = otid(), lane = tid_o & 63, wave = tid_o >> 6;
    LAS float* scr = (LAS float*)(lds + wave * 16640);
    const float* YBT = (const float*)(a->ws + WS_YBT); bf16* YB = (bf16*)(a->ws + WS_YS) + (size_t)1 * ROWS * DBR;
    for (int it = bid * NWAVES + wave; it < (DBR / 64) * ncol64; it += G * NWAVES) {
        const int cbk = it / ncol64, tb = it % ncol64;
        transpose_tile(YBT, ROWS, cbk * 64, tb * 64, YB, DBR, scr, lane); }
}

constexpr int ML_LD = 72;
constexpr int ML_QS = 0, ML_QE = 9216, ML_KS = 18432, ML_KPT = 27648, ML_SS = 36864, ML_VT = 46080, ML_CT = 66816, ML_GB = 87552, ML_GA = ML_GB + 256, ML_DEN = ML_GA + 256;
DI f32x4 mfma16(bf16x8 a, bf16x8 b, f32x4 c) { return __builtin_amdgcn_mfma_f32_16x16x32_bf16(a, b, c, 0, 0, 0); }
DI bf16x8 ldfrag(const LAS bf16* tile, int row0, int kofs, int lane) { return *(const LAS bf16x8*)(tile + (row0 + (lane & 15)) * ML_LD + kofs + 8 * (lane >> 4)); }
DI bf16x8 ldfrag_sw(const LAS bf16* tile, int row0, int kofs, int lane, int shift) { const int row = row0 + (lane & 15); return *(const LAS bf16x8*)(tile + row * ML_LD + ((kofs + 8 * (lane >> 4)) ^ (((row >> shift) & 7) << 3))); }
DI unsigned short f2bf(float f) { return (unsigned short)(cvt_pk_bf16(f, 0.f) & 0xffffu); }
DI int ml_row(int d, int ci, int j) { if (d == 0) { const int r0 = ci < 4 ? SEQ + 64 * ci : 64 * (ci - 4); return r0 + j; } const int r0 = ci < 4 ? SEQ + 64 * (3 - ci) : 64 * (259 - ci); return r0 + 63 - j; }
DI void mlstm_scan(AP a, int l, int h, int d, LAS unsigned char* lds) {
    const int tid = otid(), lane = tid & 63, w = tid >> 6, q4 = lane >> 4, r16 = lane & 15;
    LAS bf16* Qs = (LAS bf16*)(lds + ML_QS); LAS bf16* Qe = (LAS bf16*)(lds + ML_QE); LAS bf16* Ks = (LAS bf16*)(lds + ML_KS); LAS bf16* Kpt = (LAS bf16*)(lds + ML_KPT);
    LAS bf16* Ss = (LAS bf16*)(lds + ML_SS); LAS bf16* Vt = (LAS bf16*)(lds + ML_VT); LAS bf16* Ct = (LAS bf16*)(lds + ML_CT);
    LAS float* bc = (LAS float*)(lds + ML_GB); LAS float* av = (LAS float*)(lds + ML_GA); LAS float* den = (LAS float*)(lds + ML_DEN);
    const bf16* ZA = (const bf16*)(a->ws + WS_ZA); const float* GT = (const float*)(a->ws + WS_GATES);
    float* HD = (float*)(a->ws + WS_HDIR) + (size_t)d * ROWS * DBR;
    const float bias_i = a->in[I_MGB][l * 32 + d * 16 + h], bias_f = a->in[I_MGB][l * 32 + d * 16 + 8 + h];
    __syncthreads();
    for (int i = tid; i < 144 * ML_LD; i += NTHR) Ct[i] = 0;
    for (int i = tid; i < 16 * ML_LD; i += NTHR) Vt[128 * ML_LD + i] = (i < ML_LD) ? (bf16)0x3f80 : (bf16)0;
    f32x4 st[5];
#pragma unroll
    for (int j = 0; j < 5; ++j) st[j] = (f32x4){0.f, 0.f, 0.f, 0.f};
    const int jrow = tid >> 3, kb = tid & 7;
    u32x4 rq, rk, rv0, rv1; float gi = 0.f, gf = 0.f;
#define ML_LOAD(ci) do { const int row_ = ml_row(d, (ci), jrow); const bf16* zr_ = ZA + (size_t)row_ * NA_P; rq = *(const u32x4*)(zr_ + h * 64 + 8 * kb); rk = *(const u32x4*)(zr_ + 512 + h * 64 + 8 * kb); \
        rv0 = *(const u32x4*)(zr_ + 1024 + h * 128 + 16 * kb); rv1 = *(const u32x4*)(zr_ + 1024 + h * 128 + 16 * kb + 8); \
        if (tid < 64) { const int rw_ = ml_row(d, (ci), tid); gi = GT[(size_t)rw_ * 32 + d * 16 + h]; gf = GT[(size_t)rw_ * 32 + d * 16 + 8 + h]; } } while (0)
    ML_LOAD(0);
    for (int ci = 0; ci < 260; ++ci) {
        if (w == 0) {
            const float ip = 15.f * tanhf((gi + bias_i) * (1.f / 15.f)), fp = 15.f * tanhf((gf + bias_f) * (1.f / 15.f));
            float cum = fp >= 0.f ? -log1pf(expf(-fp)) : fp - log1pf(expf(fp));
#pragma unroll
            for (int o = 1; o < 64; o <<= 1) { const float t = __shfl_up(cum, o); if (lane >= o) cum += t; }
            bc[lane] = cum; av[lane] = ip;
        }
        __syncthreads();
        {
            const float bj = bc[jrow], eb = expf(bj), wk = expf(bc[63] - bj + av[jrow]);
            const unsigned qw[4] = {rq.x, rq.y, rq.z, rq.w}, kw[4] = {rk.x, rk.y, rk.z, rk.w};
            f32x4 q0, q1;
#pragma unroll
            for (int e = 0; e < 4; ++e) { const float lo = __uint_as_float(qw[e] << 16) * 0.125f, hi = __uint_as_float(qw[e] & 0xffff0000u) * 0.125f;
                if (e < 2) { q0[2 * e] = lo; q0[2 * e + 1] = hi; } else { q1[2 * (e - 2)] = lo; q1[2 * (e - 2) + 1] = hi; } }
            *(LAS u32x4*)(Qs + jrow * ML_LD + 8 * kb) = pack8(q0, q1);
            *(LAS u32x4*)(Qe + jrow * ML_LD + 8 * kb) = pack8(q0 * eb, q1 * eb);
            *(LAS u32x4*)(Ks + jrow * ML_LD + 8 * kb) = rk;
#pragma unroll
            for (int e = 0; e < 4; ++e) { Kpt[(8 * kb + 2 * e) * ML_LD + (jrow ^ (kb << 3))] = f2bf(__uint_as_float(kw[e] << 16) * wk); Kpt[(8 * kb + 2 * e + 1) * ML_LD + (jrow ^ (kb << 3))] = f2bf(__uint_as_float(kw[e] & 0xffff0000u) * wk); }
            const unsigned vw[8] = {rv0.x, rv0.y, rv0.z, rv0.w, rv1.x, rv1.y, rv1.z, rv1.w};
#pragma unroll
            for (int e = 0; e < 8; ++e) { Vt[(16 * kb + 2 * e) * ML_LD + (jrow ^ (kb << 3))] = (bf16)(vw[e] & 0xffffu); Vt[(16 * kb + 2 * e + 1) * ML_LD + (jrow ^ (kb << 3))] = (bf16)(vw[e] >> 16); }
        }
        if (ci + 1 < 260) ML_LOAD(ci + 1);
        __syncthreads();
#pragma unroll
        for (int tt = 0; tt < 2; ++tt) { const int tau = 2 * w + tt, mt = tau >> 2, ns = tau & 3;
            f32x4 acc = {0.f, 0.f, 0.f, 0.f};
            if (ns <= mt) {
#pragma unroll
                for (int ks = 0; ks < 2; ++ks) acc = mfma16(ldfrag(Qs, 16 * mt, 32 * ks, lane), ldfrag(Ks, 16 * ns, 32 * ks, lane), acc); }
            const int sx = 16 * ns + r16; const float bs = bc[sx] - av[sx];
#pragma unroll
            for (int i = 0; i < 4; ++i) { const int t = 16 * mt + 4 * q4 + i; const float val = (sx <= t) ? acc[i] * expf(bc[t] - bs) : 0.f; Ss[t * ML_LD + sx] = f2bf(val); } }
        __syncthreads();
        f32x4 nacc[5];
#pragma unroll
        for (int j = 0; j < 5; ++j) { const int tau = w + 8 * j; nacc[j] = (f32x4){0.f, 0.f, 0.f, 0.f};
            if (tau < 36) { const int mt = tau / 9, nv = tau - 9 * mt; f32x4 acc = {0.f, 0.f, 0.f, 0.f};
#pragma unroll
                for (int ks = 0; ks < 2; ++ks) acc = mfma16(ldfrag(Ss, 16 * mt, 32 * ks, lane), ldfrag_sw(Vt, 16 * nv, 32 * ks, lane, 4), acc);
#pragma unroll
                for (int ks = 0; ks < 2; ++ks) acc = mfma16(ldfrag(Qe, 16 * mt, 32 * ks, lane), ldfrag(Ct, 16 * nv, 32 * ks, lane), acc);
                nacc[j] = acc;
                if (nv == 8 && r16 == 0) {
#pragma unroll
                    for (int i = 0; i < 4; ++i) den[16 * mt + 4 * q4 + i] = acc[i]; } } }
        __syncthreads();
#pragma unroll
        for (int j = 0; j < 5; ++j) { const int tau = w + 8 * j;
            if (tau < 36) { const int mt = tau / 9, nv = tau - 9 * mt;
                if (nv < 8) {
#pragma unroll
                    for (int i = 0; i < 4; ++i) { const int t = 16 * mt + 4 * q4 + i; const float dd = 1.f / fmaxf(fabsf(den[t]), 1.f);
                        HD[(size_t)ml_row(d, ci, t) * DBR + h * 128 + 16 * nv + r16] = nacc[j][i] * dd; } } } }
        { const float g = expf(bc[63]);
#pragma unroll
            for (int j = 0; j < 5; ++j) { const int tau = w + 8 * j;
                if (tau < 36) { const int mv = tau >> 2, nk = tau & 3; f32x4 acc = st[j] * g;
#pragma unroll
                    for (int ks = 0; ks < 2; ++ks) acc = mfma16(ldfrag_sw(Vt, 16 * mv, 32 * ks, lane, 4), ldfrag_sw(Kpt, 16 * nk, 32 * ks, lane, 3), acc);
                    st[j] = acc;
#pragma unroll
                    for (int i = 0; i < 4; ++i) Ct[(16 * mv + 4 * q4 + i) * ML_LD + 16 * nk + r16] = f2bf(acc[i]); } } }
        __syncthreads();
    }
#undef ML_LOAD
}

DI int rw_row(int P) { if (P < CTX) return SEQ + P; const int p = P - CTX; return (p & 255) * 64 + (p >> 8); }
constexpr int RW_TOK = 8;
constexpr int PT = 13, PLD = 456, P_RKV = 16 * PLD * 2;
DI void rwkv_prep_item(AP a, int l, int item, LAS unsigned char* lds) {
    const int tid = otid(), lane = tid & 63, wv = __builtin_amdgcn_readfirstlane(tid >> 6), q4 = lane >> 4, r16 = lane & 15;
    LAS bf16* LI = (LAS bf16*)lds;
    LAS bf16* RKV = (LAS bf16*)(lds + P_RKV);
    const bf16* ZC = (const bf16*)(a->ws + WS_ZC); const float* mu = a->in[I_RMU] + (size_t)l * NC;
    const int P0 = item * PT;
    __syncthreads();
    for (int i = tid; i < 3 * PLD; i += NTHR) LI[PT * PLD + i] = 0;
    for (int idx = tid; idx < PT * (NC / 4); idx += NTHR) { const int tt = idx / (NC / 4), c = 4 * (idx - tt * (NC / 4)); const int P = P0 + tt;
        const bool hp = (P != 0 && P != CTX), hn = (P != CTX - 1 && P != ROWS - 1);
        const f32x4 z0 = unpack4(*(const u32x2*)(ZC + (size_t)rw_row(P) * NC_P + c));
        const f32x4 zp = hp ? unpack4(*(const u32x2*)(ZC + (size_t)rw_row(P - 1) * NC_P + c)) : (f32x4){0.f, 0.f, 0.f, 0.f};
        const f32x4 zn = hn ? unpack4(*(const u32x2*)(ZC + (size_t)rw_row(P + 1) * NC_P + c)) : (f32x4){0.f, 0.f, 0.f, 0.f};
        f32x4 z = z0 + *(const f32x4*)(mu + c) * ((zp + zn) * 0.5f - z0);
        if (c >= 3072 && c < 3200) {
#pragma unroll
            for (int e = 0; e < 4; ++e) z[e] = tanhf(z[e]); }
        if (c >= 3328) {
#pragma unroll
            for (int e = 0; e < 4; ++e) z[e] = sigmoidf_(z[e]); }
        u32x2 w; w.x = cvt_pk_bf16(z[0], z[1]); w.y = cvt_pk_bf16(z[2], z[3]);
        if (c < 3072) *(LAS u32x2*)(RKV + tt * 3072 + c) = w; else *(LAS u32x2*)(LI + tt * PLD + (c - 3072)) = w; }
    __syncthreads();
    const bf16* LT = (const bf16*)(a->ws + WS_LORAT) + (size_t)l * LORAT_L;
    _Float16* ST = (_Float16*)(a->ws + WS_STREAM); float* RV = (float*)(a->ws + WS_RV); float* RS = (float*)(a->ws + WS_RSCAL); float* RG = (float*)(a->ws + WS_RG); float* RB = (float*)(a->ws + WS_RBON);
    for (int hs = 0; hs < 2; ++hs) { const int hh = wv + 8 * hs;
        float inv[4] = {0.f, 0.f, 0.f, 0.f};
#pragma unroll
        for (int ct = 0; ct < 4; ++ct) { const int c = hh * 64 + ct * 16 + r16; const float kkw = a->in[I_RKK][l * DBR + c];
#pragma unroll
            for (int i = 0; i < 4; ++i) { const float kv = bf2f(RKV[(4 * q4 + i) * 3072 + 1024 + c]) * kkw; inv[i] += kv * kv; } }
#pragma unroll
        for (int i = 0; i < 4; ++i) inv[i] = 1.f / fmaxf(sqrtf(rowsum16(inv[i])), 1e-12f);
        float brp[2][4], krp[2][4], bd[4], vkeep[4][4];
#pragma unroll
        for (int i = 0; i < 4; ++i) { bd[i] = 0.f; brp[0][i] = 0.f; brp[1][i] = 0.f; krp[0][i] = 0.f; krp[1][i] = 0.f; }
#pragma unroll
        for (int ct = 0; ct < 4; ++ct) { const int cc = ct * 16 + r16, c = hh * 64 + cc;
            f32x4 accW[2], accA[2], accG = {0.f, 0.f, 0.f, 0.f};
#pragma unroll
            for (int d = 0; d < 2; ++d) { accW[d] = (f32x4){0.f, 0.f, 0.f, 0.f}; accA[d] = (f32x4){0.f, 0.f, 0.f, 0.f};
#pragma unroll
                for (int ks = 0; ks < 2; ++ks) {
                    accW[d] = mfma16(*(const LAS bf16x8*)(LI + r16 * PLD + d * 64 + 32 * ks + 8 * q4), *(const bf16x8*)(LT + ((size_t)d * 1024 + c) * 64 + 32 * ks + 8 * q4), accW[d]);
                    accA[d] = mfma16(*(const LAS bf16x8*)(LI + r16 * PLD + 128 + d * 64 + 32 * ks + 8 * q4), *(const bf16x8*)(LT + LORAT_A + ((size_t)d * 1024 + c) * 64 + 32 * ks + 8 * q4), accA[d]); } }
#pragma unroll
            for (int ks = 0; ks < 5; ++ks) accG = mfma16(*(const LAS bf16x8*)(LI + r16 * PLD + 256 + 32 * ks + 8 * q4), *(const bf16x8*)(LT + LORAT_G + (size_t)c * 160 + 32 * ks + 8 * q4), accG);
            const float kkw = a->in[I_RKK][l * DBR + c], ka_w = a->in[I_RKA][l * DBR + c], rk_w = a->in[I_RRK][l * DBR + c];
            const float w0a = a->in[I_RW0][(l * 2 + 0) * DBR + c], w0b = a->in[I_RW0][(l * 2 + 1) * DBR + c], a0a = a->in[I_RA0][(l * 2 + 0) * DBR + c], a0b = a->in[I_RA0][(l * 2 + 1) * DBR + c];
#pragma unroll
            for (int i = 0; i < 4; ++i) { const int t = 4 * q4 + i; const bool valid = t < PT; const int P = P0 + t;
                const float r = bf2f(RKV[t * 3072 + c]), k = bf2f(RKV[t * 3072 + 1024 + c]), v = bf2f(RKV[t * 3072 + 2048 + c]);
                const float kk = k * kkw * inv[i];
                float kd[2];
#pragma unroll
                for (int d = 0; d < 2; ++d) {
                    const float wdec = expf(-0.6065306597126334f * sigmoidf_((d ? w0b : w0a) + accW[d][i]));
                    const float ain = sigmoidf_((d ? a0b : a0a) + accA[d][i]);
                    kd[d] = k * (1.f + (ain - 1.f) * ka_w);
                    const float bb = kk * ain;
                    if (valid) { _Float16* sp = ST + ((((size_t)d * 16 + hh) * ROWS + P) * 5) * 64 + cc; sp[0] = (_Float16)wdec; sp[64] = (_Float16)bb; sp[128] = (_Float16)kd[d]; sp[192] = (_Float16)kk; sp[256] = (_Float16)(wdec * r); }
                    brp[d][i] += bb * r; krp[d][i] += kd[d] * r; }
                bd[i] += r * (kd[0] + kd[1]) * rk_w;
                if (valid) { RV[(size_t)P * DBR + c] = v; RG[(size_t)P * DBR + c] = accG[i]; }
                vkeep[ct][i] = v; } }
#pragma unroll
        for (int i = 0; i < 4; ++i) { const int t = 4 * q4 + i; const bool valid = t < PT; const int P = P0 + t;
#pragma unroll
            for (int d = 0; d < 2; ++d) { const float br = rowsum16(brp[d][i]), kr = rowsum16(krp[d][i]);
                if (valid && r16 == 0) { float* q = RS + (((size_t)d * 16 + hh) * ROWS + P) * 2; q[0] = br; q[1] = kr; } }
            const float bdt = rowsum16(bd[i]);
            if (valid) {
#pragma unroll
                for (int ct = 0; ct < 4; ++ct) RB[(size_t)P * DBR + hh * 64 + ct * 16 + r16] = bdt * vkeep[ct][i]; } }
    }
}
constexpr int RW_CH = 32, RW_ROWS = 16, RW_NLD = 256, RW_CHB = RW_CH * 1280 + RW_CH * RW_ROWS * 4 + RW_CH * 8;
DI int rw_stepP(int d, int n) { return d == 0 ? n : (n < CTX ? CTX - 1 - n : ROWS + CTX - 1 - n); }
struct RwRegs { f32x4 m[5]; float v[2], sc; };
DI void rw_issue(RwRegs& R, int c, int d, int lt, const _Float16* ST, const float* RV, const float* RS) {
    const int n0 = c * RW_CH; const int Pa = rw_stepP(d, n0), Pb = rw_stepP(d, n0 + RW_CH - 1); const int Pmin = Pa < Pb ? Pa : Pb;
    const f32x4* src = (const f32x4*)(ST + (size_t)Pmin * 320);
#pragma unroll
    for (int k = 0; k < 5; ++k) R.m[k] = src[lt + RW_NLD * k];
#pragma unroll
    for (int k = 0; k < 2; ++k) { const int i = lt + RW_NLD * k; R.v[k] = RV[(size_t)(Pmin + (i >> 4)) * DBR + (i & 15)]; }
    if (lt < RW_CH * 2) R.sc = RS[(size_t)Pmin * 2 + lt];
}
DI void rw_commit(const RwRegs& R, int c, int d, int lt, LAS unsigned char* lds) {
    LAS float* buf = (LAS float*)(lds + (c % 3) * RW_CHB);
    const bool desc = d != 0;
#pragma unroll
    for (int k = 0; k < 5; ++k) { const int i = lt + RW_NLD * k, st = i / 40, w = i - 40 * st; const f16x8 h = __builtin_bit_cast(f16x8, R.m[k]);
        LAS float* q = buf + (desc ? RW_CH - 1 - st : st) * 320 + 8 * w;
        *(LAS f32x4*)q = (f32x4){(float)h[0], (float)h[1], (float)h[2], (float)h[3]}; *(LAS f32x4*)(q + 4) = (f32x4){(float)h[4], (float)h[5], (float)h[6], (float)h[7]}; }
#pragma unroll
    for (int k = 0; k < 2; ++k) { const int i = lt + RW_NLD * k, st = i >> 4; buf[RW_CH * 320 + (desc ? RW_CH - 1 - st : st) * RW_ROWS + (i & 15)] = R.v[k]; }
    if (lt < RW_CH * 2) { const int st = lt >> 1; buf[RW_CH * 320 + RW_CH * RW_ROWS + (desc ? RW_CH - 1 - st : st) * 2 + (lt & 1)] = R.sc; }
}
DI void rwkv_scan(AP a, int item, LAS unsigned char* lds) {
    const int tid = otid(), lane = tid & 63, wv = tid >> 6;
    const int hd = item >> 2, d = hd >> 4, hh = hd & 15, rb = item & 3;
    const _Float16* ST = (const _Float16*)(a->ws + WS_STREAM) + (((size_t)d * 16 + hh) * ROWS) * 320;
    const float* RV = (const float*)(a->ws + WS_RV) + hh * 64 + rb * RW_ROWS; const float* RS = (const float*)(a->ws + WS_RSCAL) + (((size_t)d * 16 + hh) * ROWS) * 2;
    float* RY = (float*)(a->ws + WS_RY) + (size_t)d * ROWS * DBR + hh * 64 + rb * RW_ROWS;
    constexpr int NCHUNK = ROWS / RW_CH;
    __syncthreads();
    RwRegs R; const int lt = tid - 256;
    if (wv >= 4) { rw_issue(R, 0, d, lt, ST, RV, RS); rw_commit(R, 0, d, lt, lds); rw_issue(R, 1, d, lt, ST, RV, RS); rw_commit(R, 1, d, lt, lds); rw_issue(R, 2, d, lt, ST, RV, RS); }
    __syncthreads();
    f32x4 S = {0.f, 0.f, 0.f, 0.f};
    const int jg = lane & 15, rg = lane >> 4, vrow = wv * 4 + rg;
    for (int c = 0; c < NCHUNK; ++c) {
        if (wv >= 4) { if (c + 2 < NCHUNK) rw_commit(R, c + 2, d, lt, lds); if (c + 3 < NCHUNK) rw_issue(R, c + 3, d, lt, ST, RV, RS); }
        else {
            const LAS float* buf = (const LAS float*)(lds + (c % 3) * RW_CHB);
            const int n0 = c * RW_CH; const int Pa = rw_stepP(d, n0); const bool desc = rw_stepP(d, n0 + RW_CH - 1) < Pa; const int Pmin = desc ? Pa - (RW_CH - 1) : Pa;
#define RW_LD(st_, W4, B4, K4, KK4, WR4, V, SC) do { const LAS float* sb_ = buf + (st_) * 320 + 4 * jg; \
                W4 = *(const LAS f32x4*)(sb_); B4 = *(const LAS f32x4*)(sb_ + 64); K4 = *(const LAS f32x4*)(sb_ + 128); KK4 = *(const LAS f32x4*)(sb_ + 192); WR4 = *(const LAS f32x4*)(sb_ + 256); \
                V = buf[RW_CH * 320 + (st_) * RW_ROWS + vrow]; SC = *(const LAS f32x2*)(buf + RW_CH * 320 + RW_CH * RW_ROWS + (st_) * 2); } while (0)
#define RW_STEP(st_, W4, B4, K4, KK4, WR4, V, SC) do { \
                const f32x2 slo_ = {S[0], S[1]}, shi_ = {S[2], S[3]}; \
                const f32x2 da_ = slo_ * (f32x2){KK4[0], KK4[1]} + shi_ * (f32x2){KK4[2], KK4[3]}, dy_ = slo_ * (f32x2){WR4[0], WR4[1]} + shi_ * (f32x2){WR4[2], WR4[3]}; \
                const f32x4 t_ = S * W4 + K4 * V;                   \
                float pa_ = da_.x + da_.y, py_ = dy_.x + dy_.y; \
                pa_ = rowsum16(pa_); py_ = rowsum16(py_); const float y_ = py_ - pa_ * SC.x + V * SC.y; \
                S = t_ - B4 * pa_; ykeep = (jg == ((st_) & 15)) ? y_ : ykeep; } while (0)
            f32x4 wA, bA, kA, kkA, wrA, wB, bB, kB, kkB, wrB; float vA, vB; f32x2 scA, scB; float ykeep = 0.f;
            RW_LD(0, wA, bA, kA, kkA, wrA, vA, scA);
#pragma unroll
            for (int s = 0; s < RW_CH; s += 2) {
                RW_LD(s + 1, wB, bB, kB, kkB, wrB, vB, scB);
                RW_STEP(s, wA, bA, kA, kkA, wrA, vA, scA);
                if (s + 2 < RW_CH) RW_LD(s + 2, wA, bA, kA, kkA, wrA, vA, scA);
                RW_STEP(s + 1, wB, bB, kB, kkB, wrB, vB, scB);
                if ((s & 15) == 14) { const int st_l = (s & 16) + jg; const int ls_l = desc ? RW_CH - 1 - st_l : st_l; RY[(size_t)(Pmin + ls_l) * DBR + vrow] = ykeep; }
            }
#undef RW_LD
#undef RW_STEP
        }
        __syncthreads();
    }
}
DI void phase_mixer_post(AP a, int l, int bid, int G) {
    const int tid = otid(), lane = tid & 63, wave = tid >> 6;
    bf16* YS = (bf16*)(a->ws + WS_YS);
    const float* HD = (const float*)(a->ws + WS_HDIR); const bf16* ZA = (const bf16*)(a->ws + WS_ZA); const float* mn = a->in[I_MNORM] + (size_t)l * DBR;
    const bool lastl = (l == NL - 1);
    if (EN_MLSTM) for (int row = bid * NWAVES + wave; row < (lastl ? SEQ : ROWS); row += G * NWAVES) {
        const int c0 = lane * 16; f32x4 y[4]; float ss = 0.f;
#pragma unroll
        for (int e = 0; e < 4; ++e) { y[e] = *(const f32x4*)(HD + (size_t)row * DBR + c0 + 4 * e) + *(const f32x4*)(HD + (size_t)(ROWS + row) * DBR + c0 + 4 * e); ss += y[e][0] * y[e][0] + y[e][1] * y[e][1] + y[e][2] * y[e][2] + y[e][3] * y[e][3]; }
        ss += __shfl_xor(ss, 1); ss += __shfl_xor(ss, 2); ss += __shfl_xor(ss, 4);
        const float rs = rsqrtf(ss * (1.f / 128.f) + NORM_EPS);
        const u32x4 o0 = *(const u32x4*)(ZA + (size_t)row * NA_P + 2048 + c0), o1 = *(const u32x4*)(ZA + (size_t)row * NA_P + 2048 + c0 + 8);
        const unsigned ow[8] = {o0.x, o0.y, o0.z, o0.w, o1.x, o1.y, o1.z, o1.w};
        f32x4 r[4];
#pragma unroll
        for (int e = 0; e < 4; ++e) { const f32x4 g = *(const f32x4*)(mn + c0 + 4 * e);
            r[e][0] = y[e][0] * rs * g[0] * sigmoidf_(__uint_as_float(ow[2 * e] << 16)); r[e][1] = y[e][1] * rs * g[1] * sigmoidf_(__uint_as_float(ow[2 * e] & 0xffff0000u));
            r[e][2] = y[e][2] * rs * g[2] * sigmoidf_(__uint_as_float(ow[2 * e + 1] << 16)); r[e][3] = y[e][3] * rs * g[3] * sigmoidf_(__uint_as_float(ow[2 * e + 1] & 0xffff0000u)); }
        { u32x4 w; w.x = pk4_fp8(r[0][0] * 8.f, r[0][1] * 8.f, r[0][2] * 8.f, r[0][3] * 8.f); w.y = pk4_fp8(r[1][0] * 8.f, r[1][1] * 8.f, r[1][2] * 8.f, r[1][3] * 8.f);
          w.z = pk4_fp8(r[2][0] * 8.f, r[2][1] * 8.f, r[2][2] * 8.f, r[2][3] * 8.f); w.w = pk4_fp8(r[3][0] * 8.f, r[3][1] * 8.f, r[3][2] * 8.f, r[3][3] * 8.f);
          *(u32x4*)(a->ws + WS_YS8 + (size_t)row * DBR + c0) = w; }
    }
    const float* RY = (const float*)(a->ws + WS_RY); const float* RG = (const float*)(a->ws + WS_RG); const float* RB = (const float*)(a->ws + WS_RBON);
    const float* lw = a->in[I_RLNW] + (size_t)l * DBR; const float* lb = a->in[I_RLNB] + (size_t)l * DBR;
    bf16* YR = YS + (size_t)2 * ROWS * DBR;
    if (EN_RWKV) for (int P = (lastl ? CTX : 0) + bid * NWAVES + wave; P < ROWS; P += G * NWAVES) {
        const int c0 = lane * 16; f32x4 y[4]; float sm = 0.f;
#pragma unroll
        for (int e = 0; e < 4; ++e) { y[e] = *(const f32x4*)(RY + (size_t)P * DBR + c0 + 4 * e) + *(const f32x4*)(RY + (size_t)(ROWS + P) * DBR + c0 + 4 * e); sm += y[e][0] + y[e][1] + y[e][2] + y[e][3]; }
        sm += __shfl_xor(sm, 1); sm += __shfl_xor(sm, 2);
        const float mean = sm * (1.f / 64.f); float sv = 0.f;
#pragma unroll
        for (int e = 0; e < 4; ++e) { y[e] = y[e] - mean; sv += y[e][0] * y[e][0] + y[e][1] * y[e][1] + y[e][2] * y[e][2] + y[e][3] * y[e][3]; }
        sv += __shfl_xor(sv, 1); sv += __shfl_xor(sv, 2);
        const float rs = rsqrtf(sv * (1.f / 64.f) + 64e-5f);
        f32x4 r[4];
#pragma unroll
        for (int e = 0; e < 4; ++e) r[e] = (y[e] * rs * *(const f32x4*)(lw + c0 + 4 * e) + *(const f32x4*)(lb + c0 + 4 * e) + *(const f32x4*)(RB + (size_t)P * DBR + c0 + 4 * e)) * *(const f32x4*)(RG + (size_t)P * DBR + c0 + 4 * e);
        const int row = rw_row(P);
        { u32x4 w; w.x = pk4_fp8(r[0][0] * 8.f, r[0][1] * 8.f, r[0][2] * 8.f, r[0][3] * 8.f); w.y = pk4_fp8(r[1][0] * 8.f, r[1][1] * 8.f, r[1][2] * 8.f, r[1][3] * 8.f);
          w.z = pk4_fp8(r[2][0] * 8.f, r[2][1] * 8.f, r[2][2] * 8.f, r[2][3] * 8.f); w.w = pk4_fp8(r[3][0] * 8.f, r[3][1] * 8.f, r[3][2] * 8.f, r[3][3] * 8.f);
          *(u32x4*)(a->ws + WS_YS8 + ((size_t)ROWS + row) * DBR + c0) = w; }
    }
}

DI void phase_moe_route(AP a, int l, LAS unsigned char* lds, int bid, int G) {
    const int tid = otid(), lane = tid & 63, wave = tid >> 6, r = lane & 15, q = lane >> 4;
    const bf16* XR = (const bf16*)(a->ws + WS_XRES); bf16* H = (bf16*)(a->ws + WS_H);
    const float* gn = a->in[I_NMOE] + (size_t)l * D; const float* WRT = (const float*)(a->ws + WS_WRT) + (size_t)l * NEXP * D;
    int* EIDX = (int*)(a->ws + WS_MOE + MOE_EIDX); float* EW = (float*)(a->ws + WS_MOE + MOE_EW); int* SLOTTOK = (int*)(a->ws + WS_MOE + MOE_SLOTTOK);
    LAS int* hist = (LAS int*)(lds + 8 * 2304);
    __syncthreads();
    if (tid < NEXP) hist[tid] = 0;
    __syncthreads();
    for (int i = bid * NTHR + tid; i < NSLOT; i += G * NTHR) SLOTTOK[i] = 0;
    LAS float* lg = (LAS float*)(lds + wave * 2304);
    LAS float* ssp = (LAS float*)(lds + 8 * 2304 + 256);
    const int qd = wave >> 2, part = wave & 3, jj0 = 32 * part;
    const int nrg = (l == NL - 1) ? SEQ / 16 : ROWS / 16;
    for (int rg0 = bid * 2; rg0 < nrg; rg0 += G * 2) {
        const int rg = rg0 + qd; const bool act = rg < nrg;
        const int row = (act ? rg : 0) * 16 + r; const int isc = row >= SEQ;
        const bf16* xr = XR + (size_t)row * D + 8 * q;
        const float* mod = (const float*)(a->ws + WS_MOD) + ((size_t)l * 2 + isc) * 6 * D + 3 * D;
        float ss = 0.f;
        if (act) {
#pragma unroll 4
            for (int jj = jj0; jj < jj0 + 32; ++jj) { f32x4 x0, x1; unpack8(*(const u32x4*)(xr + 32 * jj), x0, x1);
                ss += x0[0] * x0[0] + x0[1] * x0[1] + x0[2] * x0[2] + x0[3] * x0[3] + x1[0] * x1[0] + x1[1] * x1[1] + x1[2] * x1[2] + x1[3] * x1[3]; } }
        ss += __shfl_xor(ss, 16); ss += __shfl_xor(ss, 32);
        if (lane < 16) ssp[wave * 16 + lane] = ss;
        __syncthreads();
        ss = ssp[(qd * 4 + 0) * 16 + r] + ssp[(qd * 4 + 1) * 16 + r] + ssp[(qd * 4 + 2) * 16 + r] + ssp[(qd * 4 + 3) * 16 + r];
        const float rs = rsqrtf(ss * (1.f / D) + NORM_EPS);
        f32x4 acc0 = {0.f, 0.f, 0.f, 0.f}, acc1 = {0.f, 0.f, 0.f, 0.f};
        if (act) {
#pragma unroll 2
            for (int jj = jj0; jj < jj0 + 32; ++jj) { const int c = 32 * jj + 8 * q;
                f32x4 hv[2], xx[2]; unpack8(*(const u32x4*)(xr + 32 * jj), xx[0], xx[1]);
#pragma unroll
                for (int e = 0; e < 2; ++e) { const f32x4 x = xx[e], g = *(const f32x4*)(gn + c + 4 * e), sh = *(const f32x4*)(mod + c + 4 * e), sc = *(const f32x4*)(mod + D + c + 4 * e);
                    hv[e] = (x * rs) * g * (sc + 1.f) + sh; }
                { u32x2 h8; h8.x = pk4_fp8(hv[0][0] * 4.f, hv[0][1] * 4.f, hv[0][2] * 4.f, hv[0][3] * 4.f); h8.y = pk4_fp8(hv[1][0] * 4.f, hv[1][1] * 4.f, hv[1][2] * 4.f, hv[1][3] * 4.f);
                  *(u32x2*)((unsigned char*)H + (size_t)row * D + c) = h8; }
                const f32x4 wa0 = *(const f32x4*)(WRT + (size_t)r * D + c), wa1 = *(const f32x4*)(WRT + (size_t)r * D + c + 4), wb0 = *(const f32x4*)(WRT + (size_t)(16 + r) * D + c), wb1 = *(const f32x4*)(WRT + (size_t)(16 + r) * D + c + 4);
#pragma unroll
                for (int e = 0; e < 4; ++e) { acc0 = __builtin_amdgcn_mfma_f32_16x16x4f32(hv[0][e], wa0[e], acc0, 0, 0, 0); acc1 = __builtin_amdgcn_mfma_f32_16x16x4f32(hv[0][e], wb0[e], acc1, 0, 0, 0); }
#pragma unroll
                for (int e = 0; e < 4; ++e) { acc0 = __builtin_amdgcn_mfma_f32_16x16x4f32(hv[1][e], wa1[e], acc0, 0, 0, 0); acc1 = __builtin_amdgcn_mfma_f32_16x16x4f32(hv[1][e], wb1[e], acc1, 0, 0, 0); } } }
#pragma unroll
        for (int i = 0; i < 4; ++i) { lg[(4 * q + i) * 36 + r] = acc0[i]; lg[(4 * q + i) * 36 + 16 + r] = acc1[i]; }
        __syncthreads();
        if (act && part == 0 && lane < 16) { float v[NEXP];
            const LAS float* l0 = (const LAS float*)(lds + (qd * 4) * 2304) + lane * 36;
#pragma unroll
            for (int e = 0; e < NEXP; ++e) v[e] = ((l0[e] + l0[576 + e]) + (l0[1152 + e] + l0[1728 + e])) + a->in[I_RTB][l * NEXP + e];
            int bi[4]; float bv[4];
#pragma unroll
            for (int k = 0; k < 4; ++k) { float best = -3.0e38f; int be = 0;
#pragma unroll
                for (int e = 0; e < NEXP; ++e) { const bool taken = (k > 0 && bi[0] == e) || (k > 1 && bi[1] == e) || (k > 2 && bi[2] == e); if (!taken && v[e] > best) { best = v[e]; be = e; } }
                bi[k] = be; bv[k] = best; }
            const float e1 = __expf(bv[1] - bv[0]), e2 = __expf(bv[2] - bv[0]), e3 = __expf(bv[3] - bv[0]); const float inv = 1.f / (1.f + e1 + e2 + e3);
            const int rr = rg * 16 + lane;
            *(int4*)(EIDX + (size_t)rr * 4) = make_int4(bi[0], bi[1], bi[2], bi[3]);
            *(f32x4*)(EW + (size_t)rr * 4) = (f32x4){inv, e1 * inv, e2 * inv, e3 * inv};
#pragma unroll
            for (int k = 0; k < 4; ++k) __hip_atomic_fetch_add(hist + bi[k], 1, __ATOMIC_RELAXED, __HIP_MEMORY_SCOPE_WORKGROUP); }
        __syncthreads();
    }
    __syncthreads();
    if (tid < NEXP) ((int*)(a->ws + WS_MOE + MOE_CNTW))[bid * NEXP + tid] = hist[tid];
}
DI void phase_moe_slots(AP a, int l, LAS unsigned char* lds, int bid, int G) {
    const int tid = otid();
    LAS int* red = (LAS int*)lds;
    LAS int* base = red + 1024;
    LAS int* lc = base + 32;
    const int* CNTW = (const int*)(a->ws + WS_MOE + MOE_CNTW);
    const int* EIDX = (const int*)(a->ws + WS_MOE + MOE_EIDX); int* TOKSLOT = (int*)(a->ws + WS_MOE + MOE_TOKSLOT); int* SLOTTOK = (int*)(a->ws + WS_MOE + MOE_SLOTTOK); int* TILEE = (int*)(a->ws + WS_MOE + MOE_TILEE);
    __syncthreads();
    { const int e = tid & 31, part = tid >> 5; int tot = 0, pre = 0;
      for (int b = part; b < G; b += 16) { const int c = CNTW[b * NEXP + e]; tot += c; pre += (b < bid) ? c : 0; }
      red[part * 32 + e] = tot; red[512 + part * 32 + e] = pre; }
    __syncthreads();
    if (tid < NEXP) { int tot = 0, pre = 0;
#pragma unroll
        for (int p2 = 0; p2 < 16; ++p2) { tot += red[p2 * 32 + tid]; pre += red[512 + p2 * 32 + tid]; }
        red[tid] = tot; red[512 + tid] = pre; }
    __syncthreads();
    if (tid == 0) { int acc = 0; for (int e = 0; e < NEXP; ++e) { base[e] = acc * 256 + red[512 + e]; lc[e] = 0; const int nt = (red[e] + 255) >> 8; if (bid == 0) for (int t = 0; t < nt; ++t) TILEE[1 + acc + t] = e; acc += nt; } if (bid == 0) TILEE[0] = acc; }
    __syncthreads();
    const int nrg = (l == NL - 1) ? SEQ / 16 : ROWS / 16;
    for (int rg0 = bid * 2; rg0 < nrg; rg0 += G * 2) {
        const int rg = rg0 + (tid >> 6); if ((tid >> 6) < 2 && rg < nrg) { const int i = rg * 64 + (tid & 63); const int e = EIDX[i];
            const int slot = base[e] + __hip_atomic_fetch_add(lc + e, 1, __ATOMIC_RELAXED, __HIP_MEMORY_SCOPE_WORKGROUP); TOKSLOT[i] = slot; SLOTTOK[slot] = i >> 2; } }
}
struct MoeGU {
    static constexpr bool GATHER = true, FP8 = true;
    int K, G, c, ntile; const char* Hb; const char* Wb; const int* SLOTTOK; const int* TILEE; const float* bgu; unsigned char* ACT;
    DI bool next(int i, Unit& u) const { const long L = (long)i * G + c; if (L >= (long)ntile * 4) return false; u.pm = (int)(L >> 2); u.pn = (int)(L & 3); u.aux = TILEE[1 + u.pm]; return true; }
    DI const char* a_ptr(const Unit&) const { return Hb; }
    DI const char* b_ptr(const Unit& u) const { return Wb + ((size_t)u.aux * 1024 + (size_t)u.pn * 256) * D; }
    DI unsigned a_row_off(const Unit& u, int r) const { return (unsigned)SLOTTOK[u.pm * 256 + r] * (unsigned)D; }
    DI void epi(const f32x4 (&acc)[2][2][4][2], const Unit& u, int wr, int wc, int fr, int fq) const {
        const float* bb = bgu + (size_t)u.aux * 1024 + u.pn * 256;
        f32x4 bv[2][2];
        _Pragma("unroll") for (int bj = 0; bj < 2; ++bj) { const int cl = bj * 128 + wc * 32 + 8 * fq; bv[bj][0] = *(const f32x4*)(bb + cl); bv[bj][1] = *(const f32x4*)(bb + cl + 4); }
        EPI_LOOP({ const f32x4 x0 = v0 * (1.f / 2048.f) + bv[bj][0], x1 = v1 * (1.f / 2048.f) + bv[bj][1];
                   float o[4];
                   _Pragma("unroll") for (int e = 0; e < 4; ++e) { const float gv = e < 2 ? x0[2 * e] : x1[2 * (e - 2)], lv = e < 2 ? x0[2 * e + 1] : x1[2 * (e - 2) + 1];
                       const float glu = fminf(gv, 7.f), lin = fminf(fmaxf(lv, -7.f), 7.f); o[e] = glu * sigmoidf_(1.702f * glu) * (lin + 1.f); }
                   *(unsigned*)(ACT + (size_t)(u.pm * 256 + rl) * DEXP + (u.pn * 256 + cl) / 2) = pk4_fp8(o[0] * 4.f, o[1] * 4.f, o[2] * 4.f, o[3] * 4.f); })
    }
};
struct MoeDown {
    static constexpr bool GATHER = false, FP8 = true;
    int K, G, c, ntile; const char* Ab; const char* Wb; const int* TILEE; const float* bdn; unsigned char* YSLOT;
    DI bool next(int i, Unit& u) const { const long L = (long)i * G + c; if (L >= (long)ntile * 16) return false; u.pm = (int)(L >> 4); u.pn = (int)(L & 15); u.aux = TILEE[1 + u.pm]; return true; }
    DI const char* a_ptr(const Unit& u) const { return Ab + (size_t)u.pm * 256 * DEXP; }
    DI const char* b_ptr(const Unit& u) const { return Wb + ((size_t)u.aux * D + (size_t)u.pn * 256) * DEXP; }
    DI unsigned a_row_off(const Unit&, int) const { return 0u; }
    DI void epi(const f32x4 (&acc)[2][2][4][2], const Unit& u, int wr, int wc, int fr, int fq) const {
        const float* bb = bdn + (size_t)u.aux * D + u.pn * 256;
        f32x4 bv[2][2];
        _Pragma("unroll") for (int bj = 0; bj < 2; ++bj) { const int cl = bj * 128 + wc * 32 + 8 * fq; bv[bj][0] = *(const f32x4*)(bb + cl); bv[bj][1] = *(const f32x4*)(bb + cl + 4); }
        EPI_LOOP({ const f32x4 y0 = (v0 * (1.f / 1024.f) + bv[bj][0]) * 8.f, y1 = (v1 * (1.f / 1024.f) + bv[bj][1]) * 8.f;
                   u32x2 w; w.x = pk4_fp8(y0[0], y0[1], y0[2], y0[3]); w.y = pk4_fp8(y1[0], y1[1], y1[2], y1[3]);
                   *(u32x2*)(YSLOT + (size_t)(u.pm * 256 + rl) * D + u.pn * 256 + cl) = w; })
    }
};
DI void phase_moe_combine(AP a, int l, LAS unsigned char* lds, int bid, int G) {
    const int tid = otid(), lane = tid & 63, wave = tid >> 6;
    LAS float* xrow = (LAS float*)(lds + wave * 16384);
    bf16* XR = (bf16*)(a->ws + WS_XRES); const unsigned char* YSLOT = a->ws + WS_YSLOT; bf16* H = (bf16*)(a->ws + WS_H);
    const int* TOKSLOT = (const int*)(a->ws + WS_MOE + MOE_TOKSLOT); const float* EW = (const float*)(a->ws + WS_MOE + MOE_EW);
    const bool last = (l == NL - 1); const int nrows = last ? SEQ : ROWS;
    const float* gn = last ? a->in[I_NFIN] : a->in[I_NMIX] + (size_t)(l + 1) * D;
    for (int row = bid * NWAVES + wave; row < nrows; row += G * NWAVES) {
        const int isc = row >= SEQ;
        const float* g2 = (const float*)(a->ws + WS_MOD) + ((size_t)l * 2 + isc) * 6 * D + 5 * D;
        const float* modn = (const float*)(a->ws + WS_MOD) + ((size_t)(last ? l : l + 1) * 2 + isc) * 6 * D;
        const int4 sl = *(const int4*)(TOKSLOT + (size_t)row * 4); const f32x4 ww = *(const f32x4*)(EW + (size_t)row * 4);
        const int sls[4] = {sl.x, sl.y, sl.z, sl.w};
        float ss = 0.f;
#pragma unroll 1
        for (int jb = 0; jb < 4; ++jb) {
            u32x2 y[2][4]; u32x4 xr[2]; f32x4 ga[2], gb[2];
#pragma unroll
            for (int jj = 0; jj < 2; ++jj) { const int c = 8 * (lane + 64 * (2 * jb + jj));
#pragma unroll
                for (int k = 0; k < 4; ++k) y[jj][k] = *(const u32x2*)(YSLOT + (size_t)sls[k] * D + c);
                xr[jj] = *(const u32x4*)(XR + (size_t)row * D + c); ga[jj] = *(const f32x4*)(g2 + c); gb[jj] = *(const f32x4*)(g2 + c + 4); }
#pragma unroll
            for (int jj = 0; jj < 2; ++jj) { const int j = 2 * jb + jj; const int c = 8 * (lane + 64 * j);
                f32x4 s0 = {0.f, 0.f, 0.f, 0.f}, s1 = {0.f, 0.f, 0.f, 0.f};
#pragma unroll
                for (int k = 0; k < 4; ++k) { const u32x2 yy = y[jj][k]; const float wk = ww[k] * 0.125f;
                    const f32x2 a0 = __builtin_amdgcn_cvt_pk_f32_fp8((int)yy.x, false), a1 = __builtin_amdgcn_cvt_pk_f32_fp8((int)yy.x, true), a2 = __builtin_amdgcn_cvt_pk_f32_fp8((int)yy.y, false), a3 = __builtin_amdgcn_cvt_pk_f32_fp8((int)yy.y, true);
                    s0[0] += wk * a0.x; s0[1] += wk * a0.y; s0[2] += wk * a1.x; s0[3] += wk * a1.y; s1[0] += wk * a2.x; s1[1] += wk * a2.y; s1[2] += wk * a3.x; s1[3] += wk * a3.y; }
                f32x4 xa, xb; unpack8(xr[jj], xa, xb);
                const f32x4 x0 = xa + ga[jj] * s0, x1 = xb + gb[jj] * s1;
                *(LAS f32x4*)(xrow + c) = x0; *(LAS f32x4*)(xrow + c + 4) = x1;
                if (!last) *(u32x4*)(XR + (size_t)row * D + c) = pack8(x0, x1);
                ss += x0[0] * x0[0] + x0[1] * x0[1] + x0[2] * x0[2] + x0[3] * x0[3] + x1[0] * x1[0] + x1[1] * x1[1] + x1[2] * x1[2] + x1[3] * x1[3]; }
        }
        const float rs = rsqrtf(wave_sum(ss) * (1.f / D) + NORM_EPS);
#pragma unroll 1
        for (int jb = 0; jb < 4; ++jb) {
            f32x4 g0[2], g1[2], sh0[2], sh1[2], sc0[2], sc1[2];
#pragma unroll
            for (int jj = 0; jj < 2; ++jj) { const int c = 8 * (lane + 64 * (2 * jb + jj));
                g0[jj] = *(const f32x4*)(gn + c); g1[jj] = *(const f32x4*)(gn + c + 4);
                if (!last) { sh0[jj] = *(const f32x4*)(modn + c); sh1[jj] = *(const f32x4*)(modn + c + 4); sc0[jj] = *(const f32x4*)(modn + D + c); sc1[jj] = *(const f32x4*)(modn + D + c + 4); } }
#pragma unroll
            for (int jj = 0; jj < 2; ++jj) { const int j = 2 * jb + jj; const int c = 8 * (lane + 64 * j);
                const f32x4 x0 = *(const LAS f32x4*)(xrow + c), x1 = *(const LAS f32x4*)(xrow + c + 4);
                if (last) { *(f32x4*)(a->out + (size_t)row * D + c) = (x0 * rs) * g0[jj]; *(f32x4*)(a->out + (size_t)row * D + c + 4) = (x1 * rs) * g1[jj]; }
                else { const f32x4 h0 = (x0 * rs) * g0[jj] * (sc0[jj] + 1.f) + sh0[jj], h1 = (x1 * rs) * g1[jj] * (sc1[jj] + 1.f) + sh1[jj];
                    *(u32x4*)(H + (size_t)row * D + c) = pack8(h0, h1);
                    u32x2 h8; h8.x = pk4_fp8(h0[0] * 4.f, h0[1] * 4.f, h0[2] * 4.f, h0[3] * 4.f); h8.y = pk4_fp8(h1[0] * 4.f, h1[1] * 4.f, h1[2] * 4.f, h1[3] * 4.f);
                    *(u32x2*)(a->ws + WS_H8 + (size_t)row * D + c) = h8; } }
        }
    }
}

__global__ void __launch_bounds__(NTHR, 2) mk_fwd(Args a_by_value) {
    AP a0 = (AP)__builtin_amdgcn_kernarg_segment_ptr();
    extern __shared__ __attribute__((aligned(16))) unsigned char lds_raw[];
    LAS unsigned char* lds = (LAS unsigned char*)lds_raw;
    volatile LAS unsigned* MISC = (volatile LAS unsigned*)(lds + MISC_OFF);
    const int tid = threadIdx.x, G = gridDim.x, bid = blockIdx.x;
    unsigned char* ws = a0->ws; const int ph_lo = a0->ph_lo, ph_hi = a0->ph_hi;
    for (int u = tid; u < (LDS_SMALL - LDSCTL_OFF) / 4; u += NTHR) ((LAS unsigned*)(lds + LDSCTL_OFF))[u] = 0u;
    __syncthreads();
    XcdBarrier bar; bar.bar = (unsigned*)(ws + WS_CTL) + 4096; bar.x = 0; bar.st = nullptr;
    if (!MK_MULTI) bar = xcd_barrier_post((unsigned*)(ws + WS_CTL) + 4096, MISC + 8);
    int ph = 0;
#ifndef PHMASK
#define PHMASK 0xffffffffu
#endif
#define PH(id, ...) { if (((PHMASK >> (id)) & 1u) && ph >= ph_lo && ph < ph_hi) { AP a = a0; asm volatile("" : "+s"(a)); unsigned char* ws = a->ws; __VA_ARGS__ } ++ph; if (!MK_MULTI) { XcdBarrier bb = bar; asm volatile("" : "+s"(bb.bar), "+s"(bb.x)); xcd_barrier(bb); } }

    PH(0, phase_prologue(a, lds, bid, G);)
    PH(1, phase_mod_reduce(a, bid, G);)
#define LAYER(l) \
        PH(2, if (l == 0 || !EN_MOE) phase_norm_mod(a, l, 0, l == 0, bid, G);) \
        PH(3, { \
            const bool lastl = (l == NL - 1); \
            InProj8 P; P.K = D; P.G = G; P.c = bid; P.lastl = lastl; P.Hb = (const char*)(ws + WS_H8); P.Wb = (const char*)(ws + WS_WIN8 + l * WIN8_L); \
            P.ZA = (bf16*)(ws + WS_ZA); P.GATES = (float*)(ws + WS_GATES); P.ZC = (bf16*)(ws + WS_ZC); P.SGp = (bf16*)(ws + WS_SG); \
            pg8::gemm_phase(lds, P); \
            const int u8 = lastl ? (NPAN - 1) * TF8 + TAC : NPAN * TF8;             \
            InProj16 Q; Q.K = D; Q.G = G; Q.c = (bid - u8 % G + G) % G; Q.nM = lastl ? NPAN - 1 : NPAN; Q.Hb = (const char*)(ws + WS_H); Q.Wb = (const char*)(ws + WS_WIN + l * WIN_L); \
            Q.ZBT = (float*)(ws + WS_ZBT); Q.SGp = (bf16*)(ws + WS_SG); \
            pg8::gemm_phase(lds, Q); }) \
        PH(4, { if (EN_RWKV) for (int it = bid; it < ROWS / PT; it += G) rwkv_prep_item(a, l, it, lds); }) \
        PH(5, { \
            if (G >= 192) { \
                if (bid < 128) { if (EN_RWKV) rwkv_scan(a, bid, lds); } \
                else if (bid < 144) { if (EN_MLSTM) mlstm_scan(a, l, (bid - 128) & 7, (bid - 128) >> 3, lds); } \
            } else { \
                if (EN_RWKV) for (int it = bid; it < 128; it += G) rwkv_scan(a, it, lds); \
                if (EN_MLSTM) for (int hdx = bid; hdx < 16; hdx += G) mlstm_scan(a, l, hdx & 7, hdx >> 3, lds); \
            } \
            { unsigned* hq = (unsigned*)(ws + WS_CTL) + CW_HQ + 64 * l; LAS int* qs = (LAS int*)(lds + LDS_SMALL + 2048); \
              for (;;) { __syncthreads(); if (threadIdx.x == 0) qs[0] = (int)__hip_atomic_fetch_add(hq, 1u, __ATOMIC_RELAXED, __HIP_MEMORY_SCOPE_AGENT); __syncthreads(); \
                  int it = qs[0]; \
                  {                          \
                      if (it < (CVQ_R + 1) * cvq_q(l)) { const int q = it / (CVQ_R + 1), r = it - q * (CVQ_R + 1); \
                          if (r != 0) { const int cc = CVQ_R * q + r - 1; if (cc < cvq_nch(l)) conv_chunk(a, cc, lds, l); continue; } \
                          it = q; } \
                      else it = cvq_q(l) + (it - (CVQ_R + 1) * cvq_q(l)); } \
                  if (it >= ((l == NL - 1) ? DBR : 2 * DBR)) break; \
                  const int seq = it >= DBR, ch = it & (DBR - 1); hyena_item(a, l, ch, seq, lds, ws + WS_HSCR + (size_t)bid * HSCR_WG); } } }) \
        PH(6, { phase_mixer_post(a, l, bid, G); phase_yb_transpose(a, lds, bid, G, (l == NL - 1) ? SEQ / 64 : ROWS / 64); }) \
        PH(7, { \
            const int nMb = (l == NL - 1) ? NPAN - 1 : NPAN; \
            BranchProj8 P; P.K = DBR; P.G = G; P.c = bid; P.nM = nMb; P.YS = (const char*)(ws + WS_YS8); P.Wb = (const char*)(ws + WS_WBR8 + (size_t)l * 2 * D * DBR); \
            P.SGp = (const bf16*)(ws + WS_SG); P.M32 = (bf16*)(ws + WS_MERGED); \
            pg8::gemm_phase(lds, P); \
            BranchProj16 Q; Q.K = DBR; Q.G = G; Q.c = bid; Q.nM = nMb; Q.YS = (const char*)(ws + WS_YS); Q.Wb = (const char*)(ws + WS_WBR + l * WBR_L); \
            Q.SGp = (const bf16*)(ws + WS_SG); Q.M32 = (const bf16*)(ws + WS_MERGED); Q.MERGED = (bf16*)(ws + WS_MERGED); \
            pg8::gemm_phase(lds, Q); }) \
        PH(8, { \
            OutProj P; P.K = D; P.G = G; P.c = bid; P.nM = (l == NL - 1) ? NPAN - 1 : NPAN; P.Ab = (const char*)(ws + WS_MERGED); P.Wb = (const char*)(ws + WS_WOUT + l * WOUT_L); \
            P.XR = (bf16*)(ws + WS_XRES); P.gate = (const float*)(ws + WS_MOD) + (size_t)l * 2 * 6 * D + 2 * D; P.xin = (l == 0) ? a->in[I_X] : nullptr; P.cin = (l == 0) ? a->in[I_CTX] : nullptr; \
            pg8::gemm_phase(lds, P); }) \
        PH(9, if (EN_MOE) phase_moe_route(a, l, lds, bid, G);) \
        PH(10, if (EN_MOE) phase_moe_slots(a, l, lds, bid, G);) \
        PH(11, if (EN_MOE) { \
            MoeGU P; P.K = D; P.G = G; P.c = bid; P.TILEE = (const int*)(ws + WS_MOE + MOE_TILEE); P.ntile = P.TILEE[0]; P.Hb = (const char*)(ws + WS_H); P.Wb = (const char*)(ws + WS_WGU + l * WGU_L); \
            P.SLOTTOK = (const int*)(ws + WS_MOE + MOE_SLOTTOK); P.bgu = a->in[I_EBGU] + (size_t)l * NEXP * 1024; P.ACT = ws + WS_ACT; \
            pg8::gemm_phase(lds, P); }) \
        PH(12, if (EN_MOE) { \
            MoeDown P; P.K = DEXP; P.G = G; P.c = bid; P.TILEE = (const int*)(ws + WS_MOE + MOE_TILEE); P.ntile = P.TILEE[0]; P.Ab = (const char*)(ws + WS_ACT); P.Wb = (const char*)(ws + WS_WDN + l * WDN_L); \
            P.bdn = a->in[I_EBDN] + (size_t)l * NEXP * D; P.YSLOT = ws + WS_YSLOT; \
            pg8::gemm_phase(lds, P); }) \
        PH(13, if (EN_MOE) phase_moe_combine(a, l, lds, bid, G);)
    LAYER(0)
    LAYER(1)
#undef LAYER
    PH(14, if (!EN_MOE) phase_final_norm(a, bid, G);)
}
constexpr int N_PHASES = 2 + NL * 12 + 1;

extern "C" void kernel_launch(void* const* d_in, const int* in_sizes, int n_in, void* d_out, int out_size, void* d_ws, size_t ws_size, hipStream_t stream) {
    static int grid = 0;
    if (grid == 0) {
        if (n_in != 40 || ws_size < WS_END0) { fprintf(stderr, "kernel_launch: unexpected n_in %d / ws %zu (need %zu)\n", n_in, ws_size, (size_t)WS_END0); grid = -1; return; }
        int dev = 0, cus = 0, per_cu = 0;
        if (hipGetDevice(&dev) != hipSuccess || hipDeviceGetAttribute(&cus, hipDeviceAttributeMultiprocessorCount, dev) != hipSuccess) { grid = -1; return; }
        if (hipFuncSetAttribute((const void*)mk_fwd, hipFuncAttributeMaxDynamicSharedMemorySize, LDS_BYTES) != hipSuccess) { fprintf(stderr, "kernel_launch: hipFuncSetAttribute failed\n"); grid = -1; return; }
        if (hipOccupancyMaxActiveBlocksPerMultiprocessor(&per_cu, (const void*)mk_fwd, NTHR, LDS_BYTES) != hipSuccess || per_cu < 1) { fprintf(stderr, "kernel_launch: occupancy query says %d\n", per_cu); }
        (void)hipGetLastError();
        grid = cus;
    }
    if (grid < 0) return;
    if (hipMemsetAsync((char*)d_ws + WS_CTL, 0, CTL_ZERO_BYTES, stream) != hipSuccess) return;
    Args a{};
    for (int i = 0; i < 40; ++i) a.in[i] = (const float*)d_in[i];
    a.out = (float*)d_out; a.ws = (unsigned char*)d_ws;
#if MK_MULTI
    for (int p = 0; p < N_PHASES; ++p) { a.ph_lo = p; a.ph_hi = p + 1; hipLaunchKernelGGL(mk_fwd, dim3(grid), dim3(NTHR), LDS_BYTES, stream, a); }
#else
    a.ph_lo = 0; a.ph_hi = N_PHASES;
    hipLaunchKernelGGL(mk_fwd, dim3(grid), dim3(NTHR), LDS_BYTES, stream, a);
#endif
}
```

```cpp
#include <hip/hip_runtime.h>
#include <cstdio>
#include <cstdint>

#define GAS __attribute__((address_space(1)))
#define LAS __attribute__((address_space(3)))
typedef unsigned short bf16;
typedef short bf16x8 __attribute__((ext_vector_type(8)));
typedef float f32x4 __attribute__((ext_vector_type(4)));
typedef float f32x2 __attribute__((ext_vector_type(2)));
typedef unsigned u32x4 __attribute__((ext_vector_type(4)));
typedef unsigned u32x2 __attribute__((ext_vector_type(2)));
typedef _Float16 f16x8 __attribute__((ext_vector_type(8)));
#define DI __device__ __forceinline__

#ifndef EN_MLSTM
#define EN_MLSTM 1
#endif
#ifndef EN_RWKV
#define EN_RWKV 1
#endif
#ifndef EN_MOE
#define EN_MOE 1
#endif
#ifndef MK_MULTI
#define MK_MULTI 0
#endif

constexpr int D = 4096, SEQ = 16384, CTX = 256, ROWS = SEQ + CTX, NL = 2, NPAN = ROWS / 256;
constexpr int DBR = 1024;
constexpr int NA = 3104, NB = 3072, NC = 3488, NG = 12288, NIN = NA + NB + NC + NG;
constexpr int NA_P = 3328, NC_P = 3584;
constexpr int NAC = NA + NC, NAC_P = 6656;
constexpr int ROW_B = NAC_P, ROW_G = ROW_B + NB, NIN_P = ROW_G + NG;
constexpr int TAC = NAC_P / 256, TB = NB / 256, TG = NG / 256, NT_IN = TAC + TB + TG;
constexpr int NEXP = 32, DEXP = 512;
constexpr float NORM_EPS = 1e-6f;
constexpr int NTHR = 512, NWAVES = 8;

constexpr size_t MiB = 1u << 20;
constexpr size_t WS_CTL = 0, CTL_ZERO_BYTES = 1 * MiB;
constexpr size_t WS_MOD = 1 * MiB;
constexpr size_t WS_MODP = 2 * MiB;
constexpr size_t WS_HDN = 15 * MiB;
constexpr size_t WS_WIN = 24 * MiB;
constexpr size_t WIN_L = (size_t)NIN_P * D * 2;
constexpr size_t WS_WBR = WS_WIN + 2 * 174 * MiB;
constexpr size_t WBR_L = (size_t)3 * D * DBR * 2;
constexpr size_t WS_WOUT = WS_WBR + 48 * MiB;
constexpr size_t WOUT_L = (size_t)D * D * 2;
constexpr size_t WS_WGU = WS_WOUT + 64 * MiB;
constexpr size_t WGU_L = (size_t)NEXP * 1024 * D;
constexpr size_t WS_H8 = WS_WGU + 256 * MiB;
constexpr size_t WS_WIN8 = WS_H8 + 66 * MiB;
constexpr size_t WS_YS8 = WS_WIN8 + 116 * MiB;
constexpr size_t WS_WBR8 = WS_YS8 + 34 * MiB;
constexpr size_t WS_LORAT = WS_WBR8 + 16 * MiB;
constexpr int LORAT_L = 2 * 1024 * 64 * 2 + 1024 * 160, LORAT_A = 2 * 1024 * 64, LORAT_G = 4 * 1024 * 64;
constexpr int NF8 = 6656 + 4096 + 4096, TF8 = NF8 / 256;
constexpr size_t WIN8_L = (size_t)NF8 * D;
static_assert(WS_WIN8 + 2 * WIN8_L <= WS_YS8 && WS_LORAT + 2 * MiB <= WS_WGU + 512 * MiB, "fp8 buffers");
constexpr int N16 = 3072 + 4096, T16 = N16 / 256;
constexpr size_t WS_WDN = WS_WGU + 512 * MiB;
constexpr size_t WDN_L = (size_t)NEXP * D * DEXP;
constexpr size_t WS_XRES = WS_WDN + 256 * MiB;
constexpr size_t WS_H = WS_XRES + 260 * MiB;
constexpr size_t WS_ZA = WS_H + 130 * MiB;
constexpr size_t WS_GATES = WS_ZA + 106 * MiB;
constexpr size_t WS_ZBT = WS_GATES + 3 * MiB;
constexpr size_t WS_ZC = WS_ZBT + 195 * MiB;
constexpr size_t WS_SG = WS_ZC + 228 * MiB;
constexpr size_t WS_YS = WS_SG + 390 * MiB;
constexpr size_t WS_MERGED = WS_YS + 98 * MiB;
constexpr size_t WS_YBT = WS_MERGED + 130 * MiB;
constexpr size_t WS_HSCR = WS_YBT + 65 * MiB;
constexpr size_t HSCR_WG = 336 * 1024;
constexpr size_t WS_STREAM = WS_HSCR + 84 * MiB;
constexpr size_t WS_RV = WS_STREAM + 650 * MiB;
constexpr size_t WS_RSCAL = WS_RV + 65 * MiB;
constexpr size_t WS_RG = WS_RSCAL + 9 * MiB;
constexpr size_t WS_RBON = WS_RG + 65 * MiB;
constexpr size_t WS_RY = WS_RBON + 65 * MiB;
constexpr size_t WS_HDIR = WS_RY + 130 * MiB;
constexpr size_t WS_MOE = WS_HDIR + 130 * MiB;
constexpr size_t WS_WRT = WS_MOE + 2 * MiB;
constexpr size_t WS_END0 = WS_WRT + 1 * MiB;
constexpr int NSLOT = ROWS * 4 + NEXP * 256;
constexpr size_t MOE_EIDX = 0, MOE_EW = (size_t)ROWS * 16, MOE_TOKSLOT = (size_t)ROWS * 32, MOE_SLOTTOK = (size_t)ROWS * 48, MOE_TILEE = MOE_SLOTTOK + (size_t)NSLOT * 4;
constexpr size_t MOE_CNTW = MOE_TILEE + 2048;
static_assert(MOE_CNTW + 256 * 32 * 4 <= 2 * MiB, "moe tables");
constexpr size_t WS_MRG32 = WS_ZBT;
constexpr size_t WS_YSLOT = WS_ZBT;
constexpr size_t WS_ACT = WS_YSLOT + 584 * MiB;
static_assert(WS_ACT + 73 * MiB <= WS_YS, "moe overlay");
constexpr int CW_HQ = 20480;
constexpr int CW_CNT = 16384, CW_CUR = 16384 + 64;
static_assert(WS_END0 <= (size_t)4096 * MiB, "workspace map exceeds 4 GiB");

constexpr int RING_BYTES = 131072;
constexpr int LDSCTL_OFF = 139264, MISC_OFF = LDSCTL_OFF + 320;
constexpr int LDS_SMALL = LDSCTL_OFF + 1024;
constexpr int LDS_BYTES = 147456;
static_assert(8 * 16640 <= LDSCTL_OFF && LDS_SMALL + 4096 <= LDS_BYTES, "LDS map");

typedef __bf16 bf16v2 __attribute__((ext_vector_type(2)));
DI unsigned cvt_pk_bf16(float lo, float hi) { const bf16v2 v = __builtin_convertvector((f32x2){lo, hi}, bf16v2); return __builtin_bit_cast(unsigned, v); }
DI u32x4 pack8(f32x4 a, f32x4 b) { u32x4 w; w.x = cvt_pk_bf16(a[0], a[1]); w.y = cvt_pk_bf16(a[2], a[3]); w.z = cvt_pk_bf16(b[0], b[1]); w.w = cvt_pk_bf16(b[2], b[3]); return w; }
DI unsigned pk4_fp8(float a, float b, float c, float d) {
    a = fminf(fmaxf(a, -448.f), 448.f); b = fminf(fmaxf(b, -448.f), 448.f); c = fminf(fmaxf(c, -448.f), 448.f); d = fminf(fmaxf(d, -448.f), 448.f);
    int w = __builtin_amdgcn_cvt_pk_fp8_f32(a, b, 0, false); w = __builtin_amdgcn_cvt_pk_fp8_f32(c, d, w, true); return (unsigned)w; }
DI void unpack8(u32x4 w, f32x4& a, f32x4& b) { a[0] = __uint_as_float(w.x << 16); a[1] = __uint_as_float(w.x & 0xffff0000u); a[2] = __uint_as_float(w.y << 16); a[3] = __uint_as_float(w.y & 0xffff0000u);
    b[0] = __uint_as_float(w.z << 16); b[1] = __uint_as_float(w.z & 0xffff0000u); b[2] = __uint_as_float(w.w << 16); b[3] = __uint_as_float(w.w & 0xffff0000u); }
DI f32x4 unpack4(u32x2 w) { return (f32x4){__uint_as_float(w.x << 16), __uint_as_float(w.x & 0xffff0000u), __uint_as_float(w.y << 16), __uint_as_float(w.y & 0xffff0000u)}; }
DI float bf2f(unsigned short b) { return __uint_as_float(((unsigned)b) << 16); }
DI float sigmoidf_(float x) { return __builtin_amdgcn_rcpf(1.f + __expf(-x)); }
DI int otid() { int t = threadIdx.x; asm volatile("" : "+v"(t)); return t; }
template <int CTRL> DI float dpp_add(float x) { return x + __builtin_bit_cast(float, __builtin_amdgcn_update_dpp(0, __builtin_bit_cast(int, x), CTRL, 0xf, 0xf, true)); }
DI float rowsum16(float x) { x = dpp_add<0xB1>(x); x = dpp_add<0x4E>(x); x = dpp_add<0x141>(x); x = dpp_add<0x140>(x); return x; }
DI float wave_sum(float v) {
    v = rowsum16(v);
    v += __builtin_bit_cast(float, __builtin_amdgcn_update_dpp(0, __builtin_bit_cast(int, v), 0x142, 0xA, 0xF, false));
    v += __builtin_bit_cast(float, __builtin_amdgcn_update_dpp(0, __builtin_bit_cast(int, v), 0x143, 0xC, 0xF, false));
    return __builtin_bit_cast(float, __builtin_amdgcn_readlane(__builtin_bit_cast(int, v), 63));
}

#define XB_TMO      128
#define XB_XCNT(j)  (256  + 64 * (j))
#define XB_XSUB(j)  (1280 + 64 * (j))
#define XB_XGEN(j)  (2304 + 64 * (j))
#define XB_TOP      3328
#define XB_TOPGEN   3392
#define XCD_BAR_WORDS 3456
#define XB_SPIN_CAP (1u << 22)
DI unsigned xb_ld(unsigned* p)              { return __hip_atomic_load(p, __ATOMIC_RELAXED, __HIP_MEMORY_SCOPE_AGENT); }
DI unsigned xb_add(unsigned* p, unsigned v) { return __hip_atomic_fetch_add(p, v, __ATOMIC_RELAXED, __HIP_MEMORY_SCOPE_AGENT); }
DI unsigned xb_xcc_id() { return (unsigned)__builtin_amdgcn_s_getreg((3 << 11) | 20) & 0xFu; }
#define XB_SPIN(cond, bar) do { unsigned _sp = 0; while (cond) { __builtin_amdgcn_s_sleep(1); \
    if ((++_sp & 255u) == 0u) { if (xb_ld(&(bar)[XB_TMO])) break; if (_sp > XB_SPIN_CAP) { atomicAdd(&(bar)[XB_TMO], 1u); break; } } } } while (0)
struct XcdBarrier { unsigned* bar; unsigned x; volatile LAS unsigned* st; };
DI XcdBarrier xcd_barrier_post(unsigned* bar, volatile LAS unsigned* st) {
    XcdBarrier b; b.bar = bar; b.x = xb_xcc_id(); b.st = st;
    if (threadIdx.x == 0) (void)xb_add(&bar[XB_XCNT(b.x)], 1u);
    return b;
}
DI void xcd_barrier_complete(unsigned* bar, unsigned x, unsigned& nloc, unsigned& nx) {
    const unsigned G = gridDim.x * gridDim.y * gridDim.z;
    unsigned sum, cnt, mine, sp = 0u;
    for (;;) {
        sum = 0u; cnt = 0u; mine = 0u;
#pragma unroll
        for (unsigned j = 0; j < 16; ++j) { const unsigned c = xb_ld(&bar[XB_XCNT(j)]); sum += c; cnt += (c > 0u) ? 1u : 0u; mine = (j == x) ? c : mine; }
        if (sum == G) break;
        __builtin_amdgcn_s_sleep(1);
        if ((++sp & 255u) == 0u) { if (xb_ld(&bar[XB_TMO])) break; if (sp > XB_SPIN_CAP) { atomicAdd(&bar[XB_TMO], 1u); break; } }
    }
    nloc = mine > 0u ? mine : 1u; nx = cnt > 0u ? cnt : 1u;
}
DI void xcd_barrier(const XcdBarrier& b) {
    asm volatile("s_waitcnt vmcnt(0)" ::: "memory");
    __syncthreads();
    if (threadIdx.x == 0) {
        unsigned* bar = b.bar;
        __builtin_amdgcn_s_waitcnt(0);
        unsigned nloc = b.st[0], nx = b.st[1];
        if (nloc == 0u) { xcd_barrier_complete(bar, b.x, nloc, nx); b.st[0] = nloc; b.st[1] = nx; }
        const unsigned old = xb_add(&bar[XB_XSUB(b.x)], 1u);
        const unsigned gen = old / nloc;
        if (old + 1u == (gen + 1u) * nloc) {
            __builtin_amdgcn_fence(__ATOMIC_RELEASE, "agent");
            asm volatile("s_waitcnt vmcnt(0)" ::: "memory");
            const unsigned og = xb_add(&bar[XB_TOP], 1u);
            const unsigned tg = og / nx;
            if (og + 1u == (tg + 1u) * nx) xb_add(&bar[XB_TOPGEN], 1u);
            else XB_SPIN(xb_ld(&bar[XB_TOPGEN]) == tg, bar);
            __builtin_amdgcn_fence(__ATOMIC_ACQUIRE, "agent");
            xb_add(&bar[XB_XGEN(b.x)], 1u);
            asm volatile("s_waitcnt vmcnt(0)" ::: "memory");
        } else {
            XB_SPIN(xb_ld(&bar[XB_XGEN(b.x)]) == gen, bar);
            __builtin_amdgcn_fence(__ATOMIC_ACQUIRE, "agent");
            asm volatile("s_waitcnt vmcnt(0)" ::: "memory");
        }
    }
    __syncthreads();
}

namespace pg8 {
constexpr int BM = 256, BK = 64, HALF = 128, HTB = HALF * BK * 2, NXCD = 8, WGM = 4;
DI int lds_byte(int r, int c) { const int st = (r >> 4) * 2 + (c >> 5), rr = r & 15, cc = c & 31, ob = rr * 64 + cc * 2; return st * 1024 + (ob ^ (((ob >> 9) & 1) << 5)); }
DI void stage_rc(int b, int& R, int& C) { const int st = b / 1024, sb = b % 1024, swz = sb ^ (((sb >> 9) & 1) << 5); R = (st >> 1) * 16 + swz / 64; C = (st & 1) * 32 + (swz % 64) / 2; }
DI int perm32(int rho) { const int n = rho >> 4, i = rho & 15; return 8 * (i >> 2) + 4 * n + (i & 3); }
struct Unit { int pm, pn, aux; };
typedef int v8i __attribute__((ext_vector_type(8)));
DI v8i cat8(bf16x8 lo, bf16x8 hi) { typedef int v4i __attribute__((ext_vector_type(4))); const v4i a = __builtin_bit_cast(v4i, lo), b = __builtin_bit_cast(v4i, hi); return (v8i){a[0], a[1], a[2], a[3], b[0], b[1], b[2], b[3]}; }
DI void tile_of(int L, int nM, int nN, int& pm, int& pn) {
    const int nwg = nM * nN; int wgid = L;
    { const int q = nwg / NXCD, r = nwg % NXCD, xcd = wgid % NXCD, off = wgid / NXCD; wgid = (xcd < r ? xcd * (q + 1) : r * (q + 1) + (xcd - r) * q) + off; }
    const int nig = WGM * nN, gid = wgid / nig, fm = gid * WGM, gsz = (nM - fm) < WGM ? (nM - fm) : WGM;
    pm = fm + ((wgid % nig) % gsz); pn = (wgid % nig) / gsz;
}
#define EPI_LOOP(...) \
    _Pragma("unroll") for (int ai = 0; ai < 2; ++ai) _Pragma("unroll") for (int m = 0; m < 4; ++m) { const int rl = ai * 128 + wr * 64 + m * 16 + fr; \
    _Pragma("unroll") for (int bj = 0; bj < 2; ++bj) { const int cl = bj * 128 + wc * 32 + 8 * fq; const f32x4 v0 = acc[ai][bj][m][0], v1 = acc[ai][bj][m][1]; __VA_ARGS__ } }

#define EPI_GROUPS(ai, ...) \
    _Pragma("unroll") for (int mm = 0; mm < 2; ++mm) { const int m = 2 * mh + mm; const int rl = (ai) * 128 + wr * 64 + m * 16 + fr; \
    _Pragma("unroll") for (int bj = 0; bj < 2; ++bj) { const int cl = bj * 128 + wc * 32 + 8 * fq; __VA_ARGS__ } }

template <class P>
DI void gemm_phase(LAS unsigned char* lds, const P& S) {
    int tid_ = threadIdx.x; asm volatile("" : "+v"(tid_));
    const int tid = tid_, wid = __builtin_amdgcn_readfirstlane(tid >> 6), lane = tid & 63, wr = wid >> 2, wc = wid & 3, fr = lane & 15, fq = lane >> 4;
    constexpr int EB = P::FP8 ? 1 : 2;
    const int K = S.K, KB = K * EB, nt = KB / (BK * 2);
    const size_t kstep = (size_t)(BK * 2);
    const size_t hstep = (size_t)HALF * KB;
    unsigned voB[2][2], voA[2][2], voAn[2][2]; int RA[2], CA[2];
#pragma unroll
    for (int i = 0; i < 2; ++i) { int R, C; stage_rc(tid * 16 + i * 8192, R, C); const int Rb = (R & ~31) + perm32(R & 31); RA[i] = R; CA[i] = C;
#pragma unroll
        for (int h = 0; h < 2; ++h) { voA[h][i] = (unsigned)(R * KB + C * 2) + (unsigned)(h * hstep); voAn[h][i] = voA[h][i]; voB[h][i] = (unsigned)(Rb * KB + C * 2) + (unsigned)(h * hstep); } }
    const unsigned ldsw = (unsigned)wid * 1024u;
    const int aoff = lds_byte(wr * 64 + fr, fq * 8), boff = lds_byte(wc * 32 + fr, fq * 8);
#define PG8_SA(b, h) (((b) * 2 + (h)) * HTB)
#define PG8_SB(b, h) ((4 + (b) * 2 + (h)) * HTB)
#define PG8_STAGE(bufoff, gbase, voff) do { _Pragma("unroll") for (int _i = 0; _i < 2; ++_i) \
        __builtin_amdgcn_global_load_lds((const unsigned*)((const char*)(gbase) + (voff)[_i]), (LAS unsigned*)(lds + (bufoff) + ldsw + _i * 8192), 16, 0, 0); } while (0)
#define PG8_LD16(off) (*(const LAS bf16x8*)(lds + (off)))
#define PG8_LDA(dst, b, h) do { _Pragma("unroll") for (int m = 0; m < 4; ++m) { \
        if constexpr (P::FP8) dst##8[m] = cat8(PG8_LD16(PG8_SA(b, h) + aoff + m * 2048), PG8_LD16(PG8_SA(b, h) + aoff + m * 2048 + 1024)); \
        else { _Pragma("unroll") for (int k = 0; k < 2; ++k) dst[m][k] = PG8_LD16(PG8_SA(b, h) + aoff + m * 2048 + k * 1024); } } } while (0)
#define PG8_LDB(dst, b, h) do { _Pragma("unroll") for (int n = 0; n < 2; ++n) { \
        if constexpr (P::FP8) dst##8[n] = cat8(PG8_LD16(PG8_SB(b, h) + boff + n * 2048), PG8_LD16(PG8_SB(b, h) + boff + n * 2048 + 1024)); \
        else { _Pragma("unroll") for (int k = 0; k < 2; ++k) dst[n][k] = PG8_LD16(PG8_SB(b, h) + boff + n * 2048 + k * 1024); } } } while (0)
#define PG8_MMA(ai, bj, At, Bt) do { __builtin_amdgcn_s_setprio(1); _Pragma("unroll") for (int m = 0; m < 4; ++m) _Pragma("unroll") for (int n = 0; n < 2; ++n) { \
        if constexpr (P::FP8) asm volatile("v_mfma_scale_f32_16x16x128_f8f6f4 %0, %1, %2, %0, %3, %3 op_sel_hi:[0,0,0]" : "+v"(acc[ai][bj][m][n]) : "v"(Bt##8[n]), "v"(At##8[m]), "v"(sc127));   \
        else { _Pragma("unroll") for (int k = 0; k < 2; ++k) acc[ai][bj][m][n] = __builtin_amdgcn_mfma_f32_16x16x32_bf16(Bt[n][k], At[m][k], acc[ai][bj][m][n], 0, 0, 0); } } \
        __builtin_amdgcn_s_setprio(0); } while (0)
#define PG8_WAIT_V(n) asm volatile("s_waitcnt vmcnt(" #n ")" ::: "memory")
#define PG8_WAIT_L(n) asm volatile("s_waitcnt lgkmcnt(" #n ")" ::: "memory")
#define PG8_BAR __builtin_amdgcn_s_barrier()
#define PG8_SCHED __builtin_amdgcn_sched_barrier(0)
    Unit cur, nxt; int ui = 0;
    if (!S.next(0, cur)) return;
    f32x4 acc[2][2][4][2];
#pragma unroll
    for (int a = 0; a < 2; ++a)
#pragma unroll
        for (int b = 0; b < 2; ++b)
#pragma unroll
            for (int m = 0; m < 4; ++m)
#pragma unroll
                for (int n = 0; n < 2; ++n) acc[a][b][m][n] = (f32x4){0.f, 0.f, 0.f, 0.f};
    const int sc127 = 127;
    bf16x8 At[4][2], B0[2][2], B1[2][2]; v8i At8[4], B08[2], B18[2];
    const char* cA = S.a_ptr(cur); const char* cB = S.b_ptr(cur);
    if constexpr (P::GATHER) {
#pragma unroll
        for (int h = 0; h < 2; ++h)
#pragma unroll
            for (int i = 0; i < 2; ++i) { int R_, C_; stage_rc(tid * 16 + i * 8192, R_, C_); voA[h][i] = S.a_row_off(cur, h * 128 + R_) + (unsigned)C_ * 2u; }
    }
    PG8_STAGE(PG8_SB(0, 0), cB, voB[0]); PG8_STAGE(PG8_SB(0, 1), cB + hstep, voB[0]); PG8_STAGE(PG8_SA(0, 0), cA, voA[0]); PG8_STAGE(PG8_SA(0, 1), cA, voA[1]);
    if (wr == 1) PG8_BAR;
    PG8_WAIT_V(2); PG8_BAR;
    PG8_STAGE(PG8_SB(1, 0), cB + kstep, voB[0]); PG8_STAGE(PG8_SA(1, 0), cA + kstep, voA[0]); PG8_STAGE(PG8_SB(1, 1), cB + hstep + kstep, voB[0]);
    PG8_WAIT_V(6); PG8_BAR;
    for (;;) {
        const bool has_next = S.next(ui + 1, nxt);
        const char* nA = has_next ? S.a_ptr(nxt) : cA; const char* nB = has_next ? S.b_ptr(nxt) : cB;
        if constexpr (P::GATHER) {
#pragma unroll
            for (int h = 0; h < 2; ++h)
#pragma unroll
                for (int i = 0; i < 2; ++i) { int R_, C_; stage_rc(tid * 16 + i * 8192, R_, C_); voAn[h][i] = has_next ? (S.a_row_off(nxt, h * 128 + R_) + (unsigned)C_ * 2u) : voA[h][i]; }
        }
        for (int t = 0; t < nt; t += 2) {
            const bool last = (t == nt - 2);
            const char* a1 = cA + (size_t)(t + 1) * kstep;
            const char* a2 = last ? nA : cA + (size_t)(t + 2) * kstep; const char* b2 = last ? nB : cB + (size_t)(t + 2) * kstep;
            const char* a3 = a2 + kstep; const char* b3 = b2 + kstep;
            unsigned vo2[2][2];
#pragma unroll
            for (int h = 0; h < 2; ++h)
#pragma unroll
                for (int i = 0; i < 2; ++i) { if constexpr (P::GATHER) vo2[h][i] = last ? voAn[h][i] : voA[h][i]; else vo2[h][i] = voA[h][i]; }
            PG8_LDB(B0, 0, 0); PG8_LDB(B1, 0, 1); PG8_SCHED; PG8_LDA(At, 0, 0); PG8_STAGE(PG8_SA(1, 1), a1, voA[1]);
            PG8_WAIT_V(8); PG8_WAIT_L(0); PG8_BAR; PG8_MMA(0, 0, At, B0); PG8_MMA(0, 1, At, B1); PG8_BAR; PG8_SCHED;
            PG8_LDA(At, 0, 1); PG8_STAGE(PG8_SB(0, 0), b2, voB[0]); PG8_STAGE(PG8_SB(0, 1), b2 + hstep, voB[0]); PG8_STAGE(PG8_SA(0, 0), a2, vo2[0]);
            PG8_WAIT_V(8); PG8_WAIT_L(0); PG8_BAR; PG8_MMA(1, 0, At, B0); PG8_MMA(1, 1, At, B1); PG8_BAR; PG8_SCHED;
            PG8_LDB(B0, 1, 0); PG8_LDB(B1, 1, 1); PG8_SCHED; PG8_LDA(At, 1, 0); PG8_STAGE(PG8_SA(0, 1), a2, vo2[1]);
            PG8_WAIT_V(8); PG8_WAIT_L(0); PG8_BAR; PG8_MMA(0, 0, At, B0); PG8_MMA(0, 1, At, B1); PG8_BAR; PG8_SCHED;
            PG8_LDA(At, 1, 1); PG8_STAGE(PG8_SB(1, 0), b3, voB[0]); PG8_STAGE(PG8_SB(1, 1), b3 + hstep, voB[0]); PG8_STAGE(PG8_SA(1, 0), a3, vo2[0]);
            PG8_WAIT_V(8); PG8_WAIT_L(0); PG8_BAR; PG8_MMA(1, 0, At, B0); PG8_MMA(1, 1, At, B1); PG8_BAR; PG8_SCHED;
        }
        if (wr == 0) PG8_BAR;
        if constexpr (P::FP8) { asm volatile("s_nop 15\n\ts_nop 7" ::: "memory");
            const int ln_ = (int)__builtin_amdgcn_mbcnt_hi(~0u, __builtin_amdgcn_mbcnt_lo(~0u, 0u)); S.epi(acc, cur, wr, wc, ln_ & 15, ln_ >> 4); }
        else S.epi(acc, cur, wr, wc, fr, fq);
        if (!has_next) break;
#pragma unroll
        for (int a = 0; a < 2; ++a)
#pragma unroll
            for (int b = 0; b < 2; ++b)
#pragma unroll
                for (int m = 0; m < 4; ++m)
#pragma unroll
                    for (int n = 0; n < 2; ++n) acc[a][b][m][n] = (f32x4){0.f, 0.f, 0.f, 0.f};
        cur = nxt; cA = nA; cB = nB; ++ui;
        if constexpr (P::GATHER) {
#pragma unroll
            for (int h = 0; h < 2; ++h)
#pragma unroll
                for (int i = 0; i < 2; ++i) voA[h][i] = voAn[h][i];
        }
        if (wr == 1) PG8_BAR;
    }
    PG8_WAIT_V(0);
    PG8_BAR;
#undef PG8_SA
#undef PG8_SB
#undef PG8_STAGE
#undef PG8_LDA
#undef PG8_LD16
#undef PG8_LDB
#undef PG8_MMA
#undef PG8_WAIT_V
#undef PG8_WAIT_L
#undef PG8_BAR
#undef PG8_SCHED
}
}
using pg8::Unit;

struct Args { const float* in[40]; float* out; unsigned char* ws; int ph_lo, ph_hi; };
#define CAS __attribute__((address_space(4)))
typedef const CAS Args* AP;
enum { I_X = 0, I_C, I_CTX, I_CCTX, I_ADAW, I_ADAB, I_NMIX, I_NMOE, I_WIN, I_MGB, I_MNORM, I_HCW, I_HCB, I_HW1, I_HB1, I_HW2, I_HB2, I_HW3, I_HFREQ, I_HSKIP,
       I_RMU, I_RW0, I_RW2, I_RA0, I_RA2, I_RG2, I_RKK, I_RKA, I_RRK, I_RLNW, I_RLNB, I_WBR, I_WOUT, I_RTW, I_RTB, I_EGU, I_EBGU, I_EDN, I_EBDN, I_NFIN };

DI void transpose_tile(const float* W, int N, int k0, int n0, bf16* dst, int Kd, LAS float* scr, int lane) {
#pragma unroll
    for (int i = 0; i < 16; ++i) { const int kk = 4 * i + (lane >> 4), nn = 4 * (lane & 15);
        const f32x4 v = *(const f32x4*)(W + (size_t)(k0 + kk) * N + n0 + nn);
        scr[kk * 65 + nn] = v[0]; scr[kk * 65 + nn + 1] = v[1]; scr[kk * 65 + nn + 2] = v[2]; scr[kk * 65 + nn + 3] = v[3]; }
    asm volatile("s_waitcnt lgkmcnt(0)" ::: "memory");
    const int c = lane & 7;
#pragma unroll
    for (int j = 0; j < 8; ++j) { const int n = (lane >> 3) + 8 * j; const LAS float* s = scr + (8 * c) * 65 + n;
        u32x4 o; o.x = cvt_pk_bf16(s[0], s[65]); o.y = cvt_pk_bf16(s[2 * 65], s[3 * 65]); o.z = cvt_pk_bf16(s[4 * 65], s[5 * 65]); o.w = cvt_pk_bf16(s[6 * 65], s[7 * 65]);
        *(u32x4*)(dst + (size_t)(n0 + n) * Kd + k0 + 8 * c) = o; }
    asm volatile("s_waitcnt lgkmcnt(0)" ::: "memory");
}
DI void transpose_tile8(const float* W, int N, int k0, int n0, unsigned char* dst, int Kd, LAS float* scr, int lane, float sc) {
#pragma unroll
    for (int i = 0; i < 16; ++i) { const int kk = 4 * i + (lane >> 4), nn = 4 * (lane & 15);
        const f32x4 v = *(const f32x4*)(W + (size_t)(k0 + kk) * N + n0 + nn);
        scr[kk * 65 + nn] = v[0]; scr[kk * 65 + nn + 1] = v[1]; scr[kk * 65 + nn + 2] = v[2]; scr[kk * 65 + nn + 3] = v[3]; }
    asm volatile("s_waitcnt lgkmcnt(0)" ::: "memory");
    const int c = lane & 7;
#pragma unroll
    for (int j = 0; j < 8; ++j) { const int n = (lane >> 3) + 8 * j; const LAS float* s = scr + (8 * c) * 65 + n;
        u32x2 o; o.x = pk4_fp8(s[0] * sc, s[65] * sc, s[2 * 65] * sc, s[3 * 65] * sc); o.y = pk4_fp8(s[4 * 65] * sc, s[5 * 65] * sc, s[6 * 65] * sc, s[7 * 65] * sc);
        *(u32x2*)(dst + (size_t)(n0 + n) * Kd + k0 + 8 * c) = o; }
    asm volatile("s_waitcnt lgkmcnt(0)" ::: "memory");
}
DI int win_map(int n) {
    if (n < NA) return (n << 1) | 1;
    if (n < NA + NB) return (n - NA) << 1;
    if (n < NA + NB + NC) return ((NA + n - NA - NB) << 1) | 1;
    const int g = n - (NA + NB + NC);
    if (g < D) return ((NAC_P + g) << 1) | 1;
    if (g < 2 * D) return (NB + (g - D)) << 1;
    return ((NAC_P + D + (g - 2 * D)) << 1) | 1; }

constexpr int CV_TIN = 64 * (NIN / 64), CV_TBR = 3 * 16 * 64, CV_TOUT = 64 * 64, CV_TGU = NEXP * 64 * 16, CV_TDN = NEXP * 8 * 64;
constexpr int CV_TL = CV_TIN + CV_TBR + CV_TOUT + CV_TGU + CV_TDN;
struct CvJob { const float* src; unsigned char* dst; int N, Kd, kind; float sc; int l, kb, n0; };
DI CvJob cv_job(AP a, int l, int r) {
    unsigned char* ws = a->ws; CvJob j; j.l = l; j.kb = 0; j.n0 = 0; j.sc = 1.f;
    if (r < CV_TIN) { const int kb = r / (NIN / 64), nb = r % (NIN / 64), n0 = nb * 64;
        const int m0 = win_map(n0), m1 = win_map(n0 + 32);
        j.src = a->in[I_WIN] + (size_t)l * D * NIN + (size_t)kb * 64 * NIN + n0; j.N = NIN; j.Kd = D; j.kb = kb; j.n0 = n0;
        if ((m0 & 1) == (m1 & 1) && (m0 >> 1) - n0 == (m1 >> 1) - (n0 + 32)) {
            if (m0 & 1) { j.kind = 1; j.sc = 512.f; j.dst = ws + WS_WIN8 + l * WIN8_L + (size_t)(m0 >> 1) * D + kb * 64; }
            else { j.kind = 0; j.dst = ws + WS_WIN + l * WIN_L + ((size_t)(m0 >> 1) * D + kb * 64) * 2; } }
        else { j.kind = 2; j.dst = ws; }
        return j; }
    r -= CV_TIN;
    if (r < CV_TBR) { const int i = r / (16 * 64), q = r % (16 * 64), kb = q / 64, nb = q % 64;
        j.src = a->in[I_WBR] + ((size_t)l * 3 + i) * DBR * D + (size_t)kb * 64 * D + nb * 64; j.N = D; j.Kd = DBR;
        if (i == 1) { j.kind = 0; j.dst = ws + WS_WBR + l * WBR_L + ((size_t)i * D * DBR + (size_t)nb * 64 * DBR + kb * 64) * 2; }
        else { j.kind = 1; j.sc = 256.f; j.dst = ws + WS_WBR8 + ((size_t)l * 2 + (i >> 1)) * D * DBR + (size_t)nb * 64 * DBR + kb * 64; }
        return j; }
    r -= CV_TBR;
    if (r < CV_TOUT) { const int kb = r / 64, nb = r % 64;
        j.src = a->in[I_WOUT] + (size_t)l * D * D + (size_t)kb * 64 * D + nb * 64; j.N = D; j.Kd = D; j.kind = 0; j.dst = ws + WS_WOUT + l * WOUT_L + ((size_t)nb * 64 * D + kb * 64) * 2; return j; }
    r -= CV_TOUT;
    if (r < CV_TGU) { const int e = r / (64 * 16), q = r % (64 * 16), kb = q / 16, nb = q % 16;
        j.src = a->in[I_EGU] + ((size_t)l * NEXP + e) * D * 1024 + (size_t)kb * 64 * 1024 + nb * 64; j.N = 1024; j.Kd = D; j.kind = 1; j.sc = 512.f;
        j.dst = ws + WS_WGU + l * WGU_L + (size_t)e * 1024 * D + (size_t)nb * 64 * D + kb * 64; return j; }
    r -= CV_TGU;
    { const int e = r / (8 * 64), q = r % (8 * 64), kb = q / 64, nb = q % 64;
        j.src = a->in[I_EDN] + ((size_t)l * NEXP + e) * DEXP * D + (size_t)kb * 64 * D + nb * 64; j.N = D; j.Kd = DEXP; j.kind = 1; j.sc = 256.f;
        j.dst = ws + WS_WDN + l * WDN_L + (size_t)e * D * DEXP + (size_t)nb * 64 * DEXP + kb * 64; }
    return j;
}
DI void cv_load(const CvJob& j, f32x4 (&v)[16], int lane) {
#pragma unroll
    for (int i = 0; i < 16; ++i) v[i] = (f32x4){0.f, 0.f, 0.f, 0.f};
    if (j.kind != 2) {
#pragma unroll
        for (int i = 0; i < 16; ++i) v[i] = *(const f32x4*)(j.src + (size_t)(4 * i + (lane >> 4)) * j.N + 4 * (lane & 15)); }
}
DI void cv_store(AP a, const CvJob& j, const f32x4 (&v)[16], LAS float* scr, int lane) {
    if (j.kind == 2) {
        const float* W = a->in[I_WIN] + (size_t)j.l * D * NIN; bf16* d16 = (bf16*)(a->ws + WS_WIN + j.l * WIN_L); unsigned char* d8 = a->ws + WS_WIN8 + j.l * WIN8_L;
        for (int e = lane; e < 64 * 64; e += 64) { const int kk = e >> 6, nn = e & 63; const float x = W[(size_t)(j.kb * 64 + kk) * NIN + j.n0 + nn]; const int mm = win_map(j.n0 + nn);
            if (mm & 1) d8[(size_t)(mm >> 1) * D + j.kb * 64 + kk] = (unsigned char)(pk4_fp8(x * 512.f, 0.f, 0.f, 0.f) & 0xffu);
            else d16[(size_t)(mm >> 1) * D + j.kb * 64 + kk] = (bf16)(cvt_pk_bf16(x, 0.f) & 0xffffu); }
        return; }
#pragma unroll
    for (int i = 0; i < 16; ++i) { const int kk = 4 * i + (lane >> 4), nn = 4 * (lane & 15);
        scr[kk * 65 + nn] = v[i][0]; scr[kk * 65 + nn + 1] = v[i][1]; scr[kk * 65 + nn + 2] = v[i][2]; scr[kk * 65 + nn + 3] = v[i][3]; }
    asm volatile("s_waitcnt lgkmcnt(0)" ::: "memory");
    const int c = lane & 7;
    if (j.kind == 0) {
#pragma unroll
        for (int jj = 0; jj < 8; ++jj) { const int n = (lane >> 3) + 8 * jj; const LAS float* s = scr + (8 * c) * 65 + n;
            u32x4 o; o.x = cvt_pk_bf16(s[0], s[65]); o.y = cvt_pk_bf16(s[2 * 65], s[3 * 65]); o.z = cvt_pk_bf16(s[4 * 65], s[5 * 65]); o.w = cvt_pk_bf16(s[6 * 65], s[7 * 65]);
            *(u32x4*)(j.dst + ((size_t)n * j.Kd + 8 * c) * 2) = o; } }
    else { const float sc = j.sc;
#pragma unroll
        for (int jj = 0; jj < 8; ++jj) { const int n = (lane >> 3) + 8 * jj; const LAS float* s = scr + (8 * c) * 65 + n;
            u32x2 o; o.x = pk4_fp8(s[0] * sc, s[65] * sc, s[2 * 65] * sc, s[3 * 65] * sc); o.y = pk4_fp8(s[4 * 65] * sc, s[5 * 65] * sc, s[6 * 65] * sc, s[7 * 65] * sc);
            *(u32x2*)(j.dst + (size_t)n * j.Kd + 8 * c) = o; } }
    asm volatile("s_waitcnt lgkmcnt(0)" ::: "memory");
}
constexpr int cvq_nt(int l) { return (CV_TL - CV_TIN) + (l + 1 < NL ? CV_TIN : 0); }
constexpr int cvq_nch(int l) { return (cvq_nt(l) + 63) / 64; }
constexpr int CVQ_R = 1;
constexpr int cvq_q(int l) { return (cvq_nch(l) + CVQ_R - 1) / CVQ_R; }
DI CvJob cvq_job(AP a, int t, int l) { if (t < CV_TL - CV_TIN) return cv_job(a, l, CV_TIN + t); return cv_job(a, l + 1, t - (CV_TL - CV_TIN)); }
DI void conv_chunk(AP a, int cc, LAS unsigned char* lds, int l) {
    const int CVQ_NT = cvq_nt(l);
    const int tid = otid(), lane = tid & 63, wave = tid >> 6;
    LAS float* scr = (LAS float*)(lds + wave * 16640);
    CvJob jc, jn; f32x4 vc[16], vn[16];
    const int t0 = cc * 64 + wave; bool have = t0 < CVQ_NT;
    jc = cvq_job(a, have ? t0 : 0, l); jn = jc;
    if (have) cv_load(jc, vc, lane);
#pragma unroll 2
    for (int j = 0; j < 8; ++j) { const int tn = t0 + (j + 1) * 8; const bool hn = (j + 1 < 8) && tn < CVQ_NT;
        if (hn) { jn = cvq_job(a, tn, l); cv_load(jn, vn, lane); }
        if (have) cv_store(a, jc, vc, scr, lane);
        jc = jn; have = hn;
#pragma unroll
        for (int i = 0; i < 16; ++i) vc[i] = vn[i]; }
}

DI void phase_prologue(AP a, LAS unsigned char* lds, int bid, int G) {
    const int tid = otid(), lane = tid & 63, wave = tid >> 6;
    unsigned char* ws = a->ws;
    {
        LAS float* scr = (LAS float*)(lds + wave * 16640);
        const int gw = bid * NWAVES + wave, NGW = G * NWAVES;
        CvJob jc, jn; f32x4 vc[16], vn[16];
        bool have = gw < CV_TIN; jc = cv_job(a, 0, have ? gw : 0); jn = jc;
        if (have) cv_load(jc, vc, lane);
#pragma unroll 2
        for (int it = gw; it < CV_TIN; it += NGW) { const bool hn = it + NGW < CV_TIN;
            if (hn) { jn = cv_job(a, 0, it + NGW); cv_load(jn, vn, lane); }
            cv_store(a, jc, vc, scr, lane);
            jc = jn;
#pragma unroll
            for (int i = 0; i < 16; ++i) vc[i] = vn[i]; }
        for (int l = 0; l < NL; ++l) { unsigned char* d8 = ws + WS_WIN8 + l * WIN8_L + (size_t)NAC * D;
            const size_t n1 = (size_t)(NAC_P - NAC) * D / 16;
            for (size_t i = (size_t)bid * NTHR + tid; i < n1; i += (size_t)G * NTHR) ((u32x4*)d8)[i] = (u32x4){0u, 0u, 0u, 0u}; }
    }
    __syncthreads();
    for (int i = bid * NTHR + tid; i < NL * NEXP * D; i += G * NTHR) { const int l = i / (NEXP * D), e = (i / D) % NEXP, k = i % D;
        ((float*)(ws + WS_WRT))[i] = a->in[I_RTW][((size_t)l * D + k) * NEXP + e]; }
    for (int i = bid * NTHR + tid; i < NL * LORAT_L; i += G * NTHR) { const int l = i / LORAT_L, q = i % LORAT_L; float v;
        if (q < LORAT_G) { const int which = q >= LORAT_A, qq = q - which * LORAT_A, d = qq / (1024 * 64), c = (qq / 64) % 1024, j = qq % 64;
            v = (which ? a->in[I_RA2] : a->in[I_RW2])[(((size_t)l * 2 + d) * 64 + j) * DBR + c]; }
        else { const int qq = q - LORAT_G, c = qq / 160, j = qq % 160; v = a->in[I_RG2][((size_t)l * 160 + j) * DBR + c]; }
        ((bf16*)(ws + WS_LORAT))[i] = (bf16)(cvt_pk_bf16(v, 0.f) & 0xffffu); }
    {
        LAS float* sv = (LAS float*)lds;
        for (int it = bid; it < NL * 12 * 32; it += G) {
            const int l = it / (12 * 32), q = it % (12 * 32), cb = q / 32, ks = q % 32;
            __syncthreads();
            if (tid < 256) { const int w = tid >> 7, k = ks * 128 + (tid & 127); const float v = (w ? a->in[I_CCTX] : a->in[I_C])[k]; sv[tid] = v / (1.f + __expf(-v)); }
            __syncthreads();
            const float* W = a->in[I_ADAW] + (size_t)l * D * 6 * D + (size_t)(ks * 128) * 6 * D + cb * 2048 + tid * 4;
            f32x4 ax = {0.f, 0.f, 0.f, 0.f}, ac = {0.f, 0.f, 0.f, 0.f};
#pragma unroll 8
            for (int k = 0; k < 128; ++k) { const f32x4 w = *(const f32x4*)(W + (size_t)k * 6 * D); ax += w * sv[k]; ac += w * sv[128 + k]; }
            float* P = (float*)(ws + WS_MODP) + (((size_t)l * 32 + ks) * 2) * 6 * D + cb * 2048 + tid * 4;
            *(f32x4*)P = ax; *(f32x4*)(P + 6 * D) = ac;
        }
    }
    __syncthreads();
    {
        LAS float* zf = (LAS float*)lds;
        LAS float* h1 = zf + 32 * 36;
        for (int it = bid; it < NL * (ROWS / 32); it += G) {
            const int l = it / (ROWS / 32), pg = it % (ROWS / 32);
            __syncthreads();
            for (int e = tid; e < 32 * 33; e += NTHR) { const int p = e / 33, j = e % 33; const int gp = pg * 32 + p; const int L = gp < SEQ ? SEQ : CTX; const int pos = gp < SEQ ? gp : gp - SEQ;
                const float fpos = (float)pos; float v;
                if (j == 0) v = fpos / (float)(L - 1);
                else { const int bi = (j - 1) & 15; const float band = 1e-4f + (float)bi * ((15.f - 1e-4f) / 15.f); const float ang = (6.283185307179586f / (float)L) * fpos;
                    v = (j <= 16) ? cosf(ang * band) : -sinf(ang * band); }
                zf[p * 36 + j] = v; }
            __syncthreads();
            const int p8 = tid >> 6, m = tid & 63; const float fq = a->in[I_HFREQ][l * 64 + m];
            { const float* w1 = a->in[I_HW1] + (size_t)l * 33 * 64; const float b = a->in[I_HB1][l * 64 + m]; float s[4] = {b, b, b, b};
#pragma unroll
              for (int j = 0; j < 33; ++j) { const float w = w1[j * 64 + m];
#pragma unroll
                  for (int q = 0; q < 4; ++q) s[q] += zf[(p8 + 8 * q) * 36 + j] * w; }
#pragma unroll
              for (int q = 0; q < 4; ++q) h1[(p8 + 8 * q) * 64 + m] = sinf(fq * s[q]); }
            __syncthreads();
            { const float* w2 = a->in[I_HW2] + (size_t)l * 64 * 64; const float b = a->in[I_HB2][l * 64 + m]; float s[4] = {b, b, b, b};
#pragma unroll 8
              for (int j = 0; j < 64; ++j) { const float w = w2[j * 64 + m];
#pragma unroll
                  for (int q = 0; q < 4; ++q) s[q] += h1[(p8 + 8 * q) * 64 + j] * w; }
#pragma unroll
              for (int q = 0; q < 4; ++q) ((_Float16*)(ws + WS_HDN))[((size_t)l * ROWS + pg * 32 + p8 + 8 * q) * 64 + m] = (_Float16)sinf(fq * s[q]); }
        }
    }
    __syncthreads();
}
DI void phase_mod_reduce(AP a, int bid, int G) {
    const float* P = (const float*)(a->ws + WS_MODP); float* M = (float*)(a->ws + WS_MOD);
    const int tid = otid();
    for (int i = bid * NTHR + tid; i < NL * 2 * 6 * D; i += G * NTHR) {
        const int l = i / (2 * 6 * D), w = (i / (6 * D)) & 1, n = i % (6 * D);
        float s = a->in[I_ADAB][(size_t)l * 6 * D + n];
        for (int ks = 0; ks < 32; ++ks) s += P[(((size_t)l * 32 + ks) * 2 + w) * 6 * D + n];
        M[i] = s; }
}
DI void phase_norm_mod(AP a, int l, int which  , bool from_input, int bid, int G) {
    const int tid_o = otid(), lane = tid_o & 63, wave = tid_o >> 6;
    const float* gn = a->in[which ? I_NMOE : I_NMIX] + (size_t)l * D;
    const bf16* XR = (const bf16*)(a->ws + WS_XRES); bf16* H = (bf16*)(a->ws + WS_H); unsigned char* H8 = a->ws + WS_H8;
    for (int row = bid * NWAVES + wave; row < ROWS; row += G * NWAVES) {
        const int isc = row >= SEQ;
        const float* src = isc ? a->in[I_CTX] + (size_t)(row - SEQ) * D : a->in[I_X] + (size_t)row * D;
        const float* mod = (const float*)(a->ws + WS_MOD) + ((size_t)l * 2 + isc) * 6 * D + (which ? 3 * D : 0);
        f32x4 v[16]; float ss = 0.f;
#pragma unroll
        for (int j = 0; j < 16; ++j) { v[j] = from_input ? *(const f32x4*)(src + 4 * (lane + 64 * j)) : unpack4(*(const u32x2*)(XR + (size_t)row * D + 4 * (lane + 64 * j))); ss += v[j][0] * v[j][0] + v[j][1] * v[j][1] + v[j][2] * v[j][2] + v[j][3] * v[j][3]; }
        const float rs = rsqrtf(wave_sum(ss) * (1.f / D) + NORM_EPS);
#pragma unroll
        for (int jb = 0; jb < 4; ++jb) {
            f32x4 g[4], sh[4], sc[4];
#pragma unroll
            for (int jj = 0; jj < 4; ++jj) { const int c = 4 * (lane + 64 * (4 * jb + jj)); g[jj] = *(const f32x4*)(gn + c); sh[jj] = *(const f32x4*)(mod + c); sc[jj] = *(const f32x4*)(mod + D + c); }
#pragma unroll
            for (int jj = 0; jj < 4; ++jj) { const int j = 4 * jb + jj; const int c = 4 * (lane + 64 * j);
                const f32x4 o = (v[j] * rs) * g[jj] * (sc[jj] + 1.f) + sh[jj];
                u32x2 w; w.x = cvt_pk_bf16(o[0], o[1]); w.y = cvt_pk_bf16(o[2], o[3]);
                *(u32x2*)(H + (size_t)row * D + c) = w;
                *(unsigned*)(H8 + (size_t)row * D + c) = pk4_fp8(o[0] * 4.f, o[1] * 4.f, o[2] * 4.f, o[3] * 4.f); } }
    }
}
DI void phase_final_norm(AP a, int bid, int G) {
    const int tid_o = otid(), lane = tid_o & 63, wave = tid_o >> 6;
    const bf16* XR = (const bf16*)(a->ws + WS_XRES); const float* gn = a->in[I_NFIN];
    for (int row = bid * NWAVES + wave; row < SEQ; row += G * NWAVES) {
        f32x4 v[16]; float ss = 0.f;
#pragma unroll
        for (int j = 0; j < 16; ++j) { v[j] = unpack4(*(const u32x2*)(XR + (size_t)row * D + 4 * (lane + 64 * j))); ss += v[j][0] * v[j][0] + v[j][1] * v[j][1] + v[j][2] * v[j][2] + v[j][3] * v[j][3]; }
        const float rs = rsqrtf(wave_sum(ss) * (1.f / D) + NORM_EPS);
#pragma unroll
        for (int j = 0; j < 16; ++j) { const int c = 4 * (lane + 64 * j); *(f32x4*)(a->out + (size_t)row * D + c) = (v[j] * rs) * *(const f32x4*)(gn + c); }
    }
}

struct InProj8 {
    static constexpr bool GATHER = false, FP8 = true;
    int K, G, c, lastl; const char* Hb; const char* Wb; bf16* ZA; float* GATES; bf16* ZC; bf16* SGp;
    DI bool next(int i, Unit& u) const { const long L = (long)i * G + c;
        if (!lastl) { if (L >= NPAN * TF8) return false; pg8::tile_of((int)L, NPAN, TF8, u.pm, u.pn); }
        else { if (L >= (NPAN - 1) * TF8 + TAC) return false;
            if (L < (NPAN - 1) * TF8) pg8::tile_of((int)L, NPAN - 1, TF8, u.pm, u.pn); else { u.pm = NPAN - 1; u.pn = (int)L - (NPAN - 1) * TF8; } }
        u.aux = 0; return true; }
    DI const char* a_ptr(const Unit& u) const { return Hb + (size_t)u.pm * 256 * D; }
    DI const char* b_ptr(const Unit& u) const { return Wb + (size_t)u.pn * 256 * D; }
    DI unsigned a_row_off(const Unit&, int) const { return 0u; }
    DI void epi(const f32x4 (&acc)[2][2][4][2], const Unit& u, int wr, int wc, int fr, int fq) const {
        const int pn = u.pn, r0 = u.pm * 256; const float ds = 1.f / 2048.f;
        if (pn < TAC) {
            EPI_LOOP({ const int gc = pn * 256 + cl; const f32x4 x0 = v0 * ds, x1 = v1 * ds;
                       if (gc < NA) { bf16* p = ZA + (size_t)(r0 + rl) * NA_P + gc; *(u32x4*)p = pack8(x0, x1);
                           if (gc >= 3072) { float* g = GATES + (size_t)(r0 + rl) * 32 + (gc - 3072); *(f32x4*)g = x0; *(f32x4*)(g + 4) = x1; } }
                       else if (gc < NAC) { bf16* p = ZC + (size_t)(r0 + rl) * NC_P + (gc - NA); *(u32x4*)p = pack8(x0, x1); } })
        } else {
            const int gcol = (pn - TAC) * 256 + ((pn - TAC) >= 16 ? D : 0);
            EPI_LOOP({ bf16* p = SGp + (size_t)(r0 + rl) * NG + gcol + cl;
                       f32x4 s0, s1;
                       _Pragma("unroll") for (int e = 0; e < 4; ++e) { s0[e] = sigmoidf_(v0[e] * ds); s1[e] = sigmoidf_(v1[e] * ds); }
                       *(u32x4*)p = pack8(s0, s1); })
        }
    }
};
struct InProj16 {
    static constexpr bool GATHER = false, FP8 = false;
    int K, G, c, nM; const char* Hb; const char* Wb; float* ZBT; bf16* SGp;
    DI bool next(int i, Unit& u) const { const long L = (long)i * G + c; if (L >= nM * T16) return false; pg8::tile_of((int)L, nM, T16, u.pm, u.pn); u.aux = (u.pn < TB); return true; }
    DI const char* a_ptr(const Unit& u) const { return u.aux ? Wb + (size_t)u.pn * 256 * D * 2 : Hb + (size_t)u.pm * 256 * D * 2; }
    DI const char* b_ptr(const Unit& u) const { return u.aux ? Hb + (size_t)u.pm * 256 * D * 2 : Wb + (size_t)u.pn * 256 * D * 2; }
    DI unsigned a_row_off(const Unit&, int) const { return 0u; }
    DI void epi(const f32x4 (&acc)[2][2][4][2], const Unit& u, int wr, int wc, int fr, int fq) const {
        const int pn = u.pn, r0 = u.pm * 256;
        if (pn < TB) {
            EPI_LOOP({ float* p = ZBT + (size_t)(pn * 256 + rl) * ROWS + r0 + cl; *(f32x4*)p = v0; *(f32x4*)(p + 4) = v1; })
        } else {
            EPI_LOOP({ bf16* p = SGp + (size_t)(r0 + rl) * NG + D + (pn - TB) * 256 + cl;
                       f32x4 s0, s1;
                       _Pragma("unroll") for (int e = 0; e < 4; ++e) { s0[e] = sigmoidf_(v0[e]); s1[e] = sigmoidf_(v1[e]); }
                       *(u32x4*)p = pack8(s0, s1); })
        }
    }
};
struct BranchProj8 {
    static constexpr bool GATHER = false, FP8 = true;
    int K, G, c, nM; const char* YS; const char* Wb; const bf16* SGp; bf16* M32;
    DI bool next(int i, Unit& u) const { const int j = i >> 1, bi = i & 1; const long L = (long)j * G + c; if (L >= nM * 16) return false; pg8::tile_of((int)L, nM, 16, u.pm, u.pn); u.aux = bi; return true; }
    DI const char* a_ptr(const Unit& u) const { return YS + ((size_t)u.aux * ROWS + (size_t)u.pm * 256) * DBR; }
    DI const char* b_ptr(const Unit& u) const { return Wb + ((size_t)u.aux * D + (size_t)u.pn * 256) * DBR; }
    DI unsigned a_row_off(const Unit&, int) const { return 0u; }
    DI void epi(const f32x4 (&acc)[2][2][4][2], const Unit& u, int wr, int wc, int fr, int fq) const {
        const int r0 = u.pm * 256, c0 = u.pn * 256, br = 2 * u.aux; const bool first = u.aux == 0; const float ds = 1.f / 2048.f;
        _Pragma("unroll") for (int ai = 0; ai < 2; ++ai) _Pragma("unroll") for (int mh = 0; mh < 2; ++mh) {
            u32x4 gwv[2][2], mv[2][2];
            EPI_GROUPS(ai, { const size_t row = (size_t)(r0 + rl); const int col = c0 + cl;
                             gwv[mm][bj] = *(const u32x4*)(SGp + row * NG + br * D + col); mv[mm][bj] = first ? (u32x4){0u, 0u, 0u, 0u} : *(const u32x4*)(M32 + row * D + col); })
            EPI_GROUPS(ai, { const size_t row = (size_t)(r0 + rl); const int col = c0 + cl; const f32x4 v0 = acc[ai][bj][m][0], v1 = acc[ai][bj][m][1];
                             f32x4 g0, g1, m0, m1; unpack8(gwv[mm][bj], g0, g1); unpack8(mv[mm][bj], m0, m1);
                             *(u32x4*)(M32 + row * D + col) = pack8(v0 * g0 * ds + m0, v1 * g1 * ds + m1); }) }
    }
};
struct BranchProj16 {
    static constexpr bool GATHER = false, FP8 = false;
    int K, G, c, nM; const char* YS; const char* Wb; const bf16* SGp; const bf16* M32; bf16* MERGED;
    DI bool next(int i, Unit& u) const { const long L = (long)i * G + c; if (L >= nM * 16) return false; pg8::tile_of((int)L, nM, 16, u.pm, u.pn); u.aux = 0; return true; }
    DI const char* a_ptr(const Unit& u) const { return YS + ((size_t)ROWS + (size_t)u.pm * 256) * DBR * 2; }
    DI const char* b_ptr(const Unit& u) const { return Wb + ((size_t)D + (size_t)u.pn * 256) * DBR * 2; }
    DI unsigned a_row_off(const Unit&, int) const { return 0u; }
    DI void epi(const f32x4 (&acc)[2][2][4][2], const Unit& u, int wr, int wc, int fr, int fq) const {
        const int r0 = u.pm * 256, c0 = u.pn * 256;
        _Pragma("unroll") for (int ai = 0; ai < 2; ++ai) _Pragma("unroll") for (int mh = 0; mh < 2; ++mh) {
            u32x4 gwv[2][2], mv[2][2];
            EPI_GROUPS(ai, { const size_t row = (size_t)(r0 + rl); const int col = c0 + cl;
                             gwv[mm][bj] = *(const u32x4*)(SGp + row * NG + D + col); mv[mm][bj] = *(const u32x4*)(M32 + row * D + col); })
            EPI_GROUPS(ai, { const size_t row = (size_t)(r0 + rl); const int col = c0 + cl; const f32x4 v0 = acc[ai][bj][m][0], v1 = acc[ai][bj][m][1];
                             f32x4 g0, g1, m0, m1; unpack8(gwv[mm][bj], g0, g1); unpack8(mv[mm][bj], m0, m1);
                             *(u32x4*)(MERGED + row * D + col) = pack8(v0 * g0 + m0, v1 * g1 + m1); }) }
    }
};
struct OutProj {
    static constexpr bool GATHER = false, FP8 = false;
    int K, G, c; const char* Ab; const char* Wb; bf16* XR; const float* gate;
    const float* xin; const float* cin;
    int nM;
    DI bool next(int i, Unit& u) const { const long L = (long)i * G + c; if (L >= nM * 16) return false; pg8::tile_of((int)L, nM, 16, u.pm, u.pn); u.aux = 0; return true; }
    DI const char* a_ptr(const Unit& u) const { return Ab + (size_t)u.pm * 256 * D * 2; }
    DI const char* b_ptr(const Unit& u) const { return Wb + (size_t)u.pn * 256 * D * 2; }
    DI unsigned a_row_off(const Unit&, int) const { return 0u; }
    DI void epi(const f32x4 (&acc)[2][2][4][2], const Unit& u, int wr, int wc, int fr, int fq) const {
        const int r0 = u.pm * 256, c0 = u.pn * 256; const float* g = gate + (u.pm == NPAN - 1 ? 6 * D : 0);
        const float* srcb = (u.pm == NPAN - 1) ? cin - (size_t)SEQ * D : xin; const bool fin = xin != nullptr;
        f32x4 gv[2][2];
        _Pragma("unroll") for (int bj = 0; bj < 2; ++bj) { const int col = c0 + bj * 128 + wc * 32 + 8 * fq; gv[bj][0] = *(const f32x4*)(g + col); gv[bj][1] = *(const f32x4*)(g + col + 4); }
        _Pragma("unroll") for (int ai = 0; ai < 2; ++ai) _Pragma("unroll") for (int mh = 0; mh < 2; ++mh) {
            f32x4 qa[2][2], qb[2][2];
            EPI_GROUPS(ai, { const int col = c0 + cl;
                             if (fin) { const float* q = srcb + (size_t)(r0 + rl) * D + col; qa[mm][bj] = *(const f32x4*)q; qb[mm][bj] = *(const f32x4*)(q + 4); }
                             else unpack8(*(const u32x4*)(XR + (size_t)(r0 + rl) * D + col), qa[mm][bj], qb[mm][bj]); })
            EPI_GROUPS(ai, { const int col = c0 + cl; const f32x4 v0 = acc[ai][bj][m][0], v1 = acc[ai][bj][m][1];
                             *(u32x4*)(XR + (size_t)(r0 + rl) * D + col) = pack8(qa[mm][bj] + gv[bj][0] * v0, qb[mm][bj] + gv[bj][1] * v1); }) }
    }
};

DI f32x4 mfma16h(f16x8 a, f16x8 b, f32x4 c) { return __builtin_amdgcn_mfma_f32_16x16x32_f16(a, b, c, 0, 0, 0); }
DI f32x2 cmul(f32x2 a, f32x2 b) { return (f32x2){a.x * b.x - a.y * b.y, a.x * b.y + a.y * b.x}; }
DI f32x2 cconj(f32x2 a) { return (f32x2){a.x, -a.y}; }
DI int sw(int i) { return i ^ ((i >> 5) & 31); }
DI f32x2 twid_r(float r) { return (f32x2){__builtin_amdgcn_cosf(r), -__builtin_amdgcn_sinf(r)}; }
template <int S, bool INV, int NBF> DI void fft_pass(LAS f32x2* Dm, int L, int lb, int tid) {
    constexpr int P = 1 << S;
    const int lh = lb - S, h = 1 << lh, nbt = L >> S; const float invB = 1.0f / (float)(1 << lb);
    constexpr float TC[8] = {1.f, 0.92387953251f, 0.70710678119f, 0.38268343236f, 0.f, -0.38268343236f, -0.70710678119f, -0.92387953251f};
    constexpr float TS[8] = {0.f, 0.38268343236f, 0.70710678119f, 0.92387953251f, 1.f, 0.92387953251f, 0.70710678119f, 0.38268343236f};
    for (int i0 = tid; i0 < nbt; i0 += NBF * NTHR) {
        f32x2 x[NBF][P]; int base[NBF]; float rr[NBF];
#pragma unroll
        for (int u = 0; u < NBF; ++u) { const int idx = i0 + u * NTHR; const int blk = idx >> lh, j = idx & (h - 1); base[u] = (blk << lb) + j; rr[u] = (float)j * invB;
            if (idx < nbt) {
#pragma unroll
                for (int k = 0; k < P; ++k) x[u][k] = Dm[sw(base[u] + k * h)]; } }
#pragma unroll
        for (int u = 0; u < NBF; ++u) { const int idx = i0 + u * NTHR;
            if (idx < nbt) {
                f32x2 wp[S]; wp[0] = twid_r(rr[u]); if (INV) wp[0] = cconj(wp[0]);
#pragma unroll
                for (int t = 1; t < S; ++t) wp[t] = cmul(wp[t - 1], wp[t - 1]);
#pragma unroll
                for (int ss = 0; ss < S; ++ss) { const int st = INV ? S - 1 - ss : ss; const int grp = 1 << (S - st), half = grp >> 1;
#pragma unroll
                    for (int kp = 0; kp < half; ++kp) { const int ci = kp << (4 - S + st);
                        const f32x2 cst = {TC[ci], INV ? TS[ci] : -TS[ci]};
                        const f32x2 tw = (ci == 0) ? wp[st] : cmul(wp[st], cst);
#pragma unroll
                        for (int g = 0; g < (1 << st); ++g) { const int ia = g * grp + kp, ib = ia + half;
                            if (!INV) { const f32x2 uu = x[u][ia] + x[u][ib], vv = cmul(x[u][ia] - x[u][ib], tw); x[u][ia] = uu; x[u][ib] = vv; }
                            else { const f32x2 tt = cmul(x[u][ib], tw); const f32x2 xa = x[u][ia]; x[u][ia] = xa + tt; x[u][ib] = xa - tt; } } } }
#pragma unroll
                for (int k = 0; k < P; ++k) Dm[sw(base[u] + k * h)] = x[u][k]; } }
    }
    __syncthreads();
}
DI void fft_fwd(LAS f32x2* Dm, int L, int lg, int tid) {
    int lb = lg;
    for (; lb >= 4; lb -= 4) fft_pass<4, false, 2>(Dm, L, lb, tid);
    if (lb == 2) fft_pass<2, false, 8>(Dm, L, 2, tid);
}
DI void fft_inv(LAS f32x2* Dm, int L, int lg, int tid) {
    const int rem = lg & 3;
    if (rem == 2) fft_pass<2, true, 8>(Dm, L, 2, tid);
    for (int lb = rem + 4; lb <= lg; lb += 4) fft_pass<4, true, 2>(Dm, L, lb, tid);
}
DI void fwd4(f32x2 (&x)[4]) { const f32x2 a0 = x[0] + x[2], a1 = x[1] + x[3], a2 = x[0] - x[2], d = x[1] - x[3]; const f32x2 a3 = {d.y, -d.x}; x[0] = a0 + a1; x[1] = a0 - a1; x[2] = a2 + a3; x[3] = a2 - a3; }
DI void inv4(f32x2 (&x)[4]) { const f32x2 b0 = x[0] + x[1], b1 = x[0] - x[1], b2 = x[2] + x[3], b3 = x[2] - x[3]; const f32x2 ib = {-b3.y, b3.x}; x[0] = b0 + b2; x[1] = b1 + ib; x[2] = b0 - b2; x[3] = b1 - ib; }
DI void fft_fwd3(LAS f32x2* Dm, int L, int tid) { int lb = 14; asm volatile("" : "+s"(lb)); for (; lb >= 6; lb -= 4) fft_pass<4, false, 2>(Dm, L, lb, tid); }
DI void fft_inv3(LAS f32x2* Dm, int L, int tid) { int lb = 6; asm volatile("" : "+s"(lb)); for (; lb <= 14; lb += 4) fft_pass<4, true, 2>(Dm, L, lb, tid); }
DI float block_sum(float v, LAS float* red, int tid) {
    v = wave_sum(v); __syncthreads(); if ((tid & 63) == 0) red[tid >> 6] = v; __syncthreads();
    float s = 0.f;
#pragma unroll
    for (int w = 0; w < NWAVES; ++w) s += red[w];
    return s;
}
DI void hyena_item(AP a, int l, int ch, int seq, LAS unsigned char* lds, unsigned char* scr_g) {
    const int tid = otid();
    const int L = seq ? CTX : SEQ, lg = seq ? 8 : 14, t0 = seq ? SEQ : 0, Lh = L >> 1;
    LAS f32x2* Dm = (LAS f32x2*)lds; LAS float* Df = (LAS float*)lds;
    LAS float* w3s = (LAS float*)(lds + LDS_SMALL);
    LAS float* red = w3s + 256;
    f32x4* G2 = (f32x4*)scr_g;
    float* Y1 = (float*)(scr_g + 131072 + 4096);
    float* K2 = (float*)(scr_g + 131072 + 4096 + 65536);
    const float* ZBT = (const float*)(a->ws + WS_ZBT);
        const float* cw = a->in[I_HCW] + (size_t)l * 3 * NB; const float* cb = a->in[I_HCB] + (size_t)l * NB;
    const float da = logf(1e-2f) / 1.5f, db = logf(1e-2f) / 0.3f;
    const float delta = fabsf(da + (float)ch * ((db - da) / 1023.f));
    const float invLm1 = 1.f / (float)(L - 1);
    __syncthreads();
    if (tid < 256) w3s[tid] = a->in[I_HW3][(size_t)l * 64 * 4096 + (size_t)(tid & 63) * 4096 + (tid >> 6) * 1024 + ch];
    __syncthreads();
    float ssq0 = 0.f, ssq1 = 0.f;
    if (tid == 0) { Df[2 * sw(Lh)] = 0.f; K2[2 * Lh] = 0.f; }
    {
        const int lane = tid & 63, wv = tid >> 6, r16 = lane & 15, q4 = lane >> 4;
        f16x8 wf[2];
#pragma unroll
        for (int ks = 0; ks < 2; ++ks)
#pragma unroll
            for (int e = 0; e < 8; ++e) wf[ks][e] = (_Float16)w3s[(r16 & 3) * 64 + 32 * ks + 8 * q4 + e];
        const _Float16* hb = (const _Float16*)(a->ws + WS_HDN) + ((size_t)l * ROWS + t0) * 64 + (size_t)r16 * 64 + 8 * q4;
        const int nblk = L >> 6;
        f16x8 cur[8], nxt[8];
        if (wv < nblk) {
#pragma unroll
            for (int j = 0; j < 8; ++j) cur[j] = *(const f16x8*)(hb + (size_t)(wv * 64 + (j >> 1) * 16) * 64 + 32 * (j & 1)); }
        for (int blk = wv; blk < nblk; blk += NWAVES) {
            if (blk + NWAVES < nblk) {
#pragma unroll
                for (int j = 0; j < 8; ++j) nxt[j] = *(const f16x8*)(hb + (size_t)((blk + NWAVES) * 64 + (j >> 1) * 16) * 64 + 32 * (j & 1)); }
            f32x4 sv = {0.f, 0.f, 0.f, 0.f};
#pragma unroll
            for (int g = 0; g < 4; ++g) { f32x4 acc = {0.f, 0.f, 0.f, 0.f};
                acc = mfma16h(wf[0], cur[2 * g], acc); acc = mfma16h(wf[1], cur[2 * g + 1], acc);
                sv = (q4 == g) ? acc : sv; }
            const int P = blk * 64 + lane; const float wd = expf(-(float)P * invLm1 * delta);
            const float kf1 = sv[0] * wd, kb1 = sv[1] * wd, kf2 = sv[2] * wd, kb2 = sv[3] * wd;
            Df[2 * sw(P >> 1) + (P & 1)] = kf1; K2[P] = kf2; ssq0 += kf1 * kf1; ssq1 += kf2 * kf2;
            if (P >= 1) { const int eb = 2 * L - P; Df[2 * sw(eb >> 1) + (eb & 1)] = kb1; K2[eb] = kb2; ssq0 += kb1 * kb1; ssq1 += kb2 * kb2; }
#pragma unroll
            for (int j = 0; j < 8; ++j) cur[j] = nxt[j];
        }
    }
    const float ksc0 = rsqrtf(block_sum(ssq0, red, tid)) / (float)L, ksc1 = rsqrtf(block_sum(ssq1, red, tid)) / (float)L;
    for (int cv = 0; cv < 2; ++cv) {
        const float kscale = cv ? ksc1 : ksc0;
        if (cv == 1) { __syncthreads(); for (int n = tid; n < L; n += NTHR) Dm[sw(n)] = *(const f32x2*)(K2 + 2 * n); __syncthreads(); }
        if (seq == 0) {
            fft_fwd3(Dm, L, tid);
#pragma unroll 1
            for (int it = 0; it < 4; ++it) { const int wq = it * NTHR + tid, r = (tid >> 6) + 8 * it, ln = tid & 63; const int kb = ((r >> 4) << 10) | ((ln >> 5) << 9) | ((ln & 31) << 4) | (r & 15);
                if (kb == 0) continue;
                const int g4 = 4 * (int)(__brev((unsigned)kb) >> 20), gp4 = 4 * (int)(__brev((unsigned)(4096 - kb)) >> 20);
                f32x2 y[4], yp[4];
#pragma unroll
                for (int i = 0; i < 4; ++i) { y[i] = Dm[sw(g4 + i)]; yp[i] = Dm[sw(gp4 + i)]; }
                fwd4(y); fwd4(yp);
                G2[4 * wq] = (f32x4){y[0].x, y[0].y, yp[3].x, yp[3].y}; G2[4 * wq + 1] = (f32x4){y[2].x, y[2].y, yp[1].x, yp[1].y};
                G2[4 * wq + 2] = (f32x4){yp[2].x, yp[2].y, y[1].x, y[1].y}; G2[4 * wq + 3] = (f32x4){yp[0].x, yp[0].y, y[3].x, y[3].y}; }
            if (tid == 0 || tid == 64) { const int g4 = tid ? 4 : 0; f32x2 y[4];
#pragma unroll
                for (int i = 0; i < 4; ++i) y[i] = Dm[sw(g4 + i)];
                fwd4(y);
                if (tid == 0) { G2[8192] = (f32x4){y[0].x, y[0].y, y[0].x, y[0].y}; G2[8193] = (f32x4){y[1].x, y[1].y, y[1].x, y[1].y}; G2[8194] = (f32x4){y[2].x, y[2].y, y[3].x, y[3].y}; }
                else { G2[8195] = (f32x4){y[0].x, y[0].y, y[3].x, y[3].y}; G2[8196] = (f32x4){y[2].x, y[2].y, y[1].x, y[1].y}; } }
        } else {
        fft_fwd(Dm, L, lg, tid);
        for (int k = tid; k <= Lh; k += NTHR) { const int mk = (L - k) & (L - 1);
            const int pk = (int)(__brev((unsigned)k) >> (32 - lg)), pm = (int)(__brev((unsigned)mk) >> (32 - lg));
            const f32x2 zk = Dm[sw(pk)], zkm = Dm[sw(pm)]; G2[k] = (f32x4){zk.x, zk.y, zkm.x, zkm.y}; }
        }
        __syncthreads();
        const float w0 = cw[ch], w1c = cw[NB + ch], w2c = cw[2 * NB + ch], bb = cb[ch];
        const float* zv = ZBT + (size_t)ch * ROWS + t0;
#pragma unroll 4
        for (int n = tid; n < L; n += NTHR) {
            f32x2 v = {0.f, 0.f};
            if (n < Lh) {
                if (cv == 0) { const int t = 2 * n; const float zm = t > 0 ? zv[t - 1] : 0.f, z2 = (t + 2 < L) ? zv[t + 2] : 0.f; const f32x2 z01 = *(const f32x2*)(zv + t);
                    v.x = zm * w0 + z01.x * w1c + z01.y * w2c + bb; v.y = z01.x * w0 + z01.y * w1c + z2 * w2c + bb; }
                else v = *(const f32x2*)(Y1 + 2 * n);
            }
            Dm[sw(n)] = v; }
        __syncthreads();
        if (seq == 0) {
            fft_fwd3(Dm, L, tid);
            auto spec = [&](int k, f32x4 g, f32x2 zu, f32x2 zum, f32x2& ou, f32x2& om) {
                const f32x2 zk = {g[0], g[1]}, zkm = {g[2], g[3]};
                const f32x2 ue = (zu + cconj(zum)) * 0.5f, du = zu - cconj(zum), uo = (f32x2){0.5f * du.y, -0.5f * du.x};
                const f32x2 ke = (zk + cconj(zkm)) * 0.5f, dk = zk - cconj(zkm), ko = (f32x2){0.5f * dk.y, -0.5f * dk.x};
                const f32x2 w = twid_r((float)k * (1.0f / 16384.f));
                const f32x2 ye = cmul(ue, ke) + cmul(w, cmul(uo, ko)), yo = cmul(ue, ko) + cmul(uo, ke);
                ou = (f32x2){ye.x - yo.y, ye.y + yo.x}; om = (f32x2){ye.x + yo.y, -ye.y + yo.x}; };
            f32x4 gq[4];
#pragma unroll
            for (int j = 0; j < 4; ++j) gq[j] = G2[4 * tid + j];
#pragma unroll 1
            for (int it = 0; it < 4; ++it) { const int wq = it * NTHR + tid, r = (tid >> 6) + 8 * it, ln = tid & 63; const int kb = ((r >> 4) << 10) | ((ln >> 5) << 9) | ((ln & 31) << 4) | (r & 15);
                const f32x4 gc0 = gq[0], gc1 = gq[1], gc2 = gq[2], gc3 = gq[3];
                if (it + 1 < 4) {
#pragma unroll
                    for (int j = 0; j < 4; ++j) gq[j] = G2[4 * (wq + NTHR) + j]; }
                if (kb == 0) continue;
                const int g4 = 4 * (int)(__brev((unsigned)kb) >> 20), gp4 = 4 * (int)(__brev((unsigned)(4096 - kb)) >> 20);
                f32x2 y[4], yp[4], o[4], op[4];
#pragma unroll
                for (int i = 0; i < 4; ++i) { y[i] = Dm[sw(g4 + i)]; yp[i] = Dm[sw(gp4 + i)]; }
                fwd4(y); fwd4(yp);
                spec(kb, gc0, y[0], yp[3], o[0], op[3]); spec(kb + 4096, gc1, y[2], yp[1], o[2], op[1]); spec(8192 - kb, gc2, yp[2], y[1], op[2], o[1]); spec(4096 - kb, gc3, yp[0], y[3], op[0], o[3]);
                inv4(o); inv4(op);
#pragma unroll
                for (int i = 0; i < 4; ++i) { Dm[sw(g4 + i)] = o[i]; Dm[sw(gp4 + i)] = op[i]; } }
            if (tid == 0 || tid == 64) {
                const int g4 = tid ? 4 : 0; f32x2 y[4], o[4], dum;
#pragma unroll
                for (int i = 0; i < 4; ++i) y[i] = Dm[sw(g4 + i)];
                fwd4(y);
                if (tid == 0) { spec(0, G2[8192], y[0], y[0], o[0], dum); spec(8192, G2[8193], y[1], y[1], o[1], dum); spec(4096, G2[8194], y[2], y[3], o[2], o[3]); }
                else { spec(2048, G2[8195], y[0], y[3], o[0], o[3]); spec(6144, G2[8196], y[2], y[1], o[2], o[1]); }
                inv4(o);
#pragma unroll
                for (int i = 0; i < 4; ++i) Dm[sw(g4 + i)] = o[i]; }
            __syncthreads();
            fft_inv3(Dm, L, tid);
        } else {
        fft_fwd(Dm, L, lg, tid);
#pragma unroll 4
        for (int k = tid; k <= Lh; k += NTHR) {
            const int mk = (L - k) & (L - 1);
            const int pk = (int)(__brev((unsigned)k) >> (32 - lg)), pm = (int)(__brev((unsigned)mk) >> (32 - lg));
            const int spk = sw(pk), spm = sw(pm);
            const f32x4 g = G2[k]; const f32x2 zu = Dm[spk], zum = Dm[spm], zk = {g[0], g[1]}, zkm = {g[2], g[3]};
            const f32x2 ue = (zu + cconj(zum)) * 0.5f, du = zu - cconj(zum), uo = (f32x2){0.5f * du.y, -0.5f * du.x};
            const f32x2 ke = (zk + cconj(zkm)) * 0.5f, dk = zk - cconj(zkm), ko = (f32x2){0.5f * dk.y, -0.5f * dk.x};
            const f32x2 w = twid_r((float)k * (1.0f / (float)L));
            const f32x2 ye = cmul(ue, ke) + cmul(w, cmul(uo, ko)), yo = cmul(ue, ko) + cmul(uo, ke);
            Dm[spk] = (f32x2){ye.x - yo.y, ye.y + yo.x};
            if (pm != pk) Dm[spm] = (f32x2){ye.x + yo.y, -ye.y + yo.x}; }
        __syncthreads();
        fft_inv(Dm, L, lg, tid);
        }
        const float skip = a->in[I_HSKIP][(size_t)l * 2 * DBR + cv * DBR + ch];
        const int chg = (cv == 0 ? DBR : 2 * DBR) + ch;
        const float g0 = cw[chg], g1 = cw[NB + chg], g2 = cw[2 * NB + chg], gb = cb[chg];
        const float* zg = ZBT + (size_t)chg * ROWS + t0;
        float* YBT = (float*)(a->ws + WS_YBT) + (size_t)ch * ROWS + t0;
#pragma unroll 8
        for (int n = tid; n < Lh; n += NTHR) { const int t = 2 * n;
            const f32x2 c = Dm[sw(n)] * kscale;
            f32x2 s;
            if (cv == 0) { const float zm = t > 0 ? zv[t - 1] : 0.f, z2 = (t + 2 < L) ? zv[t + 2] : 0.f; const f32x2 z01 = *(const f32x2*)(zv + t);
                s.x = zm * w0 + z01.x * w1c + z01.y * w2c + bb; s.y = z01.x * w0 + z01.y * w1c + z2 * w2c + bb; }
            else s = *(const f32x2*)(Y1 + t);
            const float qm = t > 0 ? zg[t - 1] : 0.f, q2 = (t + 2 < L) ? zg[t + 2] : 0.f; const f32x2 q01 = *(const f32x2*)(zg + t);
            const f32x2 ug = {qm * g0 + q01.x * g1 + q01.y * g2 + gb, q01.x * g0 + q01.y * g1 + q2 * g2 + gb};
            const f32x2 o = ug * (c + s * skip);
            if (cv == 0) *(f32x2*)(Y1 + t) = o; else *(f32x2*)(YBT + t) = o; }
        __syncthreads();
    }
}
DI void phase_yb_transpose(AP a, LAS unsigned char* lds, int bid, int G, int ncol64) {
    const int tid_o = otid(), lane = tid_o & 63, wave = tid_o >> 6;
    LAS float* scr = (LAS float*)(lds + wave * 16640);
    const float* YBT = (const float*)(a->ws + WS_YBT); bf16* YB = (bf16*)(a->ws + WS_YS) + (size_t)1 * ROWS * DBR;
    for (int it = bid * NWAVES + wave; it < (DBR / 64) * ncol64; it += G * NWAVES) {
        const int cbk = it / ncol64, tb = it % ncol64;
        transpose_tile(YBT, ROWS, cbk * 64, tb * 64, YB, DBR, scr, lane); }
}

constexpr int ML_LD = 72;
constexpr int ML_QS = 0, ML_QE = 9216, ML_KS = 18432, ML_KPT = 27648, ML_SS = 36864, ML_VT = 46080, ML_CT = 66816, ML_GB = 87552, ML_GA = ML_GB + 256, ML_DEN = ML_GA + 256;
DI f32x4 mfma16(bf16x8 a, bf16x8 b, f32x4 c) { return __builtin_amdgcn_mfma_f32_16x16x32_bf16(a, b, c, 0, 0, 0); }
DI bf16x8 ldfrag(const LAS bf16* tile, int row0, int kofs, int lane) { return *(const LAS bf16x8*)(tile + (row0 + (lane & 15)) * ML_LD + kofs + 8 * (lane >> 4)); }
DI unsigned short f2bf(float f) { return (unsigned short)(cvt_pk_bf16(f, 0.f) & 0xffffu); }
DI int ml_row(int d, int ci, int j) { if (d == 0) { const int r0 = ci < 4 ? SEQ + 64 * ci : 64 * (ci - 4); return r0 + j; } const int r0 = ci < 4 ? SEQ + 64 * (3 - ci) : 64 * (259 - ci); return r0 + 63 - j; }
DI void mlstm_scan(AP a, int l, int h, int d, LAS unsigned char* lds) {
    const int tid = otid(), lane = tid & 63, w = tid >> 6, q4 = lane >> 4, r16 = lane & 15;
    LAS bf16* Qs = (LAS bf16*)(lds + ML_QS); LAS bf16* Qe = (LAS bf16*)(lds + ML_QE); LAS bf16* Ks = (LAS bf16*)(lds + ML_KS); LAS bf16* Kpt = (LAS bf16*)(lds + ML_KPT);
    LAS bf16* Ss = (LAS bf16*)(lds + ML_SS); LAS bf16* Vt = (LAS bf16*)(lds + ML_VT); LAS bf16* Ct = (LAS bf16*)(lds + ML_CT);
    LAS float* bc = (LAS float*)(lds + ML_GB); LAS float* av = (LAS float*)(lds + ML_GA); LAS float* den = (LAS float*)(lds + ML_DEN);
    const bf16* ZA = (const bf16*)(a->ws + WS_ZA); const float* GT = (const float*)(a->ws + WS_GATES);
    float* HD = (float*)(a->ws + WS_HDIR) + (size_t)d * ROWS * DBR;
    const float bias_i = a->in[I_MGB][l * 32 + d * 16 + h], bias_f = a->in[I_MGB][l * 32 + d * 16 + 8 + h];
    __syncthreads();
    for (int i = tid; i < 144 * ML_LD; i += NTHR) Ct[i] = 0;
    for (int i = tid; i < 16 * ML_LD; i += NTHR) Vt[128 * ML_LD + i] = (i < ML_LD) ? (bf16)0x3f80 : (bf16)0;
    f32x4 st[5];
#pragma unroll
    for (int j = 0; j < 5; ++j) st[j] = (f32x4){0.f, 0.f, 0.f, 0.f};
    const int jrow = tid >> 3, kb = tid & 7;
    u32x4 rq, rk, rv0, rv1; float gi = 0.f, gf = 0.f;
#define ML_LOAD(ci) do { const int row_ = ml_row(d, (ci), jrow); const bf16* zr_ = ZA + (size_t)row_ * NA_P; rq = *(const u32x4*)(zr_ + h * 64 + 8 * kb); rk = *(const u32x4*)(zr_ + 512 + h * 64 + 8 * kb); \
        rv0 = *(const u32x4*)(zr_ + 1024 + h * 128 + 16 * kb); rv1 = *(const u32x4*)(zr_ + 1024 + h * 128 + 16 * kb + 8); \
        if (tid < 64) { const int rw_ = ml_row(d, (ci), tid); gi = GT[(size_t)rw_ * 32 + d * 16 + h]; gf = GT[(size_t)rw_ * 32 + d * 16 + 8 + h]; } } while (0)
    ML_LOAD(0);
    for (int ci = 0; ci < 260; ++ci) {
        if (w == 0) {
            const float ip = 15.f * tanhf((gi + bias_i) * (1.f / 15.f)), fp = 15.f * tanhf((gf + bias_f) * (1.f / 15.f));
            float cum = fp >= 0.f ? -log1pf(expf(-fp)) : fp - log1pf(expf(fp));
#pragma unroll
            for (int o = 1; o < 64; o <<= 1) { const float t = __shfl_up(cum, o); if (lane >= o) cum += t; }
            bc[lane] = cum; av[lane] = ip;
        }
        __syncthreads();
        {
            const float bj = bc[jrow], eb = expf(bj), wk = expf(bc[63] - bj + av[jrow]);
            const unsigned qw[4] = {rq.x, rq.y, rq.z, rq.w}, kw[4] = {rk.x, rk.y, rk.z, rk.w};
            f32x4 q0, q1;
#pragma unroll
            for (int e = 0; e < 4; ++e) { const float lo = __uint_as_float(qw[e] << 16) * 0.125f, hi = __uint_as_float(qw[e] & 0xffff0000u) * 0.125f;
                if (e < 2) { q0[2 * e] = lo; q0[2 * e + 1] = hi; } else { q1[2 * (e - 2)] = lo; q1[2 * (e - 2) + 1] = hi; } }
            *(LAS u32x4*)(Qs + jrow * ML_LD + 8 * kb) = pack8(q0, q1);
            *(LAS u32x4*)(Qe + jrow * ML_LD + 8 * kb) = pack8(q0 * eb, q1 * eb);
            *(LAS u32x4*)(Ks + jrow * ML_LD + 8 * kb) = rk;
#pragma unroll
            for (int e = 0; e < 4; ++e) { Kpt[(8 * kb + 2 * e) * ML_LD + jrow] = f2bf(__uint_as_float(kw[e] << 16) * wk); Kpt[(8 * kb + 2 * e + 1) * ML_LD + jrow] = f2bf(__uint_as_float(kw[e] & 0xffff0000u) * wk); }
            const unsigned vw[8] = {rv0.x, rv0.y, rv0.z, rv0.w, rv1.x, rv1.y, rv1.z, rv1.w};
#pragma unroll
            for (int e = 0; e < 8; ++e) { Vt[(16 * kb + 2 * e) * ML_LD + jrow] = (bf16)(vw[e] & 0xffffu); Vt[(16 * kb + 2 * e + 1) * ML_LD + jrow] = (bf16)(vw[e] >> 16); }
        }
        if (ci + 1 < 260) ML_LOAD(ci + 1);
        __syncthreads();
#pragma unroll
        for (int tt = 0; tt < 2; ++tt) { const int tau = 2 * w + tt, mt = tau >> 2, ns = tau & 3;
            f32x4 acc = {0.f, 0.f, 0.f, 0.f};
            if (ns <= mt) {
#pragma unroll
                for (int ks = 0; ks < 2; ++ks) acc = mfma16(ldfrag(Qs, 16 * mt, 32 * ks, lane), ldfrag(Ks, 16 * ns, 32 * ks, lane), acc); }
            const int sx = 16 * ns + r16; const float bs = bc[sx] - av[sx];
#pragma unroll
            for (int i = 0; i < 4; ++i) { const int t = 16 * mt + 4 * q4 + i; const float val = (sx <= t) ? acc[i] * expf(bc[t] - bs) : 0.f; Ss[t * ML_LD + sx] = f2bf(val); } }
        __syncthreads();
        f32x4 nacc[5];
#pragma unroll
        for (int j = 0; j < 5; ++j) { const int tau = w + 8 * j; nacc[j] = (f32x4){0.f, 0.f, 0.f, 0.f};
            if (tau < 36) { const int mt = tau / 9, nv = tau - 9 * mt; f32x4 acc = {0.f, 0.f, 0.f, 0.f};
#pragma unroll
                for (int ks = 0; ks < 2; ++ks) acc = mfma16(ldfrag(Ss, 16 * mt, 32 * ks, lane), ldfrag(Vt, 16 * nv, 32 * ks, lane), acc);
#pragma unroll
                for (int ks = 0; ks < 2; ++ks) acc = mfma16(ldfrag(Qe, 16 * mt, 32 * ks, lane), ldfrag(Ct, 16 * nv, 32 * ks, lane), acc);
                nacc[j] = acc;
                if (nv == 8 && r16 == 0) {
#pragma unroll
                    for (int i = 0; i < 4; ++i) den[16 * mt + 4 * q4 + i] = acc[i]; } } }
        __syncthreads();
#pragma unroll
        for (int j = 0; j < 5; ++j) { const int tau = w + 8 * j;
            if (tau < 36) { const int mt = tau / 9, nv = tau - 9 * mt;
                if (nv < 8) {
#pragma unroll
                    for (int i = 0; i < 4; ++i) { const int t = 16 * mt + 4 * q4 + i; const float dd = 1.f / fmaxf(fabsf(den[t]), 1.f);
                        HD[(size_t)ml_row(d, ci, t) * DBR + h * 128 + 16 * nv + r16] = nacc[j][i] * dd; } } } }
        { const float g = expf(bc[63]);
#pragma unroll
            for (int j = 0; j < 5; ++j) { const int tau = w + 8 * j;
                if (tau < 36) { const int mv = tau >> 2, nk = tau & 3; f32x4 acc = st[j] * g;
#pragma unroll
                    for (int ks = 0; ks < 2; ++ks) acc = mfma16(ldfrag(Vt, 16 * mv, 32 * ks, lane), ldfrag(Kpt, 16 * nk, 32 * ks, lane), acc);
                    st[j] = acc;
#pragma unroll
                    for (int i = 0; i < 4; ++i) Ct[(16 * mv + 4 * q4 + i) * ML_LD + 16 * nk + r16] = f2bf(acc[i]); } } }
        __syncthreads();
    }
#undef ML_LOAD
}

DI int rw_row(int P) { if (P < CTX) return SEQ + P; const int p = P - CTX; return (p & 255) * 64 + (p >> 8); }
constexpr int RW_TOK = 8;
constexpr int PT = 13, PLD = 456, P_RKV = 16 * PLD * 2;
DI void rwkv_prep_item(AP a, int l, int item, LAS unsigned char* lds) {
    const int tid = otid(), lane = tid & 63, wv = __builtin_amdgcn_readfirstlane(tid >> 6), q4 = lane >> 4, r16 = lane & 15;
    LAS bf16* LI = (LAS bf16*)lds;
    LAS bf16* RKV = (LAS bf16*)(lds + P_RKV);
    const bf16* ZC = (const bf16*)(a->ws + WS_ZC); const float* mu = a->in[I_RMU] + (size_t)l * NC;
    const int P0 = item * PT;
    __syncthreads();
    for (int i = tid; i < 3 * PLD; i += NTHR) LI[PT * PLD + i] = 0;
    for (int idx = tid; idx < PT * (NC / 4); idx += NTHR) { const int tt = idx / (NC / 4), c = 4 * (idx - tt * (NC / 4)); const int P = P0 + tt;
        const bool hp = (P != 0 && P != CTX), hn = (P != CTX - 1 && P != ROWS - 1);
        const f32x4 z0 = unpack4(*(const u32x2*)(ZC + (size_t)rw_row(P) * NC_P + c));
        const f32x4 zp = hp ? unpack4(*(const u32x2*)(ZC + (size_t)rw_row(P - 1) * NC_P + c)) : (f32x4){0.f, 0.f, 0.f, 0.f};
        const f32x4 zn = hn ? unpack4(*(const u32x2*)(ZC + (size_t)rw_row(P + 1) * NC_P + c)) : (f32x4){0.f, 0.f, 0.f, 0.f};
        f32x4 z = z0 + *(const f32x4*)(mu + c) * ((zp + zn) * 0.5f - z0);
        if (c >= 3072 && c < 3200) {
#pragma unroll
            for (int e = 0; e < 4; ++e) z[e] = tanhf(z[e]); }
        if (c >= 3328) {
#pragma unroll
            for (int e = 0; e < 4; ++e) z[e] = sigmoidf_(z[e]); }
        u32x2 w; w.x = cvt_pk_bf16(z[0], z[1]); w.y = cvt_pk_bf16(z[2], z[3]);
        if (c < 3072) *(LAS u32x2*)(RKV + tt * 3072 + c) = w; else *(LAS u32x2*)(LI + tt * PLD + (c - 3072)) = w; }
    __syncthreads();
    const bf16* LT = (const bf16*)(a->ws + WS_LORAT) + (size_t)l * LORAT_L;
    _Float16* ST = (_Float16*)(a->ws + WS_STREAM); float* RV = (float*)(a->ws + WS_RV); float* RS = (float*)(a->ws + WS_RSCAL); float* RG = (float*)(a->ws + WS_RG); float* RB = (float*)(a->ws + WS_RBON);
    for (int hs = 0; hs < 2; ++hs) { const int hh = wv + 8 * hs;
        float inv[4] = {0.f, 0.f, 0.f, 0.f};
#pragma unroll
        for (int ct = 0; ct < 4; ++ct) { const int c = hh * 64 + ct * 16 + r16; const float kkw = a->in[I_RKK][l * DBR + c];
#pragma unroll
            for (int i = 0; i < 4; ++i) { const float kv = bf2f(RKV[(4 * q4 + i) * 3072 + 1024 + c]) * kkw; inv[i] += kv * kv; } }
#pragma unroll
        for (int i = 0; i < 4; ++i) inv[i] = 1.f / fmaxf(sqrtf(rowsum16(inv[i])), 1e-12f);
        float brp[2][4], krp[2][4], bd[4], vkeep[4][4];
#pragma unroll
        for (int i = 0; i < 4; ++i) { bd[i] = 0.f; brp[0][i] = 0.f; brp[1][i] = 0.f; krp[0][i] = 0.f; krp[1][i] = 0.f; }
#pragma unroll
        for (int ct = 0; ct < 4; ++ct) { const int cc = ct * 16 + r16, c = hh * 64 + cc;
            f32x4 accW[2], accA[2], accG = {0.f, 0.f, 0.f, 0.f};
#pragma unroll
            for (int d = 0; d < 2; ++d) { accW[d] = (f32x4){0.f, 0.f, 0.f, 0.f}; accA[d] = (f32x4){0.f, 0.f, 0.f, 0.f};
#pragma unroll
                for (int ks = 0; ks < 2; ++ks) {
                    accW[d] = mfma16(*(const LAS bf16x8*)(LI + r16 * PLD + d * 64 + 32 * ks + 8 * q4), *(const bf16x8*)(LT + ((size_t)d * 1024 + c) * 64 + 32 * ks + 8 * q4), accW[d]);
                    accA[d] = mfma16(*(const LAS bf16x8*)(LI + r16 * PLD + 128 + d * 64 + 32 * ks + 8 * q4), *(const bf16x8*)(LT + LORAT_A + ((size_t)d * 1024 + c) * 64 + 32 * ks + 8 * q4), accA[d]); } }
#pragma unroll
            for (int ks = 0; ks < 5; ++ks) accG = mfma16(*(const LAS bf16x8*)(LI + r16 * PLD + 256 + 32 * ks + 8 * q4), *(const bf16x8*)(LT + LORAT_G + (size_t)c * 160 + 32 * ks + 8 * q4), accG);
            const float kkw = a->in[I_RKK][l * DBR + c], ka_w = a->in[I_RKA][l * DBR + c], rk_w = a->in[I_RRK][l * DBR + c];
            const float w0a = a->in[I_RW0][(l * 2 + 0) * DBR + c], w0b = a->in[I_RW0][(l * 2 + 1) * DBR + c], a0a = a->in[I_RA0][(l * 2 + 0) * DBR + c], a0b = a->in[I_RA0][(l * 2 + 1) * DBR + c];
#pragma unroll
            for (int i = 0; i < 4; ++i) { const int t = 4 * q4 + i; const bool valid = t < PT; const int P = P0 + t;
                const float r = bf2f(RKV[t * 3072 + c]), k = bf2f(RKV[t * 3072 + 1024 + c]), v = bf2f(RKV[t * 3072 + 2048 + c]);
                const float kk = k * kkw * inv[i];
                float kd[2];
#pragma unroll
                for (int d = 0; d < 2; ++d) {
                    const float wdec = expf(-0.6065306597126334f * sigmoidf_((d ? w0b : w0a) + accW[d][i]));
                    const float ain = sigmoidf_((d ? a0b : a0a) + accA[d][i]);
                    kd[d] = k * (1.f + (ain - 1.f) * ka_w);
                    const float bb = kk * ain;
                    if (valid) { _Float16* sp = ST + ((((size_t)d * 16 + hh) * ROWS + P) * 5) * 64 + cc; sp[0] = (_Float16)wdec; sp[64] = (_Float16)bb; sp[128] = (_Float16)kd[d]; sp[192] = (_Float16)kk; sp[256] = (_Float16)(wdec * r); }
                    brp[d][i] += bb * r; krp[d][i] += kd[d] * r; }
                bd[i] += r * (kd[0] + kd[1]) * rk_w;
                if (valid) { RV[(size_t)P * DBR + c] = v; RG[(size_t)P * DBR + c] = accG[i]; }
                vkeep[ct][i] = v; } }
#pragma unroll
        for (int i = 0; i < 4; ++i) { const int t = 4 * q4 + i; const bool valid = t < PT; const int P = P0 + t;
#pragma unroll
            for (int d = 0; d < 2; ++d) { const float br = rowsum16(brp[d][i]), kr = rowsum16(krp[d][i]);
                if (valid && r16 == 0) { float* q = RS + (((size_t)d * 16 + hh) * ROWS + P) * 2; q[0] = br; q[1] = kr; } }
            const float bdt = rowsum16(bd[i]);
            if (valid) {
#pragma unroll
                for (int ct = 0; ct < 4; ++ct) RB[(size_t)P * DBR + hh * 64 + ct * 16 + r16] = bdt * vkeep[ct][i]; } }
    }
}
constexpr int RW_CH = 32, RW_ROWS = 16, RW_NLD = 256, RW_CHB = RW_CH * 1280 + RW_CH * RW_ROWS * 4 + RW_CH * 8;
DI int rw_stepP(int d, int n) { return d == 0 ? n : (n < CTX ? CTX - 1 - n : ROWS + CTX - 1 - n); }
struct RwRegs { f32x4 m[5]; float v[2], sc; };
DI void rw_issue(RwRegs& R, int c, int d, int lt, const _Float16* ST, const float* RV, const float* RS) {
    const int n0 = c * RW_CH; const int Pa = rw_stepP(d, n0), Pb = rw_stepP(d, n0 + RW_CH - 1); const int Pmin = Pa < Pb ? Pa : Pb;
    const f32x4* src = (const f32x4*)(ST + (size_t)Pmin * 320);
#pragma unroll
    for (int k = 0; k < 5; ++k) R.m[k] = src[lt + RW_NLD * k];
#pragma unroll
    for (int k = 0; k < 2; ++k) { const int i = lt + RW_NLD * k; R.v[k] = RV[(size_t)(Pmin + (i >> 4)) * DBR + (i & 15)]; }
    if (lt < RW_CH * 2) R.sc = RS[(size_t)Pmin * 2 + lt];
}
DI void rw_commit(const RwRegs& R, int c, int d, int lt, LAS unsigned char* lds) {
    LAS float* buf = (LAS float*)(lds + (c % 3) * RW_CHB);
    const bool desc = d != 0;
#pragma unroll
    for (int k = 0; k < 5; ++k) { const int i = lt + RW_NLD * k, st = i / 40, w = i - 40 * st; const f16x8 h = __builtin_bit_cast(f16x8, R.m[k]);
        LAS float* q = buf + (desc ? RW_CH - 1 - st : st) * 320 + 8 * w;
        *(LAS f32x4*)q = (f32x4){(float)h[0], (float)h[1], (float)h[2], (float)h[3]}; *(LAS f32x4*)(q + 4) = (f32x4){(float)h[4], (float)h[5], (float)h[6], (float)h[7]}; }
#pragma unroll
    for (int k = 0; k < 2; ++k) { const int i = lt + RW_NLD * k, st = i >> 4; buf[RW_CH * 320 + (desc ? RW_CH - 1 - st : st) * RW_ROWS + (i & 15)] = R.v[k]; }
    if (lt < RW_CH * 2) { const int st = lt >> 1; buf[RW_CH * 320 + RW_CH * RW_ROWS + (desc ? RW_CH - 1 - st : st) * 2 + (lt & 1)] = R.sc; }
}
DI void rwkv_scan(AP a, int item, LAS unsigned char* lds) {
    const int tid = otid(), lane = tid & 63, wv = tid >> 6;
    const int hd = item >> 2, d = hd >> 4, hh = hd & 15, rb = item & 3;
    const _Float16* ST = (const _Float16*)(a->ws + WS_STREAM) + (((size_t)d * 16 + hh) * ROWS) * 320;
    const float* RV = (const float*)(a->ws + WS_RV) + hh * 64 + rb * RW_ROWS; const float* RS = (const float*)(a->ws + WS_RSCAL) + (((size_t)d * 16 + hh) * ROWS) * 2;
    float* RY = (float*)(a->ws + WS_RY) + (size_t)d * ROWS * DBR + hh * 64 + rb * RW_ROWS;
    constexpr int NCHUNK = ROWS / RW_CH;
    __syncthreads();
    RwRegs R; const int lt = tid - 256;
    if (wv >= 4) { rw_issue(R, 0, d, lt, ST, RV, RS); rw_commit(R, 0, d, lt, lds); rw_issue(R, 1, d, lt, ST, RV, RS); rw_commit(R, 1, d, lt, lds); rw_issue(R, 2, d, lt, ST, RV, RS); }
    __syncthreads();
    f32x4 S = {0.f, 0.f, 0.f, 0.f};
    const int jg = lane & 15, rg = lane >> 4, vrow = wv * 4 + rg;
    for (int c = 0; c < NCHUNK; ++c) {
        if (wv >= 4) { if (c + 2 < NCHUNK) rw_commit(R, c + 2, d, lt, lds); if (c + 3 < NCHUNK) rw_issue(R, c + 3, d, lt, ST, RV, RS); }
        else {
            const LAS float* buf = (const LAS float*)(lds + (c % 3) * RW_CHB);
            const int n0 = c * RW_CH; const int Pa = rw_stepP(d, n0); const bool desc = rw_stepP(d, n0 + RW_CH - 1) < Pa; const int Pmin = desc ? Pa - (RW_CH - 1) : Pa;
#define RW_LD(st_, W4, B4, K4, KK4, WR4, V, SC) do { const LAS float* sb_ = buf + (st_) * 320 + 4 * jg; \
                W4 = *(const LAS f32x4*)(sb_); B4 = *(const LAS f32x4*)(sb_ + 64); K4 = *(const LAS f32x4*)(sb_ + 128); KK4 = *(const LAS f32x4*)(sb_ + 192); WR4 = *(const LAS f32x4*)(sb_ + 256); \
                V = buf[RW_CH * 320 + (st_) * RW_ROWS + vrow]; SC = *(const LAS f32x2*)(buf + RW_CH * 320 + RW_CH * RW_ROWS + (st_) * 2); } while (0)
#define RW_STEP(st_, W4, B4, K4, KK4, WR4, V, SC) do { \
                const f32x2 slo_ = {S[0], S[1]}, shi_ = {S[2], S[3]}; \
                const f32x2 da_ = slo_ * (f32x2){KK4[0], KK4[1]} + shi_ * (f32x2){KK4[2], KK4[3]}, dy_ = slo_ * (f32x2){WR4[0], WR4[1]} + shi_ * (f32x2){WR4[2], WR4[3]}; \
                const f32x4 t_ = S * W4 + K4 * V;                   \
                float pa_ = da_.x + da_.y, py_ = dy_.x + dy_.y; \
                pa_ = rowsum16(pa_); py_ = rowsum16(py_); const float y_ = py_ - pa_ * SC.x + V * SC.y; \
                S = t_ - B4 * pa_; ykeep = (jg == ((st_) & 15)) ? y_ : ykeep; } while (0)
            f32x4 wA, bA, kA, kkA, wrA, wB, bB, kB, kkB, wrB; float vA, vB; f32x2 scA, scB; float ykeep = 0.f;
            RW_LD(0, wA, bA, kA, kkA, wrA, vA, scA);
#pragma unroll
            for (int s = 0; s < RW_CH; s += 2) {
                RW_LD(s + 1, wB, bB, kB, kkB, wrB, vB, scB);
                RW_STEP(s, wA, bA, kA, kkA, wrA, vA, scA);
                if (s + 2 < RW_CH) RW_LD(s + 2, wA, bA, kA, kkA, wrA, vA, scA);
                RW_STEP(s + 1, wB, bB, kB, kkB, wrB, vB, scB);
                if ((s & 15) == 14) { const int st_l = (s & 16) + jg; const int ls_l = desc ? RW_CH - 1 - st_l : st_l; RY[(size_t)(Pmin + ls_l) * DBR + vrow] = ykeep; }
            }
#undef RW_LD
#undef RW_STEP
        }
        __syncthreads();
    }
}
DI void phase_mixer_post(AP a, int l, int bid, int G) {
    const int tid = otid(), lane = tid & 63, wave = tid >> 6;
    bf16* YS = (bf16*)(a->ws + WS_YS);
    const float* HD = (const float*)(a->ws + WS_HDIR); const bf16* ZA = (const bf16*)(a->ws + WS_ZA); const float* mn = a->in[I_MNORM] + (size_t)l * DBR;
    const bool lastl = (l == NL - 1);
    if (EN_MLSTM) for (int row = bid * NWAVES + wave; row < (lastl ? SEQ : ROWS); row += G * NWAVES) {
        const int c0 = lane * 16; f32x4 y[4]; float ss = 0.f;
#pragma unroll
        for (int e = 0; e < 4; ++e) { y[e] = *(const f32x4*)(HD + (size_t)row * DBR + c0 + 4 * e) + *(const f32x4*)(HD + (size_t)(ROWS + row) * DBR + c0 + 4 * e); ss += y[e][0] * y[e][0] + y[e][1] * y[e][1] + y[e][2] * y[e][2] + y[e][3] * y[e][3]; }
        ss += __shfl_xor(ss, 1); ss += __shfl_xor(ss, 2); ss += __shfl_xor(ss, 4);
        const float rs = rsqrtf(ss * (1.f / 128.f) + NORM_EPS);
        const u32x4 o0 = *(const u32x4*)(ZA + (size_t)row * NA_P + 2048 + c0), o1 = *(const u32x4*)(ZA + (size_t)row * NA_P + 2048 + c0 + 8);
        const unsigned ow[8] = {o0.x, o0.y, o0.z, o0.w, o1.x, o1.y, o1.z, o1.w};
        f32x4 r[4];
#pragma unroll
        for (int e = 0; e < 4; ++e) { const f32x4 g = *(const f32x4*)(mn + c0 + 4 * e);
            r[e][0] = y[e][0] * rs * g[0] * sigmoidf_(__uint_as_float(ow[2 * e] << 16)); r[e][1] = y[e][1] * rs * g[1] * sigmoidf_(__uint_as_float(ow[2 * e] & 0xffff0000u));
            r[e][2] = y[e][2] * rs * g[2] * sigmoidf_(__uint_as_float(ow[2 * e + 1] << 16)); r[e][3] = y[e][3] * rs * g[3] * sigmoidf_(__uint_as_float(ow[2 * e + 1] & 0xffff0000u)); }
        { u32x4 w; w.x = pk4_fp8(r[0][0] * 8.f, r[0][1] * 8.f, r[0][2] * 8.f, r[0][3] * 8.f); w.y = pk4_fp8(r[1][0] * 8.f, r[1][1] * 8.f, r[1][2] * 8.f, r[1][3] * 8.f);
          w.z = pk4_fp8(r[2][0] * 8.f, r[2][1] * 8.f, r[2][2] * 8.f, r[2][3] * 8.f); w.w = pk4_fp8(r[3][0] * 8.f, r[3][1] * 8.f, r[3][2] * 8.f, r[3][3] * 8.f);
          *(u32x4*)(a->ws + WS_YS8 + (size_t)row * DBR + c0) = w; }
    }
    const float* RY = (const float*)(a->ws + WS_RY); const float* RG = (const float*)(a->ws + WS_RG); const float* RB = (const float*)(a->ws + WS_RBON);
    const float* lw = a->in[I_RLNW] + (size_t)l * DBR; const float* lb = a->in[I_RLNB] + (size_t)l * DBR;
    bf16* YR = YS + (size_t)2 * ROWS * DBR;
    if (EN_RWKV) for (int P = (lastl ? CTX : 0) + bid * NWAVES + wave; P < ROWS; P += G * NWAVES) {
        const int c0 = lane * 16; f32x4 y[4]; float sm = 0.f;
#pragma unroll
        for (int e = 0; e < 4; ++e) { y[e] = *(const f32x4*)(RY + (size_t)P * DBR + c0 + 4 * e) + *(const f32x4*)(RY + (size_t)(ROWS + P) * DBR + c0 + 4 * e); sm += y[e][0] + y[e][1] + y[e][2] + y[e][3]; }
        sm += __shfl_xor(sm, 1); sm += __shfl_xor(sm, 2);
        const float mean = sm * (1.f / 64.f); float sv = 0.f;
#pragma unroll
        for (int e = 0; e < 4; ++e) { y[e] = y[e] - mean; sv += y[e][0] * y[e][0] + y[e][1] * y[e][1] + y[e][2] * y[e][2] + y[e][3] * y[e][3]; }
        sv += __shfl_xor(sv, 1); sv += __shfl_xor(sv, 2);
        const float rs = rsqrtf(sv * (1.f / 64.f) + 64e-5f);
        f32x4 r[4];
#pragma unroll
        for (int e = 0; e < 4; ++e) r[e] = (y[e] * rs * *(const f32x4*)(lw + c0 + 4 * e) + *(const f32x4*)(lb + c0 + 4 * e) + *(const f32x4*)(RB + (size_t)P * DBR + c0 + 4 * e)) * *(const f32x4*)(RG + (size_t)P * DBR + c0 + 4 * e);
        const int row = rw_row(P);
        { u32x4 w; w.x = pk4_fp8(r[0][0] * 8.f, r[0][1] * 8.f, r[0][2] * 8.f, r[0][3] * 8.f); w.y = pk4_fp8(r[1][0] * 8.f, r[1][1] * 8.f, r[1][2] * 8.f, r[1][3] * 8.f);
          w.z = pk4_fp8(r[2][0] * 8.f, r[2][1] * 8.f, r[2][2] * 8.f, r[2][3] * 8.f); w.w = pk4_fp8(r[3][0] * 8.f, r[3][1] * 8.f, r[3][2] * 8.f, r[3][3] * 8.f);
          *(u32x4*)(a->ws + WS_YS8 + ((size_t)ROWS + row) * DBR + c0) = w; }
    }
}

DI void phase_moe_route(AP a, int l, LAS unsigned char* lds, int bid, int G) {
    const int tid = otid(), lane = tid & 63, wave = tid >> 6, r = lane & 15, q = lane >> 4;
    const bf16* XR = (const bf16*)(a->ws + WS_XRES); bf16* H = (bf16*)(a->ws + WS_H);
    const float* gn = a->in[I_NMOE] + (size_t)l * D; const float* WRT = (const float*)(a->ws + WS_WRT) + (size_t)l * NEXP * D;
    int* EIDX = (int*)(a->ws + WS_MOE + MOE_EIDX); float* EW = (float*)(a->ws + WS_MOE + MOE_EW); int* SLOTTOK = (int*)(a->ws + WS_MOE + MOE_SLOTTOK);
    LAS int* hist = (LAS int*)(lds + 8 * 2304);
    __syncthreads();
    if (tid < NEXP) hist[tid] = 0;
    __syncthreads();
    for (int i = bid * NTHR + tid; i < NSLOT; i += G * NTHR) SLOTTOK[i] = 0;
    LAS float* lg = (LAS float*)(lds + wave * 2304);
    LAS float* ssp = (LAS float*)(lds + 8 * 2304 + 256);
    const int qd = wave >> 2, part = wave & 3, jj0 = 32 * part;
    const int nrg = (l == NL - 1) ? SEQ / 16 : ROWS / 16;
    for (int rg0 = bid * 2; rg0 < nrg; rg0 += G * 2) {
        const int rg = rg0 + qd; const bool act = rg < nrg;
        const int row = (act ? rg : 0) * 16 + r; const int isc = row >= SEQ;
        const bf16* xr = XR + (size_t)row * D + 8 * q;
        const float* mod = (const float*)(a->ws + WS_MOD) + ((size_t)l * 2 + isc) * 6 * D + 3 * D;
        float ss = 0.f;
        if (act) {
#pragma unroll 4
            for (int jj = jj0; jj < jj0 + 32; ++jj) { f32x4 x0, x1; unpack8(*(const u32x4*)(xr + 32 * jj), x0, x1);
                ss += x0[0] * x0[0] + x0[1] * x0[1] + x0[2] * x0[2] + x0[3] * x0[3] + x1[0] * x1[0] + x1[1] * x1[1] + x1[2] * x1[2] + x1[3] * x1[3]; } }
        ss += __shfl_xor(ss, 16); ss += __shfl_xor(ss, 32);
        if (lane < 16) ssp[wave * 16 + lane] = ss;
        __syncthreads();
        ss = ssp[(qd * 4 + 0) * 16 + r] + ssp[(qd * 4 + 1) * 16 + r] + ssp[(qd * 4 + 2) * 16 + r] + ssp[(qd * 4 + 3) * 16 + r];
        const float rs = rsqrtf(ss * (1.f / D) + NORM_EPS);
        f32x4 acc0 = {0.f, 0.f, 0.f, 0.f}, acc1 = {0.f, 0.f, 0.f, 0.f};
        if (act) {
#pragma unroll 2
            for (int jj = jj0; jj < jj0 + 32; ++jj) { const int c = 32 * jj + 8 * q;
                f32x4 hv[2], xx[2]; unpack8(*(const u32x4*)(xr + 32 * jj), xx[0], xx[1]);
#pragma unroll
                for (int e = 0; e < 2; ++e) { const f32x4 x = xx[e], g = *(const f32x4*)(gn + c + 4 * e), sh = *(const f32x4*)(mod + c + 4 * e), sc = *(const f32x4*)(mod + D + c + 4 * e);
                    hv[e] = (x * rs) * g * (sc + 1.f) + sh; }
                { u32x2 h8; h8.x = pk4_fp8(hv[0][0] * 4.f, hv[0][1] * 4.f, hv[0][2] * 4.f, hv[0][3] * 4.f); h8.y = pk4_fp8(hv[1][0] * 4.f, hv[1][1] * 4.f, hv[1][2] * 4.f, hv[1][3] * 4.f);
                  *(u32x2*)((unsigned char*)H + (size_t)row * D + c) = h8; }
                const f32x4 wa0 = *(const f32x4*)(WRT + (size_t)r * D + c), wa1 = *(const f32x4*)(WRT + (size_t)r * D + c + 4), wb0 = *(const f32x4*)(WRT + (size_t)(16 + r) * D + c), wb1 = *(const f32x4*)(WRT + (size_t)(16 + r) * D + c + 4);
#pragma unroll
                for (int e = 0; e < 4; ++e) { acc0 = __builtin_amdgcn_mfma_f32_16x16x4f32(hv[0][e], wa0[e], acc0, 0, 0, 0); acc1 = __builtin_amdgcn_mfma_f32_16x16x4f32(hv[0][e], wb0[e], acc1, 0, 0, 0); }
#pragma unroll
                for (int e = 0; e < 4; ++e) { acc0 = __builtin_amdgcn_mfma_f32_16x16x4f32(hv[1][e], wa1[e], acc0, 0, 0, 0); acc1 = __builtin_amdgcn_mfma_f32_16x16x4f32(hv[1][e], wb1[e], acc1, 0, 0, 0); } } }
#pragma unroll
        for (int i = 0; i < 4; ++i) { lg[(4 * q + i) * 36 + r] = acc0[i]; lg[(4 * q + i) * 36 + 16 + r] = acc1[i]; }
        __syncthreads();
        if (act && part == 0 && lane < 16) { float v[NEXP];
            const LAS float* l0 = (const LAS float*)(lds + (qd * 4) * 2304) + lane * 36;
#pragma unroll
            for (int e = 0; e < NEXP; ++e) v[e] = ((l0[e] + l0[576 + e]) + (l0[1152 + e] + l0[1728 + e])) + a->in[I_RTB][l * NEXP + e];
            int bi[4]; float bv[4];
#pragma unroll
            for (int k = 0; k < 4; ++k) { float best = -3.0e38f; int be = 0;
#pragma unroll
                for (int e = 0; e < NEXP; ++e) { const bool taken = (k > 0 && bi[0] == e) || (k > 1 && bi[1] == e) || (k > 2 && bi[2] == e); if (!taken && v[e] > best) { best = v[e]; be = e; } }
                bi[k] = be; bv[k] = best; }
            const float e1 = __expf(bv[1] - bv[0]), e2 = __expf(bv[2] - bv[0]), e3 = __expf(bv[3] - bv[0]); const float inv = 1.f / (1.f + e1 + e2 + e3);
            const int rr = rg * 16 + lane;
            *(int4*)(EIDX + (size_t)rr * 4) = make_int4(bi[0], bi[1], bi[2], bi[3]);
            *(f32x4*)(EW + (size_t)rr * 4) = (f32x4){inv, e1 * inv, e2 * inv, e3 * inv};
#pragma unroll
            for (int k = 0; k < 4; ++k) __hip_atomic_fetch_add(hist + bi[k], 1, __ATOMIC_RELAXED, __HIP_MEMORY_SCOPE_WORKGROUP); }
        __syncthreads();
    }
    __syncthreads();
    if (tid < NEXP) ((int*)(a->ws + WS_MOE + MOE_CNTW))[bid * NEXP + tid] = hist[tid];
}
DI void phase_moe_slots(AP a, int l, LAS unsigned char* lds, int bid, int G) {
    const int tid = otid();
    LAS int* red = (LAS int*)lds;
    LAS int* base = red + 1024;
    LAS int* lc = base + 32;
    const int* CNTW = (const int*)(a->ws + WS_MOE + MOE_CNTW);
    const int* EIDX = (const int*)(a->ws + WS_MOE + MOE_EIDX); int* TOKSLOT = (int*)(a->ws + WS_MOE + MOE_TOKSLOT); int* SLOTTOK = (int*)(a->ws + WS_MOE + MOE_SLOTTOK); int* TILEE = (int*)(a->ws + WS_MOE + MOE_TILEE);
    __syncthreads();
    { const int e = tid & 31, part = tid >> 5; int tot = 0, pre = 0;
      for (int b = part; b < G; b += 16) { const int c = CNTW[b * NEXP + e]; tot += c; pre += (b < bid) ? c : 0; }
      red[part * 32 + e] = tot; red[512 + part * 32 + e] = pre; }
    __syncthreads();
    if (tid < NEXP) { int tot = 0, pre = 0;
#pragma unroll
        for (int p2 = 0; p2 < 16; ++p2) { tot += red[p2 * 32 + tid]; pre += red[512 + p2 * 32 + tid]; }
        red[tid] = tot; red[512 + tid] = pre; }
    __syncthreads();
    if (tid == 0) { int acc = 0; for (int e = 0; e < NEXP; ++e) { base[e] = acc * 256 + red[512 + e]; lc[e] = 0; const int nt = (red[e] + 255) >> 8; if (bid == 0) for (int t = 0; t < nt; ++t) TILEE[1 + acc + t] = e; acc += nt; } if (bid == 0) TILEE[0] = acc; }
    __syncthreads();
    const int nrg = (l == NL - 1) ? SEQ / 16 : ROWS / 16;
    for (int rg0 = bid * 2; rg0 < nrg; rg0 += G * 2) {
        const int rg = rg0 + (tid >> 6); if ((tid >> 6) < 2 && rg < nrg) { const int i = rg * 64 + (tid & 63); const int e = EIDX[i];
            const int slot = base[e] + __hip_atomic_fetch_add(lc + e, 1, __ATOMIC_RELAXED, __HIP_MEMORY_SCOPE_WORKGROUP); TOKSLOT[i] = slot; SLOTTOK[slot] = i >> 2; } }
}
struct MoeGU {
    static constexpr bool GATHER = true, FP8 = true;
    int K, G, c, ntile; const char* Hb; const char* Wb; const int* SLOTTOK; const int* TILEE; const float* bgu; unsigned char* ACT;
    DI bool next(int i, Unit& u) const { const long L = (long)i * G + c; if (L >= (long)ntile * 4) return false; u.pm = (int)(L >> 2); u.pn = (int)(L & 3); u.aux = TILEE[1 + u.pm]; return true; }
    DI const char* a_ptr(const Unit&) const { return Hb; }
    DI const char* b_ptr(const Unit& u) const { return Wb + ((size_t)u.aux * 1024 + (size_t)u.pn * 256) * D; }
    DI unsigned a_row_off(const Unit& u, int r) const { return (unsigned)SLOTTOK[u.pm * 256 + r] * (unsigned)D; }
    DI void epi(const f32x4 (&acc)[2][2][4][2], const Unit& u, int wr, int wc, int fr, int fq) const {
        const float* bb = bgu + (size_t)u.aux * 1024 + u.pn * 256;
        f32x4 bv[2][2];
        _Pragma("unroll") for (int bj = 0; bj < 2; ++bj) { const int cl = bj * 128 + wc * 32 + 8 * fq; bv[bj][0] = *(const f32x4*)(bb + cl); bv[bj][1] = *(const f32x4*)(bb + cl + 4); }
        EPI_LOOP({ const f32x4 x0 = v0 * (1.f / 2048.f) + bv[bj][0], x1 = v1 * (1.f / 2048.f) + bv[bj][1];
                   float o[4];
                   _Pragma("unroll") for (int e = 0; e < 4; ++e) { const float gv = e < 2 ? x0[2 * e] : x1[2 * (e - 2)], lv = e < 2 ? x0[2 * e + 1] : x1[2 * (e - 2) + 1];
                       const float glu = fminf(gv, 7.f), lin = fminf(fmaxf(lv, -7.f), 7.f); o[e] = glu * sigmoidf_(1.702f * glu) * (lin + 1.f); }
                   *(unsigned*)(ACT + (size_t)(u.pm * 256 + rl) * DEXP + (u.pn * 256 + cl) / 2) = pk4_fp8(o[0] * 4.f, o[1] * 4.f, o[2] * 4.f, o[3] * 4.f); })
    }
};
struct MoeDown {
    static constexpr bool GATHER = false, FP8 = true;
    int K, G, c, ntile; const char* Ab; const char* Wb; const int* TILEE; const float* bdn; unsigned char* YSLOT;
    DI bool next(int i, Unit& u) const { const long L = (long)i * G + c; if (L >= (long)ntile * 16) return false; u.pm = (int)(L >> 4); u.pn = (int)(L & 15); u.aux = TILEE[1 + u.pm]; return true; }
    DI const char* a_ptr(const Unit& u) const { return Ab + (size_t)u.pm * 256 * DEXP; }
    DI const char* b_ptr(const Unit& u) const { return Wb + ((size_t)u.aux * D + (size_t)u.pn * 256) * DEXP; }
    DI unsigned a_row_off(const Unit&, int) const { return 0u; }
    DI void epi(const f32x4 (&acc)[2][2][4][2], const Unit& u, int wr, int wc, int fr, int fq) const {
        const float* bb = bdn + (size_t)u.aux * D + u.pn * 256;
        f32x4 bv[2][2];
        _Pragma("unroll") for (int bj = 0; bj < 2; ++bj) { const int cl = bj * 128 + wc * 32 + 8 * fq; bv[bj][0] = *(const f32x4*)(bb + cl); bv[bj][1] = *(const f32x4*)(bb + cl + 4); }
        EPI_LOOP({ const f32x4 y0 = (v0 * (1.f / 1024.f) + bv[bj][0]) * 8.f, y1 = (v1 * (1.f / 1024.f) + bv[bj][1]) * 8.f;
                   u32x2 w; w.x = pk4_fp8(y0[0], y0[1], y0[2], y0[3]); w.y = pk4_fp8(y1[0], y1[1], y1[2], y1[3]);
                   *(u32x2*)(YSLOT + (size_t)(u.pm * 256 + rl) * D + u.pn * 256 + cl) = w; })
    }
};
DI void phase_moe_combine(AP a, int l, LAS unsigned char* lds, int bid, int G) {
    const int tid = otid(), lane = tid & 63, wave = tid >> 6;
    LAS float* xrow = (LAS float*)(lds + wave * 16384);
    bf16* XR = (bf16*)(a->ws + WS_XRES); const unsigned char* YSLOT = a->ws + WS_YSLOT; bf16* H = (bf16*)(a->ws + WS_H);
    const int* TOKSLOT = (const int*)(a->ws + WS_MOE + MOE_TOKSLOT); const float* EW = (const float*)(a->ws + WS_MOE + MOE_EW);
    const bool last = (l == NL - 1); const int nrows = last ? SEQ : ROWS;
    const float* gn = last ? a->in[I_NFIN] : a->in[I_NMIX] + (size_t)(l + 1) * D;
    for (int row = bid * NWAVES + wave; row < nrows; row += G * NWAVES) {
        const int isc = row >= SEQ;
        const float* g2 = (const float*)(a->ws + WS_MOD) + ((size_t)l * 2 + isc) * 6 * D + 5 * D;
        const float* modn = (const float*)(a->ws + WS_MOD) + ((size_t)(last ? l : l + 1) * 2 + isc) * 6 * D;
        const int4 sl = *(const int4*)(TOKSLOT + (size_t)row * 4); const f32x4 ww = *(const f32x4*)(EW + (size_t)row * 4);
        const int sls[4] = {sl.x, sl.y, sl.z, sl.w};
        float ss = 0.f;
#pragma unroll 1
        for (int jb = 0; jb < 4; ++jb) {
            u32x2 y[2][4]; u32x4 xr[2]; f32x4 ga[2], gb[2];
#pragma unroll
            for (int jj = 0; jj < 2; ++jj) { const int c = 8 * (lane + 64 * (2 * jb + jj));
#pragma unroll
                for (int k = 0; k < 4; ++k) y[jj][k] = *(const u32x2*)(YSLOT + (size_t)sls[k] * D + c);
                xr[jj] = *(const u32x4*)(XR + (size_t)row * D + c); ga[jj] = *(const f32x4*)(g2 + c); gb[jj] = *(const f32x4*)(g2 + c + 4); }
#pragma unroll
            for (int jj = 0; jj < 2; ++jj) { const int j = 2 * jb + jj; const int c = 8 * (lane + 64 * j);
                f32x4 s0 = {0.f, 0.f, 0.f, 0.f}, s1 = {0.f, 0.f, 0.f, 0.f};
#pragma unroll
                for (int k = 0; k < 4; ++k) { const u32x2 yy = y[jj][k]; const float wk = ww[k] * 0.125f;
                    const f32x2 a0 = __builtin_amdgcn_cvt_pk_f32_fp8((int)yy.x, false), a1 = __builtin_amdgcn_cvt_pk_f32_fp8((int)yy.x, true), a2 = __builtin_amdgcn_cvt_pk_f32_fp8((int)yy.y, false), a3 = __builtin_amdgcn_cvt_pk_f32_fp8((int)yy.y, true);
                    s0[0] += wk * a0.x; s0[1] += wk * a0.y; s0[2] += wk * a1.x; s0[3] += wk * a1.y; s1[0] += wk * a2.x; s1[1] += wk * a2.y; s1[2] += wk * a3.x; s1[3] += wk * a3.y; }
                f32x4 xa, xb; unpack8(xr[jj], xa, xb);
                const f32x4 x0 = xa + ga[jj] * s0, x1 = xb + gb[jj] * s1;
                *(LAS f32x4*)(xrow + c) = x0; *(LAS f32x4*)(xrow + c + 4) = x1;
                if (!last) *(u32x4*)(XR + (size_t)row * D + c) = pack8(x0, x1);
                ss += x0[0] * x0[0] + x0[1] * x0[1] + x0[2] * x0[2] + x0[3] * x0[3] + x1[0] * x1[0] + x1[1] * x1[1] + x1[2] * x1[2] + x1[3] * x1[3]; }
        }
        const float rs = rsqrtf(wave_sum(ss) * (1.f / D) + NORM_EPS);
#pragma unroll 1
        for (int jb = 0; jb < 4; ++jb) {
            f32x4 g0[2], g1[2], sh0[2], sh1[2], sc0[2], sc1[2];
#pragma unroll
            for (int jj = 0; jj < 2; ++jj) { const int c = 8 * (lane + 64 * (2 * jb + jj));
                g0[jj] = *(const f32x4*)(gn + c); g1[jj] = *(const f32x4*)(gn + c + 4);
                if (!last) { sh0[jj] = *(const f32x4*)(modn + c); sh1[jj] = *(const f32x4*)(modn + c + 4); sc0[jj] = *(const f32x4*)(modn + D + c); sc1[jj] = *(const f32x4*)(modn + D + c + 4); } }
#pragma unroll
            for (int jj = 0; jj < 2; ++jj) { const int j = 2 * jb + jj; const int c = 8 * (lane + 64 * j);
                const f32x4 x0 = *(const LAS f32x4*)(xrow + c), x1 = *(const LAS f32x4*)(xrow + c + 4);
                if (last) { *(f32x4*)(a->out + (size_t)row * D + c) = (x0 * rs) * g0[jj]; *(f32x4*)(a->out + (size_t)row * D + c + 4) = (x1 * rs) * g1[jj]; }
                else { const f32x4 h0 = (x0 * rs) * g0[jj] * (sc0[jj] + 1.f) + sh0[jj], h1 = (x1 * rs) * g1[jj] * (sc1[jj] + 1.f) + sh1[jj];
                    *(u32x4*)(H + (size_t)row * D + c) = pack8(h0, h1);
                    u32x2 h8; h8.x = pk4_fp8(h0[0] * 4.f, h0[1] * 4.f, h0[2] * 4.f, h0[3] * 4.f); h8.y = pk4_fp8(h1[0] * 4.f, h1[1] * 4.f, h1[2] * 4.f, h1[3] * 4.f);
                    *(u32x2*)(a->ws + WS_H8 + (size_t)row * D + c) = h8; } }
        }
    }
}

__global__ void __launch_bounds__(NTHR, 2) mk_fwd(Args a_by_value) {
    AP a0 = (AP)__builtin_amdgcn_kernarg_segment_ptr();
    extern __shared__ __attribute__((aligned(16))) unsigned char lds_raw[];
    LAS unsigned char* lds = (LAS unsigned char*)lds_raw;
    volatile LAS unsigned* MISC = (volatile LAS unsigned*)(lds + MISC_OFF);
    const int tid = threadIdx.x, G = gridDim.x, bid = blockIdx.x;
    unsigned char* ws = a0->ws; const int ph_lo = a0->ph_lo, ph_hi = a0->ph_hi;
    for (int u = tid; u < (LDS_SMALL - LDSCTL_OFF) / 4; u += NTHR) ((LAS unsigned*)(lds + LDSCTL_OFF))[u] = 0u;
    __syncthreads();
    XcdBarrier bar; bar.bar = (unsigned*)(ws + WS_CTL) + 4096; bar.x = 0; bar.st = nullptr;
    if (!MK_MULTI) bar = xcd_barrier_post((unsigned*)(ws + WS_CTL) + 4096, MISC + 8);
    int ph = 0;
#ifndef PHMASK
#define PHMASK 0xffffffffu
#endif
#define PH(id, ...) { if (((PHMASK >> (id)) & 1u) && ph >= ph_lo && ph < ph_hi) { AP a = a0; asm volatile("" : "+s"(a)); unsigned char* ws = a->ws; __VA_ARGS__ } ++ph; if (!MK_MULTI) { XcdBarrier bb = bar; asm volatile("" : "+s"(bb.bar), "+s"(bb.x)); xcd_barrier(bb); } }

    PH(0, phase_prologue(a, lds, bid, G);)
    PH(1, phase_mod_reduce(a, bid, G);)
#define LAYER(l) \
        PH(2, if (l == 0 || !EN_MOE) phase_norm_mod(a, l, 0, l == 0, bid, G);) \
        PH(3, { \
            const bool lastl = (l == NL - 1); \
            InProj8 P; P.K = D; P.G = G; P.c = bid; P.lastl = lastl; P.Hb = (const char*)(ws + WS_H8); P.Wb = (const char*)(ws + WS_WIN8 + l * WIN8_L); \
            P.ZA = (bf16*)(ws + WS_ZA); P.GATES = (float*)(ws + WS_GATES); P.ZC = (bf16*)(ws + WS_ZC); P.SGp = (bf16*)(ws + WS_SG); \
            pg8::gemm_phase(lds, P); \
            const int u8 = lastl ? (NPAN - 1) * TF8 + TAC : NPAN * TF8;             \
            InProj16 Q; Q.K = D; Q.G = G; Q.c = (bid - u8 % G + G) % G; Q.nM = lastl ? NPAN - 1 : NPAN; Q.Hb = (const char*)(ws + WS_H); Q.Wb = (const char*)(ws + WS_WIN + l * WIN_L); \
            Q.ZBT = (float*)(ws + WS_ZBT); Q.SGp = (bf16*)(ws + WS_SG); \
            pg8::gemm_phase(lds, Q); }) \
        PH(4, { if (EN_RWKV) for (int it = bid; it < ROWS / PT; it += G) rwkv_prep_item(a, l, it, lds); }) \
        PH(5, { \
            if (G >= 192) { \
                if (bid < 128) { if (EN_RWKV) rwkv_scan(a, bid, lds); } \
                else if (bid < 144) { if (EN_MLSTM) mlstm_scan(a, l, (bid - 128) & 7, (bid - 128) >> 3, lds); } \
            } else { \
                if (EN_RWKV) for (int it = bid; it < 128; it += G) rwkv_scan(a, it, lds); \
                if (EN_MLSTM) for (int hdx = bid; hdx < 16; hdx += G) mlstm_scan(a, l, hdx & 7, hdx >> 3, lds); \
            } \
            { unsigned* hq = (unsigned*)(ws + WS_CTL) + CW_HQ + 64 * l; LAS int* qs = (LAS int*)(lds + LDS_SMALL + 2048); \
              for (;;) { __syncthreads(); if (threadIdx.x == 0) qs[0] = (int)__hip_atomic_fetch_add(hq, 1u, __ATOMIC_RELAXED, __HIP_MEMORY_SCOPE_AGENT); __syncthreads(); \
                  int it = qs[0]; \
                  {                          \
                      if (it < (CVQ_R + 1) * cvq_q(l)) { const int q = it / (CVQ_R + 1), r = it - q * (CVQ_R + 1); \
                          if (r != 0) { const int cc = CVQ_R * q + r - 1; if (cc < cvq_nch(l)) conv_chunk(a, cc, lds, l); continue; } \
                          it = q; } \
                      else it = cvq_q(l) + (it - (CVQ_R + 1) * cvq_q(l)); } \
                  if (it >= ((l == NL - 1) ? DBR : 2 * DBR)) break; \
                  const int seq = it >= DBR, ch = it & (DBR - 1); hyena_item(a, l, ch, seq, lds, ws + WS_HSCR + (size_t)bid * HSCR_WG); } } }) \
        PH(6, { phase_mixer_post(a, l, bid, G); phase_yb_transpose(a, lds, bid, G, (l == NL - 1) ? SEQ / 64 : ROWS / 64); }) \
        PH(7, { \
            const int nMb = (l == NL - 1) ? NPAN - 1 : NPAN; \
            BranchProj8 P; P.K = DBR; P.G = G; P.c = bid; P.nM = nMb; P.YS = (const char*)(ws + WS_YS8); P.Wb = (const char*)(ws + WS_WBR8 + (size_t)l * 2 * D * DBR); \
            P.SGp = (const bf16*)(ws + WS_SG); P.M32 = (bf16*)(ws + WS_MERGED); \
            pg8::gemm_phase(lds, P); \
            BranchProj16 Q; Q.K = DBR; Q.G = G; Q.c = bid; Q.nM = nMb; Q.YS = (const char*)(ws + WS_YS); Q.Wb = (const char*)(ws + WS_WBR + l * WBR_L); \
            Q.SGp = (const bf16*)(ws + WS_SG); Q.M32 = (const bf16*)(ws + WS_MERGED); Q.MERGED = (bf16*)(ws + WS_MERGED); \
            pg8::gemm_phase(lds, Q); }) \
        PH(8, { \
            OutProj P; P.K = D; P.G = G; P.c = bid; P.nM = (l == NL - 1) ? NPAN - 1 : NPAN; P.Ab = (const char*)(ws + WS_MERGED); P.Wb = (const char*)(ws + WS_WOUT + l * WOUT_L); \
            P.XR = (bf16*)(ws + WS_XRES); P.gate = (const float*)(ws + WS_MOD) + (size_t)l * 2 * 6 * D + 2 * D; P.xin = (l == 0) ? a->in[I_X] : nullptr; P.cin = (l == 0) ? a->in[I_CTX] : nullptr; \
            pg8::gemm_phase(lds, P); }) \
        PH(9, if (EN_MOE) phase_moe_route(a, l, lds, bid, G);) \
        PH(10, if (EN_MOE) phase_moe_slots(a, l, lds, bid, G);) \
        PH(11, if (EN_MOE) { \
            MoeGU P; P.K = D; P.G = G; P.c = bid; P.TILEE = (const int*)(ws + WS_MOE + MOE_TILEE); P.ntile = P.TILEE[0]; P.Hb = (const char*)(ws + WS_H); P.Wb = (const char*)(ws + WS_WGU + l * WGU_L); \
            P.SLOTTOK = (const int*)(ws + WS_MOE + MOE_SLOTTOK); P.bgu = a->in[I_EBGU] + (size_t)l * NEXP * 1024; P.ACT = ws + WS_ACT; \
            pg8::gemm_phase(lds, P); }) \
        PH(12, if (EN_MOE) { \
            MoeDown P; P.K = DEXP; P.G = G; P.c = bid; P.TILEE = (const int*)(ws + WS_MOE + MOE_TILEE); P.ntile = P.TILEE[0]; P.Ab = (const char*)(ws + WS_ACT); P.Wb = (const char*)(ws + WS_WDN + l * WDN_L); \
            P.bdn = a->in[I_EBDN] + (size_t)l * NEXP * D; P.YSLOT = ws + WS_YSLOT; \
            pg8::gemm_phase(lds, P); }) \
        PH(13, if (EN_MOE) phase_moe_combine(a, l, lds, bid, G);)
    LAYER(0)
    LAYER(1)
#undef LAYER
    PH(14, if (!EN_MOE) phase_final_norm(a, bid, G);)
}
constexpr int N_PHASES = 2 + NL * 12 + 1;

extern "C" void kernel_launch(void* const* d_in, const int* in_sizes, int n_in, void* d_out, int out_size, void* d_ws, size_t ws_size, hipStream_t stream) {
    static int grid = 0;
    if (grid == 0) {
        if (n_in != 40 || ws_size < WS_END0) { fprintf(stderr, "kernel_launch: unexpected n_in %d / ws %zu (need %zu)\n", n_in, ws_size, (size_t)WS_END0); grid = -1; return; }
        int dev = 0, cus = 0, per_cu = 0;
        if (hipGetDevice(&dev) != hipSuccess || hipDeviceGetAttribute(&cus, hipDeviceAttributeMultiprocessorCount, dev) != hipSuccess) { grid = -1; return; }
        if (hipFuncSetAttribute((const void*)mk_fwd, hipFuncAttributeMaxDynamicSharedMemorySize, LDS_BYTES) != hipSuccess) { fprintf(stderr, "kernel_launch: hipFuncSetAttribute failed\n"); grid = -1; return; }
        if (hipOccupancyMaxActiveBlocksPerMultiprocessor(&per_cu, (const void*)mk_fwd, NTHR, LDS_BYTES) != hipSuccess || per_cu < 1) { fprintf(stderr, "kernel_launch: occupancy query says %d\n", per_cu); }
        (void)hipGetLastError();
        grid = cus;
    }
    if (grid < 0) return;
    if (hipMemsetAsync((char*)d_ws + WS_CTL, 0, CTL_ZERO_BYTES, stream) != hipSuccess) return;
    Args a{};
    for (int i = 0; i < 40; ++i) a.in[i] = (const float*)d_in[i];
    a.out = (float*)d_out; a.ws = (unsigned char*)d_ws;
#if MK_MULTI
    for (int p = 0; p < N_PHASES; ++p) { a.ph_lo = p; a.ph_hi = p + 1; hipLaunchKernelGGL(mk_fwd, dim3(grid), dim3(NTHR), LDS_BYTES, stream, a); }
#else
    a.ph_lo = 0; a.ph_hi = N_PHASES;
    hipLaunchKernelGGL(mk_fwd, dim3(grid), dim3(NTHR), LDS_BYTES, stream, a);
#endif
}
```

```cpp
#include <hip/hip_runtime.h>
#include <cstdio>
#include <cstdint>

#define GAS __attribute__((address_space(1)))
#define LAS __attribute__((address_space(3)))
typedef unsigned short bf16;
typedef short bf16x8 __attribute__((ext_vector_type(8)));
typedef float f32x4 __attribute__((ext_vector_type(4)));
typedef float f32x2 __attribute__((ext_vector_type(2)));
typedef unsigned u32x4 __attribute__((ext_vector_type(4)));
typedef unsigned u32x2 __attribute__((ext_vector_type(2)));
typedef _Float16 f16x8 __attribute__((ext_vector_type(8)));
#define DI __device__ __forceinline__

#ifndef EN_MLSTM
#define EN_MLSTM 1
#endif
#ifndef EN_RWKV
#define EN_RWKV 1
#endif
#ifndef EN_MOE
#define EN_MOE 1
#endif
#ifndef MK_MULTI
#define MK_MULTI 0
#endif

constexpr int D = 4096, SEQ = 16384, CTX = 256, ROWS = SEQ + CTX, NL = 2, NPAN = ROWS / 256;
constexpr int DBR = 1024;
constexpr int NA = 3104, NB = 3072, NC = 3488, NG = 12288, NIN = NA + NB + NC + NG;
constexpr int NA_P = 3328, NC_P = 3584;
constexpr int NAC = NA + NC, NAC_P = 6656;
constexpr int ROW_B = NAC_P, ROW_G = ROW_B + NB, NIN_P = ROW_G + NG;
constexpr int TAC = NAC_P / 256, TB = NB / 256, TG = NG / 256, NT_IN = TAC + TB + TG;
constexpr int NEXP = 32, DEXP = 512;
constexpr float NORM_EPS = 1e-6f;
constexpr int NTHR = 512, NWAVES = 8;

constexpr size_t MiB = 1u << 20;
constexpr size_t WS_CTL = 0, CTL_ZERO_BYTES = 1 * MiB;
constexpr size_t WS_MOD = 1 * MiB;
constexpr size_t WS_MODP = 2 * MiB;
constexpr size_t WS_HDN = 15 * MiB;
constexpr size_t WS_WIN = 24 * MiB;
constexpr size_t WIN_L = (size_t)NIN_P * D * 2;
constexpr size_t WS_WBR = WS_WIN + 2 * 174 * MiB;
constexpr size_t WBR_L = (size_t)3 * D * DBR * 2;
constexpr size_t WS_WOUT = WS_WBR + 48 * MiB;
constexpr size_t WOUT_L = (size_t)D * D * 2;
constexpr size_t WS_WGU = WS_WOUT + 64 * MiB;
constexpr size_t WGU_L = (size_t)NEXP * 1024 * D;
constexpr size_t WS_H8 = WS_WGU + 256 * MiB;
constexpr size_t WS_WIN8 = WS_H8 + 66 * MiB;
constexpr size_t WS_YS8 = WS_WIN8 + 116 * MiB;
constexpr size_t WS_WBR8 = WS_YS8 + 34 * MiB;
constexpr size_t WS_LORAT = WS_WBR8 + 16 * MiB;
constexpr int LORAT_L = 2 * 1024 * 64 * 2 + 1024 * 160, LORAT_A = 2 * 1024 * 64, LORAT_G = 4 * 1024 * 64;
constexpr int NF8 = 6656 + 4096 + 4096, TF8 = NF8 / 256;
constexpr size_t WIN8_L = (size_t)NF8 * D;
static_assert(WS_WIN8 + 2 * WIN8_L <= WS_YS8 && WS_LORAT + 2 * MiB <= WS_WGU + 512 * MiB, "fp8 buffers");
constexpr int N16 = 3072 + 4096, T16 = N16 / 256;
constexpr size_t WS_WDN = WS_WGU + 512 * MiB;
constexpr size_t WDN_L = (size_t)NEXP * D * DEXP;
constexpr size_t WS_XRES = WS_WDN + 256 * MiB;
constexpr size_t WS_H = WS_XRES + 260 * MiB;
constexpr size_t WS_ZA = WS_H + 130 * MiB;
constexpr size_t WS_GATES = WS_ZA + 106 * MiB;
constexpr size_t WS_ZBT = WS_GATES + 3 * MiB;
constexpr size_t WS_ZC = WS_ZBT + 195 * MiB;
constexpr size_t WS_SG = WS_ZC + 228 * MiB;
constexpr size_t WS_YS = WS_SG + 390 * MiB;
constexpr size_t WS_MERGED = WS_YS + 98 * MiB;
constexpr size_t WS_YBT = WS_MERGED + 130 * MiB;
constexpr size_t WS_HSCR = WS_YBT + 65 * MiB;
constexpr size_t HSCR_WG = 336 * 1024;
constexpr size_t WS_STREAM = WS_HSCR + 84 * MiB;
constexpr size_t WS_RV = WS_STREAM + 650 * MiB;
constexpr size_t WS_RSCAL = WS_RV + 65 * MiB;
constexpr size_t WS_RG = WS_RSCAL + 9 * MiB;
constexpr size_t WS_RBON = WS_RG + 65 * MiB;
constexpr size_t WS_RY = WS_RBON + 65 * MiB;
constexpr size_t WS_HDIR = WS_RY + 130 * MiB;
constexpr size_t WS_MOE = WS_HDIR + 130 * MiB;
constexpr size_t WS_WRT = WS_MOE + 2 * MiB;
constexpr size_t WS_END0 = WS_WRT + 1 * MiB;
constexpr int NSLOT = ROWS * 4 + NEXP * 256;
constexpr size_t MOE_EIDX = 0, MOE_EW = (size_t)ROWS * 16, MOE_TOKSLOT = (size_t)ROWS * 32, MOE_SLOTTOK = (size_t)ROWS * 48, MOE_TILEE = MOE_SLOTTOK + (size_t)NSLOT * 4;
constexpr size_t MOE_CNTW = MOE_TILEE + 2048;
static_assert(MOE_CNTW + 256 * 32 * 4 <= 2 * MiB, "moe tables");
constexpr size_t WS_MRG32 = WS_ZBT;
constexpr size_t WS_YSLOT = WS_ZBT;
constexpr size_t WS_ACT = WS_YSLOT + 584 * MiB;
static_assert(WS_ACT + 73 * MiB <= WS_YS, "moe overlay");
constexpr int CW_HQ = 20480;
constexpr int CW_CNT = 16384, CW_CUR = 16384 + 64;
static_assert(WS_END0 <= (size_t)4096 * MiB, "workspace map exceeds 4 GiB");

constexpr int RING_BYTES = 131072;
constexpr int LDSCTL_OFF = 139264, MISC_OFF = LDSCTL_OFF + 320;
constexpr int LDS_SMALL = LDSCTL_OFF + 1024;
constexpr int LDS_BYTES = 147456;
static_assert(8 * 16640 <= LDSCTL_OFF && LDS_SMALL + 4096 <= LDS_BYTES, "LDS map");

typedef __bf16 bf16v2 __attribute__((ext_vector_type(2)));
DI unsigned cvt_pk_bf16(float lo, float hi) { const bf16v2 v = __builtin_convertvector((f32x2){lo, hi}, bf16v2); return __builtin_bit_cast(unsigned, v); }
DI u32x4 pack8(f32x4 a, f32x4 b) { u32x4 w; w.x = cvt_pk_bf16(a[0], a[1]); w.y = cvt_pk_bf16(a[2], a[3]); w.z = cvt_pk_bf16(b[0], b[1]); w.w = cvt_pk_bf16(b[2], b[3]); return w; }
DI unsigned pk4_fp8(float a, float b, float c, float d) {
    a = fminf(fmaxf(a, -448.f), 448.f); b = fminf(fmaxf(b, -448.f), 448.f); c = fminf(fmaxf(c, -448.f), 448.f); d = fminf(fmaxf(d, -448.f), 448.f);
    int w = __builtin_amdgcn_cvt_pk_fp8_f32(a, b, 0, false); w = __builtin_amdgcn_cvt_pk_fp8_f32(c, d, w, true); return (unsigned)w; }
DI void unpack8(u32x4 w, f32x4& a, f32x4& b) { a[0] = __uint_as_float(w.x << 16); a[1] = __uint_as_float(w.x & 0xffff0000u); a[2] = __uint_as_float(w.y << 16); a[3] = __uint_as_float(w.y & 0xffff0000u);
    b[0] = __uint_as_float(w.z << 16); b[1] = __uint_as_float(w.z & 0xffff0000u); b[2] = __uint_as_float(w.w << 16); b[3] = __uint_as_float(w.w & 0xffff0000u); }
DI f32x4 unpack4(u32x2 w) { return (f32x4){__uint_as_float(w.x << 16), __uint_as_float(w.x & 0xffff0000u), __uint_as_float(w.y << 16), __uint_as_float(w.y & 0xffff0000u)}; }
DI float bf2f(unsigned short b) { return __uint_as_float(((unsigned)b) << 16); }
DI float sigmoidf_(float x) { return __builtin_amdgcn_rcpf(1.f + __expf(-x)); }
DI int otid() { int t = threadIdx.x; asm volatile("" : "+v"(t)); return t; }
template <int CTRL> DI float dpp_add(float x) { return x + __builtin_bit_cast(float, __builtin_amdgcn_update_dpp(0, __builtin_bit_cast(int, x), CTRL, 0xf, 0xf, true)); }
DI float rowsum16(float x) { x = dpp_add<0xB1>(x); x = dpp_add<0x4E>(x); x = dpp_add<0x141>(x); x = dpp_add<0x140>(x); return x; }
DI float wave_sum(float v) {
    v = rowsum16(v);
    v += __builtin_bit_cast(float, __builtin_amdgcn_update_dpp(0, __builtin_bit_cast(int, v), 0x142, 0xA, 0xF, false));
    v += __builtin_bit_cast(float, __builtin_amdgcn_update_dpp(0, __builtin_bit_cast(int, v), 0x143, 0xC, 0xF, false));
    return __builtin_bit_cast(float, __builtin_amdgcn_readlane(__builtin_bit_cast(int, v), 63));
}

#define XB_TMO      128
#define XB_XCNT(j)  (256  + 64 * (j))
#define XB_XSUB(j)  (1280 + 64 * (j))
#define XB_XGEN(j)  (2304 + 64 * (j))
#define XB_TOP      3328
#define XB_TOPGEN   3392
#define XCD_BAR_WORDS 3456
#define XB_SPIN_CAP (1u << 22)
DI unsigned xb_ld(unsigned* p)              { return __hip_atomic_load(p, __ATOMIC_RELAXED, __HIP_MEMORY_SCOPE_AGENT); }
DI unsigned xb_add(unsigned* p, unsigned v) { return __hip_atomic_fetch_add(p, v, __ATOMIC_RELAXED, __HIP_MEMORY_SCOPE_AGENT); }
DI unsigned xb_xcc_id() { return (unsigned)__builtin_amdgcn_s_getreg((3 << 11) | 20) & 0xFu; }
#define XB_SPIN(cond, bar) do { unsigned _sp = 0; while (cond) { __builtin_amdgcn_s_sleep(1); \
    if ((++_sp & 255u) == 0u) { if (xb_ld(&(bar)[XB_TMO])) break; if (_sp > XB_SPIN_CAP) { atomicAdd(&(bar)[XB_TMO], 1u); break; } } } } while (0)
struct XcdBarrier { unsigned* bar; unsigned x; volatile LAS unsigned* st; };
DI XcdBarrier xcd_barrier_post(unsigned* bar, volatile LAS unsigned* st) {
    XcdBarrier b; b.bar = bar; b.x = xb_xcc_id(); b.st = st;
    if (threadIdx.x == 0) (void)xb_add(&bar[XB_XCNT(b.x)], 1u);
    return b;
}
DI void xcd_barrier_complete(unsigned* bar, unsigned x, unsigned& nloc, unsigned& nx) {
    const unsigned G = gridDim.x * gridDim.y * gridDim.z;
    unsigned sum, cnt, mine, sp = 0u;
    for (;;) {
        sum = 0u; cnt = 0u; mine = 0u;
#pragma unroll
        for (unsigned j = 0; j < 16; ++j) { const unsigned c = xb_ld(&bar[XB_XCNT(j)]); sum += c; cnt += (c > 0u) ? 1u : 0u; mine = (j == x) ? c : mine; }
        if (sum == G) break;
        __builtin_amdgcn_s_sleep(1);
        if ((++sp & 255u) == 0u) { if (xb_ld(&bar[XB_TMO])) break; if (sp > XB_SPIN_CAP) { atomicAdd(&bar[XB_TMO], 1u); break; } }
    }
    nloc = mine > 0u ? mine : 1u; nx = cnt > 0u ? cnt : 1u;
}
DI void xcd_barrier(const XcdBarrier& b) {
    asm volatile("s_waitcnt vmcnt(0)" ::: "memory");
    __syncthreads();
    if (threadIdx.x == 0) {
        unsigned* bar = b.bar;
        __builtin_amdgcn_s_waitcnt(0);
        unsigned nloc = b.st[0], nx = b.st[1];
        if (nloc == 0u) { xcd_barrier_complete(bar, b.x, nloc, nx); b.st[0] = nloc; b.st[1] = nx; }
        const unsigned old = xb_add(&bar[XB_XSUB(b.x)], 1u);
        const unsigned gen = old / nloc;
        if (old + 1u == (gen + 1u) * nloc) {
            __builtin_amdgcn_fence(__ATOMIC_RELEASE, "agent");
            asm volatile("s_waitcnt vmcnt(0)" ::: "memory");
            const unsigned og = xb_add(&bar[XB_TOP], 1u);
            const unsigned tg = og / nx;
            if (og + 1u == (tg + 1u) * nx) xb_add(&bar[XB_TOPGEN], 1u);
            else XB_SPIN(xb_ld(&bar[XB_TOPGEN]) == tg, bar);
            __builtin_amdgcn_fence(__ATOMIC_ACQUIRE, "agent");
            xb_add(&bar[XB_XGEN(b.x)], 1u);
            asm volatile("s_waitcnt vmcnt(0)" ::: "memory");
        } else {
            XB_SPIN(xb_ld(&bar[XB_XGEN(b.x)]) == gen, bar);
            __builtin_amdgcn_fence(__ATOMIC_ACQUIRE, "agent");
            asm volatile("s_waitcnt vmcnt(0)" ::: "memory");
        }
    }
    __syncthreads();
}

namespace pg8 {
constexpr int BM = 256, BK = 64, HALF = 128, HTB = HALF * BK * 2, NXCD = 8, WGM = 4;
DI int lds_byte(int r, int c) { const int st = (r >> 4) * 2 + (c >> 5), rr = r & 15, cc = c & 31, ob = rr * 64 + cc * 2; return st * 1024 + (ob ^ (((ob >> 9) & 1) << 5)); }
DI void stage_rc(int b, int& R, int& C) { const int st = b / 1024, sb = b % 1024, swz = sb ^ (((sb >> 9) & 1) << 5); R = (st >> 1) * 16 + swz / 64; C = (st & 1) * 32 + (swz % 64) / 2; }
DI int perm32(int rho) { const int n = rho >> 4, i = rho & 15; return 8 * (i >> 2) + 4 * n + (i & 3); }
struct Unit { int pm, pn, aux; };
typedef int v8i __attribute__((ext_vector_type(8)));
DI v8i cat8(bf16x8 lo, bf16x8 hi) { typedef int v4i __attribute__((ext_vector_type(4))); const v4i a = __builtin_bit_cast(v4i, lo), b = __builtin_bit_cast(v4i, hi); return (v8i){a[0], a[1], a[2], a[3], b[0], b[1], b[2], b[3]}; }
DI void tile_of(int L, int nM, int nN, int& pm, int& pn) {
    const int nwg = nM * nN; int wgid = L;
    { const int q = nwg / NXCD, r = nwg % NXCD, xcd = wgid % NXCD, off = wgid / NXCD; wgid = (xcd < r ? xcd * (q + 1) : r * (q + 1) + (xcd - r) * q) + off; }
    const int nig = WGM * nN, gid = wgid / nig, fm = gid * WGM, gsz = (nM - fm) < WGM ? (nM - fm) : WGM;
    pm = fm + ((wgid % nig) % gsz); pn = (wgid % nig) / gsz;
}
#define EPI_LOOP(...) \
    _Pragma("unroll") for (int ai = 0; ai < 2; ++ai) _Pragma("unroll") for (int m = 0; m < 4; ++m) { const int rl = ai * 128 + wr * 64 + m * 16 + fr; \
    _Pragma("unroll") for (int bj = 0; bj < 2; ++bj) { const int cl = bj * 128 + wc * 32 + 8 * fq; const f32x4 v0 = acc[ai][bj][m][0], v1 = acc[ai][bj][m][1]; __VA_ARGS__ } }

#define EPI_GROUPS(ai, ...) \
    _Pragma("unroll") for (int mm = 0; mm < 2; ++mm) { const int m = 2 * mh + mm; const int rl = (ai) * 128 + wr * 64 + m * 16 + fr; \
    _Pragma("unroll") for (int bj = 0; bj < 2; ++bj) { const int cl = bj * 128 + wc * 32 + 8 * fq; __VA_ARGS__ } }

template <class P>
DI void gemm_phase(LAS unsigned char* lds, const P& S) {
    int tid_ = threadIdx.x; asm volatile("" : "+v"(tid_));
    const int tid = tid_, wid = __builtin_amdgcn_readfirstlane(tid >> 6), lane = tid & 63, wr = wid >> 2, wc = wid & 3, fr = lane & 15, fq = lane >> 4;
    constexpr int EB = P::FP8 ? 1 : 2;
    const int K = S.K, KB = K * EB, nt = KB / (BK * 2);
    const size_t kstep = (size_t)(BK * 2);
    const size_t hstep = (size_t)HALF * KB;
    unsigned voB[2][2], voA[2][2], voAn[2][2]; int RA[2], CA[2];
#pragma unroll
    for (int i = 0; i < 2; ++i) { int R, C; stage_rc(tid * 16 + i * 8192, R, C); const int Rb = (R & ~31) + perm32(R & 31); RA[i] = R; CA[i] = C;
#pragma unroll
        for (int h = 0; h < 2; ++h) { voA[h][i] = (unsigned)(R * KB + C * 2) + (unsigned)(h * hstep); voAn[h][i] = voA[h][i]; voB[h][i] = (unsigned)(Rb * KB + C * 2) + (unsigned)(h * hstep); } }
    const unsigned ldsw = (unsigned)wid * 1024u;
    const int aoff = lds_byte(wr * 64 + fr, fq * 8), boff = lds_byte(wc * 32 + fr, fq * 8);
#define PG8_SA(b, h) (((b) * 2 + (h)) * HTB)
#define PG8_SB(b, h) ((4 + (b) * 2 + (h)) * HTB)
#define PG8_STAGE(bufoff, gbase, voff) do { _Pragma("unroll") for (int _i = 0; _i < 2; ++_i) \
        __builtin_amdgcn_global_load_lds((const unsigned*)((const char*)(gbase) + (voff)[_i]), (LAS unsigned*)(lds + (bufoff) + ldsw + _i * 8192), 16, 0, 0); } while (0)
#define PG8_LD16(off) (*(const LAS bf16x8*)(lds + (off)))
#define PG8_LDA(dst, b, h) do { _Pragma("unroll") for (int m = 0; m < 4; ++m) { \
        if constexpr (P::FP8) dst##8[m] = cat8(PG8_LD16(PG8_SA(b, h) + aoff + m * 2048), PG8_LD16(PG8_SA(b, h) + aoff + m * 2048 + 1024)); \
        else { _Pragma("unroll") for (int k = 0; k < 2; ++k) dst[m][k] = PG8_LD16(PG8_SA(b, h) + aoff + m * 2048 + k * 1024); } } } while (0)
#define PG8_LDB(dst, b, h) do { _Pragma("unroll") for (int n = 0; n < 2; ++n) { \
        if constexpr (P::FP8) dst##8[n] = cat8(PG8_LD16(PG8_SB(b, h) + boff + n * 2048), PG8_LD16(PG8_SB(b, h) + boff + n * 2048 + 1024)); \
        else { _Pragma("unroll") for (int k = 0; k < 2; ++k) dst[n][k] = PG8_LD16(PG8_SB(b, h) + boff + n * 2048 + k * 1024); } } } while (0)
#define PG8_MMA(ai, bj, At, Bt) do { __builtin_amdgcn_s_setprio(1); _Pragma("unroll") for (int m = 0; m < 4; ++m) _Pragma("unroll") for (int n = 0; n < 2; ++n) { \
        if constexpr (P::FP8) asm volatile("v_mfma_scale_f32_16x16x128_f8f6f4 %0, %1, %2, %0, %3, %3 op_sel_hi:[0,0,0]" : "+v"(acc[ai][bj][m][n]) : "v"(Bt##8[n]), "v"(At##8[m]), "v"(sc127));   \
        else { _Pragma("unroll") for (int k = 0; k < 2; ++k) acc[ai][bj][m][n] = __builtin_amdgcn_mfma_f32_16x16x32_bf16(Bt[n][k], At[m][k], acc[ai][bj][m][n], 0, 0, 0); } } \
        __builtin_amdgcn_s_setprio(0); } while (0)
#define PG8_WAIT_V(n) asm volatile("s_waitcnt vmcnt(" #n ")" ::: "memory")
#define PG8_WAIT_L(n) asm volatile("s_waitcnt lgkmcnt(" #n ")" ::: "memory")
#define PG8_BAR __builtin_amdgcn_s_barrier()
#define PG8_SCHED __builtin_amdgcn_sched_barrier(0)
    Unit cur, nxt; int ui = 0;
    if (!S.next(0, cur)) return;
    f32x4 acc[2][2][4][2];
#pragma unroll
    for (int a = 0; a < 2; ++a)
#pragma unroll
        for (int b = 0; b < 2; ++b)
#pragma unroll
            for (int m = 0; m < 4; ++m)
#pragma unroll
                for (int n = 0; n < 2; ++n) acc[a][b][m][n] = (f32x4){0.f, 0.f, 0.f, 0.f};
    const int sc127 = 127;
    bf16x8 At[4][2], B0[2][2], B1[2][2]; v8i At8[4], B08[2], B18[2];
    const char* cA = S.a_ptr(cur); const char* cB = S.b_ptr(cur);
    if constexpr (P::GATHER) {
#pragma unroll
        for (int h = 0; h < 2; ++h)
#pragma unroll
            for (int i = 0; i < 2; ++i) { int R_, C_; stage_rc(tid * 16 + i * 8192, R_, C_); voA[h][i] = S.a_row_off(cur, h * 128 + R_) + (unsigned)C_ * 2u; }
    }
    PG8_STAGE(PG8_SB(0, 0), cB, voB[0]); PG8_STAGE(PG8_SB(0, 1), cB + hstep, voB[0]); PG8_STAGE(PG8_SA(0, 0), cA, voA[0]); PG8_STAGE(PG8_SA(0, 1), cA, voA[1]);
    if (wr == 1) PG8_BAR;
    PG8_WAIT_V(2); PG8_BAR;
    PG8_STAGE(PG8_SB(1, 0), cB + kstep, voB[0]); PG8_STAGE(PG8_SA(1, 0), cA + kstep, voA[0]); PG8_STAGE(PG8_SB(1, 1), cB + hstep + kstep, voB[0]);
    PG8_WAIT_V(6); PG8_BAR;
    for (;;) {
        const bool has_next = S.next(ui + 1, nxt);
        const char* nA = has_next ? S.a_ptr(nxt) : cA; const char* nB = has_next ? S.b_ptr(nxt) : cB;
        if constexpr (P::GATHER) {
#pragma unroll
            for (int h = 0; h < 2; ++h)
#pragma unroll
                for (int i = 0; i < 2; ++i) { int R_, C_; stage_rc(tid * 16 + i * 8192, R_, C_); voAn[h][i] = has_next ? (S.a_row_off(nxt, h * 128 + R_) + (unsigned)C_ * 2u) : voA[h][i]; }
        }
        for (int t = 0; t < nt; t += 2) {
            const bool last = (t == nt - 2);
            const char* a1 = cA + (size_t)(t + 1) * kstep;
            const char* a2 = last ? nA : cA + (size_t)(t + 2) * kstep; const char* b2 = last ? nB : cB + (size_t)(t + 2) * kstep;
            const char* a3 = a2 + kstep; const char* b3 = b2 + kstep;
            unsigned vo2[2][2];
#pragma unroll
            for (int h = 0; h < 2; ++h)
#pragma unroll
                for (int i = 0; i < 2; ++i) { if constexpr (P::GATHER) vo2[h][i] = last ? voAn[h][i] : voA[h][i]; else vo2[h][i] = voA[h][i]; }
            PG8_LDB(B0, 0, 0); PG8_LDB(B1, 0, 1); PG8_SCHED; PG8_LDA(At, 0, 0); PG8_STAGE(PG8_SA(1, 1), a1, voA[1]);
            PG8_WAIT_V(8); PG8_WAIT_L(0); PG8_BAR; PG8_MMA(0, 0, At, B0); PG8_MMA(0, 1, At, B1); PG8_BAR; PG8_SCHED;
            PG8_LDA(At, 0, 1); PG8_STAGE(PG8_SB(0, 0), b2, voB[0]); PG8_STAGE(PG8_SB(0, 1), b2 + hstep, voB[0]); PG8_STAGE(PG8_SA(0, 0), a2, vo2[0]);
            PG8_WAIT_V(8); PG8_WAIT_L(0); PG8_BAR; PG8_MMA(1, 0, At, B0); PG8_MMA(1, 1, At, B1); PG8_BAR; PG8_SCHED;
            PG8_LDB(B0, 1, 0); PG8_LDB(B1, 1, 1); PG8_SCHED; PG8_LDA(At, 1, 0); PG8_STAGE(PG8_SA(0, 1), a2, vo2[1]);
            PG8_WAIT_V(8); PG8_WAIT_L(0); PG8_BAR; PG8_MMA(0, 0, At, B0); PG8_MMA(0, 1, At, B1); PG8_BAR; PG8_SCHED;
            PG8_LDA(At, 1, 1); PG8_STAGE(PG8_SB(1, 0), b3, voB[0]); PG8_STAGE(PG8_SB(1, 1), b3 + hstep, voB[0]); PG8_STAGE(PG8_SA(1, 0), a3, vo2[0]);
            PG8_WAIT_V(8); PG8_WAIT_L(0); PG8_BAR; PG8_MMA(1, 0, At, B0); PG8_MMA(1, 1, At, B1); PG8_BAR; PG8_SCHED;
        }
        if (wr == 0) PG8_BAR;
        if constexpr (P::FP8) { asm volatile("s_nop 15\n\ts_nop 7" ::: "memory");
            const int ln_ = (int)__builtin_amdgcn_mbcnt_hi(~0u, __builtin_amdgcn_mbcnt_lo(~0u, 0u)); S.epi(acc, cur, wr, wc, ln_ & 15, ln_ >> 4); }
        else S.epi(acc, cur, wr, wc, fr, fq);
        if (!has_next) break;
#pragma unroll
        for (int a = 0; a < 2; ++a)
#pragma unroll
            for (int b = 0; b < 2; ++b)
#pragma unroll
                for (int m = 0; m < 4; ++m)
#pragma unroll
                    for (int n = 0; n < 2; ++n) acc[a][b][m][n] = (f32x4){0.f, 0.f, 0.f, 0.f};
        cur = nxt; cA = nA; cB = nB; ++ui;
        if constexpr (P::GATHER) {
#pragma unroll
            for (int h = 0; h < 2; ++h)
#pragma unroll
                for (int i = 0; i < 2; ++i) voA[h][i] = voAn[h][i];
        }
        if (wr == 1) PG8_BAR;
    }
    PG8_WAIT_V(0);
    PG8_BAR;
#undef PG8_SA
#undef PG8_SB
#undef PG8_STAGE
#undef PG8_LDA
#undef PG8_LD16
#undef PG8_LDB
#undef PG8_MMA
#undef PG8_WAIT_V
#undef PG8_WAIT_L
#undef PG8_BAR
#undef PG8_SCHED
}
}
using pg8::Unit;

struct Args { const float* in[40]; float* out; unsigned char* ws; int ph_lo, ph_hi; };
#define CAS __attribute__((address_space(4)))
typedef const CAS Args* AP;
enum { I_X = 0, I_C, I_CTX, I_CCTX, I_ADAW, I_ADAB, I_NMIX, I_NMOE, I_WIN, I_MGB, I_MNORM, I_HCW, I_HCB, I_HW1, I_HB1, I_HW2, I_HB2, I_HW3, I_HFREQ, I_HSKIP,
       I_RMU, I_RW0, I_RW2, I_RA0, I_RA2, I_RG2, I_RKK, I_RKA, I_RRK, I_RLNW, I_RLNB, I_WBR, I_WOUT, I_RTW, I_RTB, I_EGU, I_EBGU, I_EDN, I_EBDN, I_NFIN };

DI void transpose_tile(const float* W, int N, int k0, int n0, bf16* dst, int Kd, LAS float* scr, int lane) {
#pragma unroll
    for (int i = 0; i < 16; ++i) { const int kk = 4 * i + (lane >> 4), nn = 4 * (lane & 15);
        const f32x4 v = *(const f32x4*)(W + (size_t)(k0 + kk) * N + n0 + nn);
        scr[kk * 65 + nn] = v[0]; scr[kk * 65 + nn + 1] = v[1]; scr[kk * 65 + nn + 2] = v[2]; scr[kk * 65 + nn + 3] = v[3]; }
    asm volatile("s_waitcnt lgkmcnt(0)" ::: "memory");
    const int c = lane & 7;
#pragma unroll
    for (int j = 0; j < 8; ++j) { const int n = (lane >> 3) + 8 * j; const LAS float* s = scr + (8 * c) * 65 + n;
        u32x4 o; o.x = cvt_pk_bf16(s[0], s[65]); o.y = cvt_pk_bf16(s[2 * 65], s[3 * 65]); o.z = cvt_pk_bf16(s[4 * 65], s[5 * 65]); o.w = cvt_pk_bf16(s[6 * 65], s[7 * 65]);
        *(u32x4*)(dst + (size_t)(n0 + n) * Kd + k0 + 8 * c) = o; }
    asm volatile("s_waitcnt lgkmcnt(0)" ::: "memory");
}
DI void transpose_tile8(const float* W, int N, int k0, int n0, unsigned char* dst, int Kd, LAS float* scr, int lane, float sc) {
#pragma unroll
    for (int i = 0; i < 16; ++i) { const int kk = 4 * i + (lane >> 4), nn = 4 * (lane & 15);
        const f32x4 v = *(const f32x4*)(W + (size_t)(k0 + kk) * N + n0 + nn);
        scr[kk * 65 + nn] = v[0]; scr[kk * 65 + nn + 1] = v[1]; scr[kk * 65 + nn + 2] = v[2]; scr[kk * 65 + nn + 3] = v[3]; }
    asm volatile("s_waitcnt lgkmcnt(0)" ::: "memory");
    const int c = lane & 7;
#pragma unroll
    for (int j = 0; j < 8; ++j) { const int n = (lane >> 3) + 8 * j; const LAS float* s = scr + (8 * c) * 65 + n;
        u32x2 o; o.x = pk4_fp8(s[0] * sc, s[65] * sc, s[2 * 65] * sc, s[3 * 65] * sc); o.y = pk4_fp8(s[4 * 65] * sc, s[5 * 65] * sc, s[6 * 65] * sc, s[7 * 65] * sc);
        *(u32x2*)(dst + (size_t)(n0 + n) * Kd + k0 + 8 * c) = o; }
    asm volatile("s_waitcnt lgkmcnt(0)" ::: "memory");
}
DI int win_map(int n) {
    if (n < NA) return (n << 1) | 1;
    if (n < NA + NB) return (n - NA) << 1;
    if (n < NA + NB + NC) return ((NA + n - NA - NB) << 1) | 1;
    const int g = n - (NA + NB + NC);
    if (g < D) return ((NAC_P + g) << 1) | 1;
    if (g < 2 * D) return (NB + (g - D)) << 1;
    return ((NAC_P + D + (g - 2 * D)) << 1) | 1; }

constexpr int CV_TIN = 64 * (NIN / 64), CV_TBR = 3 * 16 * 64, CV_TOUT = 64 * 64, CV_TGU = NEXP * 64 * 16, CV_TDN = NEXP * 8 * 64;
constexpr int CV_TL = CV_TIN + CV_TBR + CV_TOUT + CV_TGU + CV_TDN;
struct CvJob { const float* src; unsigned char* dst; int N, Kd, kind; float sc; int l, kb, n0; };
DI CvJob cv_job(AP a, int l, int r) {
    unsigned char* ws = a->ws; CvJob j; j.l = l; j.kb = 0; j.n0 = 0; j.sc = 1.f;
    if (r < CV_TIN) { const int kb = r / (NIN / 64), nb = r % (NIN / 64), n0 = nb * 64;
        const int m0 = win_map(n0), m1 = win_map(n0 + 32);
        j.src = a->in[I_WIN] + (size_t)l * D * NIN + (size_t)kb * 64 * NIN + n0; j.N = NIN; j.Kd = D; j.kb = kb; j.n0 = n0;
        if ((m0 & 1) == (m1 & 1) && (m0 >> 1) - n0 == (m1 >> 1) - (n0 + 32)) {
            if (m0 & 1) { j.kind = 1; j.sc = 512.f; j.dst = ws + WS_WIN8 + l * WIN8_L + (size_t)(m0 >> 1) * D + kb * 64; }
            else { j.kind = 0; j.dst = ws + WS_WIN + l * WIN_L + ((size_t)(m0 >> 1) * D + kb * 64) * 2; } }
        else { j.kind = 2; j.dst = ws; }
        return j; }
    r -= CV_TIN;
    if (r < CV_TBR) { const int i = r / (16 * 64), q = r % (16 * 64), kb = q / 64, nb = q % 64;
        j.src = a->in[I_WBR] + ((size_t)l * 3 + i) * DBR * D + (size_t)kb * 64 * D + nb * 64; j.N = D; j.Kd = DBR;
        if (i == 1) { j.kind = 0; j.dst = ws + WS_WBR + l * WBR_L + ((size_t)i * D * DBR + (size_t)nb * 64 * DBR + kb * 64) * 2; }
        else { j.kind = 1; j.sc = 256.f; j.dst = ws + WS_WBR8 + ((size_t)l * 2 + (i >> 1)) * D * DBR + (size_t)nb * 64 * DBR + kb * 64; }
        return j; }
    r -= CV_TBR;
    if (r < CV_TOUT) { const int kb = r / 64, nb = r % 64;
        j.src = a->in[I_WOUT] + (size_t)l * D * D + (size_t)kb * 64 * D + nb * 64; j.N = D; j.Kd = D; j.kind = 0; j.dst = ws + WS_WOUT + l * WOUT_L + ((size_t)nb * 64 * D + kb * 64) * 2; return j; }
    r -= CV_TOUT;
    if (r < CV_TGU) { const int e = r / (64 * 16), q = r % (64 * 16), kb = q / 16, nb = q % 16;
        j.src = a->in[I_EGU] + ((size_t)l * NEXP + e) * D * 1024 + (size_t)kb * 64 * 1024 + nb * 64; j.N = 1024; j.Kd = D; j.kind = 1; j.sc = 512.f;
        j.dst = ws + WS_WGU + l * WGU_L + (size_t)e * 1024 * D + (size_t)nb * 64 * D + kb * 64; return j; }
    r -= CV_TGU;
    { const int e = r / (8 * 64), q = r % (8 * 64), kb = q / 64, nb = q % 64;
        j.src = a->in[I_EDN] + ((size_t)l * NEXP + e) * DEXP * D + (size_t)kb * 64 * D + nb * 64; j.N = D; j.Kd = DEXP; j.kind = 1; j.sc = 256.f;
        j.dst = ws + WS_WDN + l * WDN_L + (size_t)e * D * DEXP + (size_t)nb * 64 * DEXP + kb * 64; }
    return j;
}
DI void cv_load(const CvJob& j, f32x4 (&v)[16], int lane) {
#pragma unroll
    for (int i = 0; i < 16; ++i) v[i] = (f32x4){0.f, 0.f, 0.f, 0.f};
    if (j.kind != 2) {
#pragma unroll
        for (int i = 0; i < 16; ++i) v[i] = *(const f32x4*)(j.src + (size_t)(4 * i + (lane >> 4)) * j.N + 4 * (lane & 15)); }
}
DI void cv_store(AP a, const CvJob& j, const f32x4 (&v)[16], LAS float* scr, int lane) {
    if (j.kind == 2) {
        const float* W = a->in[I_WIN] + (size_t)j.l * D * NIN; bf16* d16 = (bf16*)(a->ws + WS_WIN + j.l * WIN_L); unsigned char* d8 = a->ws + WS_WIN8 + j.l * WIN8_L;
        for (int e = lane; e < 64 * 64; e += 64) { const int kk = e >> 6, nn = e & 63; const float x = W[(size_t)(j.kb * 64 + kk) * NIN + j.n0 + nn]; const int mm = win_map(j.n0 + nn);
            if (mm & 1) d8[(size_t)(mm >> 1) * D + j.kb * 64 + kk] = (unsigned char)(pk4_fp8(x * 512.f, 0.f, 0.f, 0.f) & 0xffu);
            else d16[(size_t)(mm >> 1) * D + j.kb * 64 + kk] = (bf16)(cvt_pk_bf16(x, 0.f) & 0xffffu); }
        return; }
#pragma unroll
    for (int i = 0; i < 16; ++i) { const int kk = 4 * i + (lane >> 4), nn = 4 * (lane & 15);
        scr[kk * 65 + nn] = v[i][0]; scr[kk * 65 + nn + 1] = v[i][1]; scr[kk * 65 + nn + 2] = v[i][2]; scr[kk * 65 + nn + 3] = v[i][3]; }
    asm volatile("s_waitcnt lgkmcnt(0)" ::: "memory");
    const int c = lane & 7;
    if (j.kind == 0) {
#pragma unroll
        for (int jj = 0; jj < 8; ++jj) { const int n = (lane >> 3) + 8 * jj; const LAS float* s = scr + (8 * c) * 65 + n;
            u32x4 o; o.x = cvt_pk_bf16(s[0], s[65]); o.y = cvt_pk_bf16(s[2 * 65], s[3 * 65]); o.z = cvt_pk_bf16(s[4 * 65], s[5 * 65]); o.w = cvt_pk_bf16(s[6 * 65], s[7 * 65]);
            *(u32x4*)(j.dst + ((size_t)n * j.Kd + 8 * c) * 2) = o; } }
    else { const float sc = j.sc;
#pragma unroll
        for (int jj = 0; jj < 8; ++jj) { const int n = (lane >> 3) + 8 * jj; const LAS float* s = scr + (8 * c) * 65 + n;
            u32x2 o; o.x = pk4_fp8(s[0] * sc, s[65] * sc, s[2 * 65] * sc, s[3 * 65] * sc); o.y = pk4_fp8(s[4 * 65] * sc, s[5 * 65] * sc, s[6 * 65] * sc, s[7 * 65] * sc);
            *(u32x2*)(j.dst + (size_t)n * j.Kd + 8 * c) = o; } }
    asm volatile("s_waitcnt lgkmcnt(0)" ::: "memory");
}
constexpr int cvq_nt(int l) { return (CV_TL - CV_TIN) + (l + 1 < NL ? CV_TIN : 0); }
constexpr int cvq_nch(int l) { return (cvq_nt(l) + 63) / 64; }
constexpr int CVQ_R = 1;
constexpr int cvq_q(int l) { return (cvq_nch(l) + CVQ_R - 1) / CVQ_R; }
DI CvJob cvq_job(AP a, int t, int l) { if (t < CV_TL - CV_TIN) return cv_job(a, l, CV_TIN + t); return cv_job(a, l + 1, t - (CV_TL - CV_TIN)); }
DI void conv_chunk(AP a, int cc, LAS unsigned char* lds, int l) {
    const int CVQ_NT = cvq_nt(l);
    const int tid = otid(), lane = tid & 63, wave = tid >> 6;
    LAS float* scr = (LAS float*)(lds + wave * 16640);
    CvJob jc, jn; f32x4 vc[16], vn[16];
    const int t0 = cc * 64 + wave; bool have = t0 < CVQ_NT;
    jc = cvq_job(a, have ? t0 : 0, l); jn = jc;
    if (have) cv_load(jc, vc, lane);
#pragma unroll 2
    for (int j = 0; j < 8; ++j) { const int tn = t0 + (j + 1) * 8; const bool hn = (j + 1 < 8) && tn < CVQ_NT;
        if (hn) { jn = cvq_job(a, tn, l); cv_load(jn, vn, lane); }
        if (have) cv_store(a, jc, vc, scr, lane);
        jc = jn; have = hn;
#pragma unroll
        for (int i = 0; i < 16; ++i) vc[i] = vn[i]; }
}

DI void phase_prologue(AP a, LAS unsigned char* lds, int bid, int G) {
    const int tid = otid(), lane = tid & 63, wave = tid >> 6;
    unsigned char* ws = a->ws;
    {
        LAS float* scr = (LAS float*)(lds + wave * 16640);
        const int gw = bid * NWAVES + wave, NGW = G * NWAVES;
        CvJob jc, jn; f32x4 vc[16], vn[16];
        bool have = gw < CV_TIN; jc = cv_job(a, 0, have ? gw : 0); jn = jc;
        if (have) cv_load(jc, vc, lane);
#pragma unroll 2
        for (int it = gw; it < CV_TIN; it += NGW) { const bool hn = it + NGW < CV_TIN;
            if (hn) { jn = cv_job(a, 0, it + NGW); cv_load(jn, vn, lane); }
            cv_store(a, jc, vc, scr, lane);
            jc = jn;
#pragma unroll
            for (int i = 0; i < 16; ++i) vc[i] = vn[i]; }
        for (int l = 0; l < NL; ++l) { unsigned char* d8 = ws + WS_WIN8 + l * WIN8_L + (size_t)NAC * D;
            const size_t n1 = (size_t)(NAC_P - NAC) * D / 16;
            for (size_t i = (size_t)bid * NTHR + tid; i < n1; i += (size_t)G * NTHR) ((u32x4*)d8)[i] = (u32x4){0u, 0u, 0u, 0u}; }
    }
    __syncthreads();
    for (int i = bid * NTHR + tid; i < NL * NEXP * D; i += G * NTHR) { const int l = i / (NEXP * D), e = (i / D) % NEXP, k = i % D;
        ((float*)(ws + WS_WRT))[i] = a->in[I_RTW][((size_t)l * D + k) * NEXP + e]; }
    for (int i = bid * NTHR + tid; i < NL * LORAT_L; i += G * NTHR) { const int l = i / LORAT_L, q = i % LORAT_L; float v;
        if (q < LORAT_G) { const int which = q >= LORAT_A, qq = q - which * LORAT_A, d = qq / (1024 * 64), c = (qq / 64) % 1024, j = qq % 64;
            v = (which ? a->in[I_RA2] : a->in[I_RW2])[(((size_t)l * 2 + d) * 64 + j) * DBR + c]; }
        else { const int qq = q - LORAT_G, c = qq / 160, j = qq % 160; v = a->in[I_RG2][((size_t)l * 160 + j) * DBR + c]; }
        ((bf16*)(ws + WS_LORAT))[i] = (bf16)(cvt_pk_bf16(v, 0.f) & 0xffffu); }
    {
        LAS float* sv = (LAS float*)lds;
        for (int it = bid; it < NL * 12 * 32; it += G) {
            const int l = it / (12 * 32), q = it % (12 * 32), cb = q / 32, ks = q % 32;
            __syncthreads();
            if (tid < 256) { const int w = tid >> 7, k = ks * 128 + (tid & 127); const float v = (w ? a->in[I_CCTX] : a->in[I_C])[k]; sv[tid] = v / (1.f + __expf(-v)); }
            __syncthreads();
            const float* W = a->in[I_ADAW] + (size_t)l * D * 6 * D + (size_t)(ks * 128) * 6 * D + cb * 2048 + tid * 4;
            f32x4 ax = {0.f, 0.f, 0.f, 0.f}, ac = {0.f, 0.f, 0.f, 0.f};
#pragma unroll 8
            for (int k = 0; k < 128; ++k) { const f32x4 w = *(const f32x4*)(W + (size_t)k * 6 * D); ax += w * sv[k]; ac += w * sv[128 + k]; }
            float* P = (float*)(ws + WS_MODP) + (((size_t)l * 32 + ks) * 2) * 6 * D + cb * 2048 + tid * 4;
            *(f32x4*)P = ax; *(f32x4*)(P + 6 * D) = ac;
        }
    }
    __syncthreads();
    {
        LAS float* zf = (LAS float*)lds;
        LAS float* h1 = zf + 32 * 36;
        for (int it = bid; it < NL * (ROWS / 32); it += G) {
            const int l = it / (ROWS / 32), pg = it % (ROWS / 32);
            __syncthreads();
            for (int e = tid; e < 32 * 33; e += NTHR) { const int p = e / 33, j = e % 33; const int gp = pg * 32 + p; const int L = gp < SEQ ? SEQ : CTX; const int pos = gp < SEQ ? gp : gp - SEQ;
                const float fpos = (float)pos; float v;
                if (j == 0) v = fpos / (float)(L - 1);
                else { const int bi = (j - 1) & 15; const float band = 1e-4f + (float)bi * ((15.f - 1e-4f) / 15.f); const float ang = (6.283185307179586f / (float)L) * fpos;
                    v = (j <= 16) ? cosf(ang * band) : -sinf(ang * band); }
                zf[p * 36 + j] = v; }
            __syncthreads();
            const int p8 = tid >> 6, m = tid & 63; const float fq = a->in[I_HFREQ][l * 64 + m];
            { const float* w1 = a->in[I_HW1] + (size_t)l * 33 * 64; const float b = a->in[I_HB1][l * 64 + m]; float s[4] = {b, b, b, b};
#pragma unroll
              for (int j = 0; j < 33; ++j) { const float w = w1[j * 64 + m];
#pragma unroll
                  for (int q = 0; q < 4; ++q) s[q] += zf[(p8 + 8 * q) * 36 + j] * w; }
#pragma unroll
              for (int q = 0; q < 4; ++q) h1[(p8 + 8 * q) * 64 + m] = sinf(fq * s[q]); }
            __syncthreads();
            { const float* w2 = a->in[I_HW2] + (size_t)l * 64 * 64; const float b = a->in[I_HB2][l * 64 + m]; float s[4] = {b, b, b, b};
#pragma unroll 8
              for (int j = 0; j < 64; ++j) { const float w = w2[j * 64 + m];
#pragma unroll
                  for (int q = 0; q < 4; ++q) s[q] += h1[(p8 + 8 * q) * 64 + j] * w; }
#pragma unroll
              for (int q = 0; q < 4; ++q) ((_Float16*)(ws + WS_HDN))[((size_t)l * ROWS + pg * 32 + p8 + 8 * q) * 64 + m] = (_Float16)sinf(fq * s[q]); }
        }
    }
    __syncthreads();
}
DI void phase_mod_reduce(AP a, int bid, int G) {
    const float* P = (const float*)(a->ws + WS_MODP); float* M = (float*)(a->ws + WS_MOD);
    const int tid = otid();
    for (int i = bid * NTHR + tid; i < NL * 2 * 6 * D; i += G * NTHR) {
        const int l = i / (2 * 6 * D), w = (i / (6 * D)) & 1, n = i % (6 * D);
        float s = a->in[I_ADAB][(size_t)l * 6 * D + n];
        for (int ks = 0; ks < 32; ++ks) s += P[(((size_t)l * 32 + ks) * 2 + w) * 6 * D + n];
        M[i] = s; }
}
DI void phase_norm_mod(AP a, int l, int which  , bool from_input, int bid, int G) {
    const int tid_o = otid(), lane = tid_o & 63, wave = tid_o >> 6;
    const float* gn = a->in[which ? I_NMOE : I_NMIX] + (size_t)l * D;
    const bf16* XR = (const bf16*)(a->ws + WS_XRES); bf16* H = (bf16*)(a->ws + WS_H); unsigned char* H8 = a->ws + WS_H8;
    for (int row = bid * NWAVES + wave; row < ROWS; row += G * NWAVES) {
        const int isc = row >= SEQ;
        const float* src = isc ? a->in[I_CTX] + (size_t)(row - SEQ) * D : a->in[I_X] + (size_t)row * D;
        const float* mod = (const float*)(a->ws + WS_MOD) + ((size_t)l * 2 + isc) * 6 * D + (which ? 3 * D : 0);
        f32x4 v[16]; float ss = 0.f;
#pragma unroll
        for (int j = 0; j < 16; ++j) { v[j] = from_input ? *(const f32x4*)(src + 4 * (lane + 64 * j)) : unpack4(*(const u32x2*)(XR + (size_t)row * D + 4 * (lane + 64 * j))); ss += v[j][0] * v[j][0] + v[j][1] * v[j][1] + v[j][2] * v[j][2] + v[j][3] * v[j][3]; }
        const float rs = rsqrtf(wave_sum(ss) * (1.f / D) + NORM_EPS);
#pragma unroll
        for (int jb = 0; jb < 4; ++jb) {
            f32x4 g[4], sh[4], sc[4];
#pragma unroll
            for (int jj = 0; jj < 4; ++jj) { const int c = 4 * (lane + 64 * (4 * jb + jj)); g[jj] = *(const f32x4*)(gn + c); sh[jj] = *(const f32x4*)(mod + c); sc[jj] = *(const f32x4*)(mod + D + c); }
#pragma unroll
            for (int jj = 0; jj < 4; ++jj) { const int j = 4 * jb + jj; const int c = 4 * (lane + 64 * j);
                const f32x4 o = (v[j] * rs) * g[jj] * (sc[jj] + 1.f) + sh[jj];
                u32x2 w; w.x = cvt_pk_bf16(o[0], o[1]); w.y = cvt_pk_bf16(o[2], o[3]);
                *(u32x2*)(H + (size_t)row * D + c) = w;
                *(unsigned*)(H8 + (size_t)row * D + c) = pk4_fp8(o[0] * 4.f, o[1] * 4.f, o[2] * 4.f, o[3] * 4.f); } }
    }
}
DI void phase_final_norm(AP a, int bid, int G) {
    const int tid_o = otid(), lane = tid_o & 63, wave = tid_o >> 6;
    const bf16* XR = (const bf16*)(a->ws + WS_XRES); const float* gn = a->in[I_NFIN];
    for (int row = bid * NWAVES + wave; row < SEQ; row += G * NWAVES) {
        f32x4 v[16]; float ss = 0.f;
#pragma unroll
        for (int j = 0; j < 16; ++j) { v[j] = unpack4(*(const u32x2*)(XR + (size_t)row * D + 4 * (lane + 64 * j))); ss += v[j][0] * v[j][0] + v[j][1] * v[j][1] + v[j][2] * v[j][2] + v[j][3] * v[j][3]; }
        const float rs = rsqrtf(wave_sum(ss) * (1.f / D) + NORM_EPS);
#pragma unroll
        for (int j = 0; j < 16; ++j) { const int c = 4 * (lane + 64 * j); *(f32x4*)(a->out + (size_t)row * D + c) = (v[j] * rs) * *(const f32x4*)(gn + c); }
    }
}

struct InProj8 {
    static constexpr bool GATHER = false, FP8 = true;
    int K, G, c, lastl; const char* Hb; const char* Wb; bf16* ZA; float* GATES; bf16* ZC; bf16* SGp;
    DI bool next(int i, Unit& u) const { const long L = (long)i * G + c;
        if (!lastl) { if (L >= NPAN * TF8) return false; pg8::tile_of((int)L, NPAN, TF8, u.pm, u.pn); }
        else { if (L >= (NPAN - 1) * TF8 + TAC) return false;
            if (L < (NPAN - 1) * TF8) pg8::tile_of((int)L, NPAN - 1, TF8, u.pm, u.pn); else { u.pm = NPAN - 1; u.pn = (int)L - (NPAN - 1) * TF8; } }
        u.aux = 0; return true; }
    DI const char* a_ptr(const Unit& u) const { return Hb + (size_t)u.pm * 256 * D; }
    DI const char* b_ptr(const Unit& u) const { return Wb + (size_t)u.pn * 256 * D; }
    DI unsigned a_row_off(const Unit&, int) const { return 0u; }
    DI void epi(const f32x4 (&acc)[2][2][4][2], const Unit& u, int wr, int wc, int fr, int fq) const {
        const int pn = u.pn, r0 = u.pm * 256; const float ds = 1.f / 2048.f;
        if (pn < TAC) {
            EPI_LOOP({ const int gc = pn * 256 + cl; const f32x4 x0 = v0 * ds, x1 = v1 * ds;
                       if (gc < NA) { bf16* p = ZA + (size_t)(r0 + rl) * NA_P + gc; *(u32x4*)p = pack8(x0, x1);
                           if (gc >= 3072) { float* g = GATES + (size_t)(r0 + rl) * 32 + (gc - 3072); *(f32x4*)g = x0; *(f32x4*)(g + 4) = x1; } }
                       else if (gc < NAC) { bf16* p = ZC + (size_t)(r0 + rl) * NC_P + (gc - NA); *(u32x4*)p = pack8(x0, x1); } })
        } else {
            const int gcol = (pn - TAC) * 256 + ((pn - TAC) >= 16 ? D : 0);
            EPI_LOOP({ bf16* p = SGp + (size_t)(r0 + rl) * NG + gcol + cl;
                       f32x4 s0, s1;
                       _Pragma("unroll") for (int e = 0; e < 4; ++e) { s0[e] = sigmoidf_(v0[e] * ds); s1[e] = sigmoidf_(v1[e] * ds); }
                       *(u32x4*)p = pack8(s0, s1); })
        }
    }
};
struct InProj16 {
    static constexpr bool GATHER = false, FP8 = false;
    int K, G, c, nM; const char* Hb; const char* Wb; float* ZBT; bf16* SGp;
    DI bool next(int i, Unit& u) const { const long L = (long)i * G + c; if (L >= nM * T16) return false; pg8::tile_of((int)L, nM, T16, u.pm, u.pn); u.aux = (u.pn < TB); return true; }
    DI const char* a_ptr(const Unit& u) const { return u.aux ? Wb + (size_t)u.pn * 256 * D * 2 : Hb + (size_t)u.pm * 256 * D * 2; }
    DI const char* b_ptr(const Unit& u) const { return u.aux ? Hb + (size_t)u.pm * 256 * D * 2 : Wb + (size_t)u.pn * 256 * D * 2; }
    DI unsigned a_row_off(const Unit&, int) const { return 0u; }
    DI void epi(const f32x4 (&acc)[2][2][4][2], const Unit& u, int wr, int wc, int fr, int fq) const {
        const int pn = u.pn, r0 = u.pm * 256;
        if (pn < TB) {
            EPI_LOOP({ float* p = ZBT + (size_t)(pn * 256 + rl) * ROWS + r0 + cl; *(f32x4*)p = v0; *(f32x4*)(p + 4) = v1; })
        } else {
            EPI_LOOP({ bf16* p = SGp + (size_t)(r0 + rl) * NG + D + (pn - TB) * 256 + cl;
                       f32x4 s0, s1;
                       _Pragma("unroll") for (int e = 0; e < 4; ++e) { s0[e] = sigmoidf_(v0[e]); s1[e] = sigmoidf_(v1[e]); }
                       *(u32x4*)p = pack8(s0, s1); })
        }
    }
};
struct BranchProj8 {
    static constexpr bool GATHER = false, FP8 = true;
    int K, G, c, nM; const char* YS; const char* Wb; const bf16* SGp; bf16* M32;
    DI bool next(int i, Unit& u) const { const int j = i >> 1, bi = i & 1; const long L = (long)j * G + c; if (L >= nM * 16) return false; pg8::tile_of((int)L, nM, 16, u.pm, u.pn); u.aux = bi; return true; }
    DI const char* a_ptr(const Unit& u) const { return YS + ((size_t)u.aux * ROWS + (size_t)u.pm * 256) * DBR; }
    DI const char* b_ptr(const Unit& u) const { return Wb + ((size_t)u.aux * D + (size_t)u.pn * 256) * DBR; }
    DI unsigned a_row_off(const Unit&, int) const { return 0u; }
    DI void epi(const f32x4 (&acc)[2][2][4][2], const Unit& u, int wr, int wc, int fr, int fq) const {
        const int r0 = u.pm * 256, c0 = u.pn * 256, br = 2 * u.aux; const bool first = u.aux == 0; const float ds = 1.f / 2048.f;
        _Pragma("unroll") for (int ai = 0; ai < 2; ++ai) _Pragma("unroll") for (int mh = 0; mh < 2; ++mh) {
            u32x4 gwv[2][2], mv[2][2];
            EPI_GROUPS(ai, { const size_t row = (size_t)(r0 + rl); const int col = c0 + cl;
                             gwv[mm][bj] = *(const u32x4*)(SGp + row * NG + br * D + col); mv[mm][bj] = first ? (u32x4){0u, 0u, 0u, 0u} : *(const u32x4*)(M32 + row * D + col); })
            EPI_GROUPS(ai, { const size_t row = (size_t)(r0 + rl); const int col = c0 + cl; const f32x4 v0 = acc[ai][bj][m][0], v1 = acc[ai][bj][m][1];
                             f32x4 g0, g1, m0, m1; unpack8(gwv[mm][bj], g0, g1); unpack8(mv[mm][bj], m0, m1);
                             *(u32x4*)(M32 + row * D + col) = pack8(v0 * g0 * ds + m0, v1 * g1 * ds + m1); }) }
    }
};
struct BranchProj16 {
    static constexpr bool GATHER = false, FP8 = false;
    int K, G, c, nM; const char* YS; const char* Wb; const bf16* SGp; const bf16* M32; bf16* MERGED;
    DI bool next(int i, Unit& u) const { const long L = (long)i * G + c; if (L >= nM * 16) return false; pg8::tile_of((int)L, nM, 16, u.pm, u.pn); u.aux = 0; return true; }
    DI const char* a_ptr(const Unit& u) const { return YS + ((size_t)ROWS + (size_t)u.pm * 256) * DBR * 2; }
    DI const char* b_ptr(const Unit& u) const { return Wb + ((size_t)D + (size_t)u.pn * 256) * DBR * 2; }
    DI unsigned a_row_off(const Unit&, int) const { return 0u; }
    DI void epi(const f32x4 (&acc)[2][2][4][2], const Unit& u, int wr, int wc, int fr, int fq) const {
        const int r0 = u.pm * 256, c0 = u.pn * 256;
        _Pragma("unroll") for (int ai = 0; ai < 2; ++ai) _Pragma("unroll") for (int mh = 0; mh < 2; ++mh) {
            u32x4 gwv[2][2], mv[2][2];
            EPI_GROUPS(ai, { const size_t row = (size_t)(r0 + rl); const int col = c0 + cl;
                             gwv[mm][bj] = *(const u32x4*)(SGp + row * NG + D + col); mv[mm][bj] = *(const u32x4*)(M32 + row * D + col); })
            EPI_GROUPS(ai, { const size_t row = (size_t)(r0 + rl); const int col = c0 + cl; const f32x4 v0 = acc[ai][bj][m][0], v1 = acc[ai][bj][m][1];
                             f32x4 g0, g1, m0, m1; unpack8(gwv[mm][bj], g0, g1); unpack8(mv[mm][bj], m0, m1);
                             *(u32x4*)(MERGED + row * D + col) = pack8(v0 * g0 + m0, v1 * g1 + m1); }) }
    }
};
struct OutProj {
    static constexpr bool GATHER = false, FP8 = false;
    int K, G, c; const char* Ab; const char* Wb; bf16* XR; const float* gate;
    const float* xin; const float* cin;
    int nM;
    DI bool next(int i, Unit& u) const { const long L = (long)i * G + c; if (L >= nM * 16) return false; pg8::tile_of((int)L, nM, 16, u.pm, u.pn); u.aux = 0; return true; }
    DI const char* a_ptr(const Unit& u) const { return Ab + (size_t)u.pm * 256 * D * 2; }
    DI const char* b_ptr(const Unit& u) const { return Wb + (size_t)u.pn * 256 * D * 2; }
    DI unsigned a_row_off(const Unit&, int) const { return 0u; }
    DI void epi(const f32x4 (&acc)[2][2][4][2], const Unit& u, int wr, int wc, int fr, int fq) const {
        const int r0 = u.pm * 256, c0 = u.pn * 256; const float* g = gate + (u.pm == NPAN - 1 ? 6 * D : 0);
        const float* srcb = (u.pm == NPAN - 1) ? cin - (size_t)SEQ * D : xin; const bool fin = xin != nullptr;
        f32x4 gv[2][2];
        _Pragma("unroll") for (int bj = 0; bj < 2; ++bj) { const int col = c0 + bj * 128 + wc * 32 + 8 * fq; gv[bj][0] = *(const f32x4*)(g + col); gv[bj][1] = *(const f32x4*)(g + col + 4); }
        _Pragma("unroll") for (int ai = 0; ai < 2; ++ai) _Pragma("unroll") for (int mh = 0; mh < 2; ++mh) {
            f32x4 qa[2][2], qb[2][2];
            EPI_GROUPS(ai, { const int col = c0 + cl;
                             if (fin) { const float* q = srcb + (size_t)(r0 + rl) * D + col; qa[mm][bj] = *(const f32x4*)q; qb[mm][bj] = *(const f32x4*)(q + 4); }
                             else unpack8(*(const u32x4*)(XR + (size_t)(r0 + rl) * D + col), qa[mm][bj], qb[mm][bj]); })
            EPI_GROUPS(ai, { const int col = c0 + cl; const f32x4 v0 = acc[ai][bj][m][0], v1 = acc[ai][bj][m][1];
                             *(u32x4*)(XR + (size_t)(r0 + rl) * D + col) = pack8(qa[mm][bj] + gv[bj][0] * v0, qb[mm][bj] + gv[bj][1] * v1); }) }
    }
};

DI f32x4 mfma16h(f16x8 a, f16x8 b, f32x4 c) { return __builtin_amdgcn_mfma_f32_16x16x32_f16(a, b, c, 0, 0, 0); }
DI f32x2 cmul(f32x2 a, f32x2 b) { return (f32x2){a.x * b.x - a.y * b.y, a.x * b.y + a.y * b.x}; }
DI f32x2 cconj(f32x2 a) { return (f32x2){a.x, -a.y}; }
DI int sw(int i) { return i ^ ((i >> 5) & 31); }
DI f32x2 twid_r(float r) { return (f32x2){__builtin_amdgcn_cosf(r), -__builtin_amdgcn_sinf(r)}; }
template <int S, bool INV, int NBF> DI void fft_pass(LAS f32x2* Dm, int L, int lb, int tid) {
    constexpr int P = 1 << S;
    const int lh = lb - S, h = 1 << lh, nbt = L >> S; const float invB = 1.0f / (float)(1 << lb);
    constexpr float TC[8] = {1.f, 0.92387953251f, 0.70710678119f, 0.38268343236f, 0.f, -0.38268343236f, -0.70710678119f, -0.92387953251f};
    constexpr float TS[8] = {0.f, 0.38268343236f, 0.70710678119f, 0.92387953251f, 1.f, 0.92387953251f, 0.70710678119f, 0.38268343236f};
    for (int i0 = tid; i0 < nbt; i0 += NBF * NTHR) {
        f32x2 x[NBF][P]; int base[NBF]; float rr[NBF];
#pragma unroll
        for (int u = 0; u < NBF; ++u) { const int idx = i0 + u * NTHR; const int blk = idx >> lh, j = idx & (h - 1); base[u] = (blk << lb) + j; rr[u] = (float)j * invB;
            if (idx < nbt) {
#pragma unroll
                for (int k = 0; k < P; ++k) x[u][k] = Dm[sw(base[u] + k * h)]; } }
#pragma unroll
        for (int u = 0; u < NBF; ++u) { const int idx = i0 + u * NTHR;
            if (idx < nbt) {
                f32x2 wp[S]; wp[0] = twid_r(rr[u]); if (INV) wp[0] = cconj(wp[0]);
#pragma unroll
                for (int t = 1; t < S; ++t) wp[t] = cmul(wp[t - 1], wp[t - 1]);
#pragma unroll
                for (int ss = 0; ss < S; ++ss) { const int st = INV ? S - 1 - ss : ss; const int grp = 1 << (S - st), half = grp >> 1;
#pragma unroll
                    for (int kp = 0; kp < half; ++kp) { const int ci = kp << (4 - S + st);
                        const f32x2 cst = {TC[ci], INV ? TS[ci] : -TS[ci]};
                        const f32x2 tw = (ci == 0) ? wp[st] : cmul(wp[st], cst);
#pragma unroll
                        for (int g = 0; g < (1 << st); ++g) { const int ia = g * grp + kp, ib = ia + half;
                            if (!INV) { const f32x2 uu = x[u][ia] + x[u][ib], vv = cmul(x[u][ia] - x[u][ib], tw); x[u][ia] = uu; x[u][ib] = vv; }
                            else { const f32x2 tt = cmul(x[u][ib], tw); const f32x2 xa = x[u][ia]; x[u][ia] = xa + tt; x[u][ib] = xa - tt; } } } }
#pragma unroll
                for (int k = 0; k < P; ++k) Dm[sw(base[u] + k * h)] = x[u][k]; } }
    }
    __syncthreads();
}
DI void fft_fwd(LAS f32x2* Dm, int L, int lg, int tid) {
    int lb = lg;
    for (; lb >= 4; lb -= 4) fft_pass<4, false, 2>(Dm, L, lb, tid);
    if (lb == 2) fft_pass<2, false, 8>(Dm, L, 2, tid);
}
DI void fft_inv(LAS f32x2* Dm, int L, int lg, int tid) {
    const int rem = lg & 3;
    if (rem == 2) fft_pass<2, true, 8>(Dm, L, 2, tid);
    for (int lb = rem + 4; lb <= lg; lb += 4) fft_pass<4, true, 2>(Dm, L, lb, tid);
}
DI void fwd4(f32x2 (&x)[4]) { const f32x2 a0 = x[0] + x[2], a1 = x[1] + x[3], a2 = x[0] - x[2], d = x[1] - x[3]; const f32x2 a3 = {d.y, -d.x}; x[0] = a0 + a1; x[1] = a0 - a1; x[2] = a2 + a3; x[3] = a2 - a3; }
DI void inv4(f32x2 (&x)[4]) { const f32x2 b0 = x[0] + x[1], b1 = x[0] - x[1], b2 = x[2] + x[3], b3 = x[2] - x[3]; const f32x2 ib = {-b3.y, b3.x}; x[0] = b0 + b2; x[1] = b1 + ib; x[2] = b0 - b2; x[3] = b1 - ib; }
DI void fft_fwd3(LAS f32x2* Dm, int L, int tid) { int lb = 14; asm volatile("" : "+s"(lb)); for (; lb >= 6; lb -= 4) fft_pass<4, false, 2>(Dm, L, lb, tid); }
DI void fft_inv3(LAS f32x2* Dm, int L, int tid) { int lb = 6; asm volatile("" : "+s"(lb)); for (; lb <= 14; lb += 4) fft_pass<4, true, 2>(Dm, L, lb, tid); }
DI float block_sum(float v, LAS float* red, int tid) {
    v = wave_sum(v); __syncthreads(); if ((tid & 63) == 0) red[tid >> 6] = v; __syncthreads();
    float s = 0.f;
#pragma unroll
    for (int w = 0; w < NWAVES; ++w) s += red[w];
    return s;
}
DI void hyena_item(AP a, int l, int ch, int seq, LAS unsigned char* lds, unsigned char* scr_g) {
    const int tid = otid();
    const int L = seq ? CTX : SEQ, lg = seq ? 8 : 14, t0 = seq ? SEQ : 0, Lh = L >> 1;
    LAS f32x2* Dm = (LAS f32x2*)lds; LAS float* Df = (LAS float*)lds;
    LAS float* w3s = (LAS float*)(lds + LDS_SMALL);
    LAS float* red = w3s + 256;
    f32x4* G2 = (f32x4*)scr_g;
    float* Y1 = (float*)(scr_g + 131072 + 4096);
    float* K2 = (float*)(scr_g + 131072 + 4096 + 65536);
    const float* ZBT = (const float*)(a->ws + WS_ZBT);
        const float* cw = a->in[I_HCW] + (size_t)l * 3 * NB; const float* cb = a->in[I_HCB] + (size_t)l * NB;
    const float da = logf(1e-2f) / 1.5f, db = logf(1e-2f) / 0.3f;
    const float delta = fabsf(da + (float)ch * ((db - da) / 1023.f));
    const float invLm1 = 1.f / (float)(L - 1);
    __syncthreads();
    if (tid < 256) w3s[tid] = a->in[I_HW3][(size_t)l * 64 * 4096 + (size_t)(tid & 63) * 4096 + (tid >> 6) * 1024 + ch];
    __syncthreads();
    float ssq0 = 0.f, ssq1 = 0.f;
    if (tid == 0) { Df[2 * sw(Lh)] = 0.f; K2[2 * Lh] = 0.f; }
    {
        const int lane = tid & 63, wv = tid >> 6, r16 = lane & 15, q4 = lane >> 4;
        f16x8 wf[2];
#pragma unroll
        for (int ks = 0; ks < 2; ++ks)
#pragma unroll
            for (int e = 0; e < 8; ++e) wf[ks][e] = (_Float16)w3s[(r16 & 3) * 64 + 32 * ks + 8 * q4 + e];
        const _Float16* hb = (const _Float16*)(a->ws + WS_HDN) + ((size_t)l * ROWS + t0) * 64 + (size_t)r16 * 64 + 8 * q4;
        const int nblk = L >> 6;
        f16x8 cur[8], nxt[8];
        if (wv < nblk) {
#pragma unroll
            for (int j = 0; j < 8; ++j) cur[j] = *(const f16x8*)(hb + (size_t)(wv * 64 + (j >> 1) * 16) * 64 + 32 * (j & 1)); }
        for (int blk = wv; blk < nblk; blk += NWAVES) {
            if (blk + NWAVES < nblk) {
#pragma unroll
                for (int j = 0; j < 8; ++j) nxt[j] = *(const f16x8*)(hb + (size_t)((blk + NWAVES) * 64 + (j >> 1) * 16) * 64 + 32 * (j & 1)); }
            f32x4 sv = {0.f, 0.f, 0.f, 0.f};
#pragma unroll
            for (int g = 0; g < 4; ++g) { f32x4 acc = {0.f, 0.f, 0.f, 0.f};
                acc = mfma16h(wf[0], cur[2 * g], acc); acc = mfma16h(wf[1], cur[2 * g + 1], acc);
                sv = (q4 == g) ? acc : sv; }
            const int P = blk * 64 + lane; const float wd = expf(-(float)P * invLm1 * delta);
            const float kf1 = sv[0] * wd, kb1 = sv[1] * wd, kf2 = sv[2] * wd, kb2 = sv[3] * wd;
            Df[2 * sw(P >> 1) + (P & 1)] = kf1; K2[P] = kf2; ssq0 += kf1 * kf1; ssq1 += kf2 * kf2;
            if (P >= 1) { const int eb = 2 * L - P; Df[2 * sw(eb >> 1) + (eb & 1)] = kb1; K2[eb] = kb2; ssq0 += kb1 * kb1; ssq1 += kb2 * kb2; }
#pragma unroll
            for (int j = 0; j < 8; ++j) cur[j] = nxt[j];
        }
    }
    const float ksc0 = rsqrtf(block_sum(ssq0, red, tid)) / (float)L, ksc1 = rsqrtf(block_sum(ssq1, red, tid)) / (float)L;
    for (int cv = 0; cv < 2; ++cv) {
        const float kscale = cv ? ksc1 : ksc0;
        if (cv == 1) { __syncthreads(); for (int n = tid; n < L; n += NTHR) Dm[sw(n)] = *(const f32x2*)(K2 + 2 * n); __syncthreads(); }
        if (seq == 0) {
            fft_fwd3(Dm, L, tid);
#pragma unroll 1
            for (int it = 0; it < 4; ++it) { const int wq = it * NTHR + tid, r = (tid >> 6) + 8 * it, ln = tid & 63; const int kb = ((r >> 4) << 10) | ((ln >> 5) << 9) | ((ln & 31) << 4) | (r & 15);
                if (kb == 0) continue;
                const int g4 = 4 * (int)(__brev((unsigned)kb) >> 20), gp4 = 4 * (int)(__brev((unsigned)(4096 - kb)) >> 20);
                f32x2 y[4], yp[4];
#pragma unroll
                for (int i = 0; i < 4; ++i) { y[i] = Dm[sw(g4 + i)]; yp[i] = Dm[sw(gp4 + i)]; }
                fwd4(y); fwd4(yp);
                G2[4 * wq] = (f32x4){y[0].x, y[0].y, yp[3].x, yp[3].y}; G2[4 * wq + 1] = (f32x4){y[2].x, y[2].y, yp[1].x, yp[1].y};
                G2[4 * wq + 2] = (f32x4){yp[2].x, yp[2].y, y[1].x, y[1].y}; G2[4 * wq + 3] = (f32x4){yp[0].x, yp[0].y, y[3].x, y[3].y}; }
            if (tid == 0 || tid == 64) { const int g4 = tid ? 4 : 0; f32x2 y[4];
#pragma unroll
                for (int i = 0; i < 4; ++i) y[i] = Dm[sw(g4 + i)];
                fwd4(y);
                if (tid == 0) { G2[8192] = (f32x4){y[0].x, y[0].y, y[0].x, y[0].y}; G2[8193] = (f32x4){y[1].x, y[1].y, y[1].x, y[1].y}; G2[8194] = (f32x4){y[2].x, y[2].y, y[3].x, y[3].y}; }
                else { G2[8195] = (f32x4){y[0].x, y[0].y, y[3].x, y[3].y}; G2[8196] = (f32x4){y[2].x, y[2].y, y[1].x, y[1].y}; } }
        } else {
        fft_fwd(Dm, L, lg, tid);
        for (int k = tid; k <= Lh; k += NTHR) { const int mk = (L - k) & (L - 1);
            const int pk = (int)(__brev((unsigned)k) >> (32 - lg)), pm = (int)(__brev((unsigned)mk) >> (32 - lg));
            const f32x2 zk = Dm[sw(pk)], zkm = Dm[sw(pm)]; G2[k] = (f32x4){zk.x, zk.y, zkm.x, zkm.y}; }
        }
        __syncthreads();
        const float w0 = cw[ch], w1c = cw[NB + ch], w2c = cw[2 * NB + ch], bb = cb[ch];
        const float* zv = ZBT + (size_t)ch * ROWS + t0;
#pragma unroll 8
        for (int n = tid; n < L; n += NTHR) {
            f32x2 v = {0.f, 0.f};
            if (n < Lh) {
                if (cv == 0) { const int t = 2 * n; const float zm = t > 0 ? zv[t - 1] : 0.f, z2 = (t + 2 < L) ? zv[t + 2] : 0.f; const f32x2 z01 = *(const f32x2*)(zv + t);
                    v.x = zm * w0 + z01.x * w1c + z01.y * w2c + bb; v.y = z01.x * w0 + z01.y * w1c + z2 * w2c + bb; }
                else v = *(const f32x2*)(Y1 + 2 * n);
            }
            Dm[sw(n)] = v; }
        __syncthreads();
        if (seq == 0) {
            fft_fwd3(Dm, L, tid);
            auto spec = [&](int k, f32x4 g, f32x2 zu, f32x2 zum, f32x2& ou, f32x2& om) {
                const f32x2 zk = {g[0], g[1]}, zkm = {g[2], g[3]};
                const f32x2 ue = (zu + cconj(zum)) * 0.5f, du = zu - cconj(zum), uo = (f32x2){0.5f * du.y, -0.5f * du.x};
                const f32x2 ke = (zk + cconj(zkm)) * 0.5f, dk = zk - cconj(zkm), ko = (f32x2){0.5f * dk.y, -0.5f * dk.x};
                const f32x2 w = twid_r((float)k * (1.0f / 16384.f));
                const f32x2 ye = cmul(ue, ke) + cmul(w, cmul(uo, ko)), yo = cmul(ue, ko) + cmul(uo, ke);
                ou = (f32x2){ye.x - yo.y, ye.y + yo.x}; om = (f32x2){ye.x + yo.y, -ye.y + yo.x}; };
            f32x4 gq[4];
#pragma unroll
            for (int j = 0; j < 4; ++j) gq[j] = G2[4 * tid + j];
#pragma unroll 1
            for (int it = 0; it < 4; ++it) { const int wq = it * NTHR + tid, r = (tid >> 6) + 8 * it, ln = tid & 63; const int kb = ((r >> 4) << 10) | ((ln >> 5) << 9) | ((ln & 31) << 4) | (r & 15);
                const f32x4 gc0 = gq[0], gc1 = gq[1], gc2 = gq[2], gc3 = gq[3];
                if (it + 1 < 4) {
#pragma unroll
                    for (int j = 0; j < 4; ++j) gq[j] = G2[4 * (wq + NTHR) + j]; }
                if (kb == 0) continue;
                const int g4 = 4 * (int)(__brev((unsigned)kb) >> 20), gp4 = 4 * (int)(__brev((unsigned)(4096 - kb)) >> 20);
                f32x2 y[4], yp[4], o[4], op[4];
#pragma unroll
                for (int i = 0; i < 4; ++i) { y[i] = Dm[sw(g4 + i)]; yp[i] = Dm[sw(gp4 + i)]; }
                fwd4(y); fwd4(yp);
                spec(kb, gc0, y[0], yp[3], o[0], op[3]); spec(kb + 4096, gc1, y[2], yp[1], o[2], op[1]); spec(8192 - kb, gc2, yp[2], y[1], op[2], o[1]); spec(4096 - kb, gc3, yp[0], y[3], op[0], o[3]);
                inv4(o); inv4(op);
#pragma unroll
                for (int i = 0; i < 4; ++i) { Dm[sw(g4 + i)] = o[i]; Dm[sw(gp4 + i)] = op[i]; } }
            if (tid == 0 || tid == 64) {
                const int g4 = tid ? 4 : 0; f32x2 y[4], o[4], dum;
#pragma unroll
                for (int i = 0; i < 4; ++i) y[i] = Dm[sw(g4 + i)];
                fwd4(y);
                if (tid == 0) { spec(0, G2[8192], y[0], y[0], o[0], dum); spec(8192, G2[8193], y[1], y[1], o[1], dum); spec(4096, G2[8194], y[2], y[3], o[2], o[3]); }
                else { spec(2048, G2[8195], y[0], y[3], o[0], o[3]); spec(6144, G2[8196], y[2], y[1], o[2], o[1]); }
                inv4(o);
#pragma unroll
                for (int i = 0; i < 4; ++i) Dm[sw(g4 + i)] = o[i]; }
            __syncthreads();
            fft_inv3(Dm, L, tid);
        } else {
        fft_fwd(Dm, L, lg, tid);
#pragma unroll 4
        for (int k = tid; k <= Lh; k += NTHR) {
            const int mk = (L - k) & (L - 1);
            const int pk = (int)(__brev((unsigned)k) >> (32 - lg)), pm = (int)(__brev((unsigned)mk) >> (32 - lg));
            const int spk = sw(pk), spm = sw(pm);
            const f32x4 g = G2[k]; const f32x2 zu = Dm[spk], zum = Dm[spm], zk = {g[0], g[1]}, zkm = {g[2], g[3]};
            const f32x2 ue = (zu + cconj(zum)) * 0.5f, du = zu - cconj(zum), uo = (f32x2){0.5f * du.y, -0.5f * du.x};
            const f32x2 ke = (zk + cconj(zkm)) * 0.5f, dk = zk - cconj(zkm), ko = (f32x2){0.5f * dk.y, -0.5f * dk.x};
            const f32x2 w = twid_r((float)k * (1.0f / (float)L));
            const f32x2 ye = cmul(ue, ke) + cmul(w, cmul(uo, ko)), yo = cmul(ue, ko) + cmul(uo, ke);
            Dm[spk] = (f32x2){ye.x - yo.y, ye.y + yo.x};
            if (pm != pk) Dm[spm] = (f32x2){ye.x + yo.y, -ye.y + yo.x}; }
        __syncthreads();
        fft_inv(Dm, L, lg, tid);
        }
        const float skip = a->in[I_HSKIP][(size_t)l * 2 * DBR + cv * DBR + ch];
        const int chg = (cv == 0 ? DBR : 2 * DBR) + ch;
        const float g0 = cw[chg], g1 = cw[NB + chg], g2 = cw[2 * NB + chg], gb = cb[chg];
        const float* zg = ZBT + (size_t)chg * ROWS + t0;
        float* YBT = (float*)(a->ws + WS_YBT) + (size_t)ch * ROWS + t0;
#pragma unroll 8
        for (int n = tid; n < Lh; n += NTHR) { const int t = 2 * n;
            const f32x2 c = Dm[sw(n)] * kscale;
            f32x2 s;
            if (cv == 0) { const float zm = t > 0 ? zv[t - 1] : 0.f, z2 = (t + 2 < L) ? zv[t + 2] : 0.f; const f32x2 z01 = *(const f32x2*)(zv + t);
                s.x = zm * w0 + z01.x * w1c + z01.y * w2c + bb; s.y = z01.x * w0 + z01.y * w1c + z2 * w2c + bb; }
            else s = *(const f32x2*)(Y1 + t);
            const float qm = t > 0 ? zg[t - 1] : 0.f, q2 = (t + 2 < L) ? zg[t + 2] : 0.f; const f32x2 q01 = *(const f32x2*)(zg + t);
            const f32x2 ug = {qm * g0 + q01.x * g1 + q01.y * g2 + gb, q01.x * g0 + q01.y * g1 + q2 * g2 + gb};
            const f32x2 o = ug * (c + s * skip);
            if (cv == 0) *(f32x2*)(Y1 + t) = o; else *(f32x2*)(YBT + t) = o; }
        __syncthreads();
    }
}
DI void phase_yb_transpose(AP a, LAS unsigned char* lds, int bid, int G, int ncol64) {
    const int tid_o = otid(), lane = tid_o & 63, wave = tid_o >> 6;
    LAS float* scr = (LAS float*)(lds + wave * 16640);
    const float* YBT = (const float*)(a->ws + WS_YBT); bf16* YB = (bf16*)(a->ws + WS_YS) + (size_t)1 * ROWS * DBR;
    for (int it = bid * NWAVES + wave; it < (DBR / 64) * ncol64; it += G * NWAVES) {
        const int cbk = it / ncol64, tb = it % ncol64;
        transpose_tile(YBT, ROWS, cbk * 64, tb * 64, YB, DBR, scr, lane); }
}

constexpr int ML_LD = 72;
constexpr int ML_QS = 0, ML_QE = 9216, ML_KS = 18432, ML_KPT = 27648, ML_SS = 36864, ML_VT = 46080, ML_CT = 66816, ML_GB = 87552, ML_GA = ML_GB + 256, ML_DEN = ML_GA + 256;
DI f32x4 mfma16(bf16x8 a, bf16x8 b, f32x4 c) { return __builtin_amdgcn_mfma_f32_16x16x32_bf16(a, b, c, 0, 0, 0); }
DI bf16x8 ldfrag(const LAS bf16* tile, int row0, int kofs, int lane) { return *(const LAS bf16x8*)(tile + (row0 + (lane & 15)) * ML_LD + kofs + 8 * (lane >> 4)); }
DI unsigned short f2bf(float f) { return (unsigned short)(cvt_pk_bf16(f, 0.f) & 0xffffu); }
DI int ml_row(int d, int ci, int j) { if (d == 0) { const int r0 = ci < 4 ? SEQ + 64 * ci : 64 * (ci - 4); return r0 + j; } const int r0 = ci < 4 ? SEQ + 64 * (3 - ci) : 64 * (259 - ci); return r0 + 63 - j; }
DI void mlstm_scan(AP a, int l, int h, int d, LAS unsigned char* lds) {
    const int tid = otid(), lane = tid & 63, w = tid >> 6, q4 = lane >> 4, r16 = lane & 15;
    LAS bf16* Qs = (LAS bf16*)(lds + ML_QS); LAS bf16* Qe = (LAS bf16*)(lds + ML_QE); LAS bf16* Ks = (LAS bf16*)(lds + ML_KS); LAS bf16* Kpt = (LAS bf16*)(lds + ML_KPT);
    LAS bf16* Ss = (LAS bf16*)(lds + ML_SS); LAS bf16* Vt = (LAS bf16*)(lds + ML_VT); LAS bf16* Ct = (LAS bf16*)(lds + ML_CT);
    LAS float* bc = (LAS float*)(lds + ML_GB); LAS float* av = (LAS float*)(lds + ML_GA); LAS float* den = (LAS float*)(lds + ML_DEN);
    const bf16* ZA = (const bf16*)(a->ws + WS_ZA); const float* GT = (const float*)(a->ws + WS_GATES);
    float* HD = (float*)(a->ws + WS_HDIR) + (size_t)d * ROWS * DBR;
    const float bias_i = a->in[I_MGB][l * 32 + d * 16 + h], bias_f = a->in[I_MGB][l * 32 + d * 16 + 8 + h];
    __syncthreads();
    for (int i = tid; i < 144 * ML_LD; i += NTHR) Ct[i] = 0;
    for (int i = tid; i < 16 * ML_LD; i += NTHR) Vt[128 * ML_LD + i] = (i < ML_LD) ? (bf16)0x3f80 : (bf16)0;
    f32x4 st[5];
#pragma unroll
    for (int j = 0; j < 5; ++j) st[j] = (f32x4){0.f, 0.f, 0.f, 0.f};
    const int jrow = tid >> 3, kb = tid & 7;
    u32x4 rq, rk, rv0, rv1; float gi = 0.f, gf = 0.f;
#define ML_LOAD(ci) do { const int row_ = ml_row(d, (ci), jrow); const bf16* zr_ = ZA + (size_t)row_ * NA_P; rq = *(const u32x4*)(zr_ + h * 64 + 8 * kb); rk = *(const u32x4*)(zr_ + 512 + h * 64 + 8 * kb); \
        rv0 = *(const u32x4*)(zr_ + 1024 + h * 128 + 16 * kb); rv1 = *(const u32x4*)(zr_ + 1024 + h * 128 + 16 * kb + 8); \
        if (tid < 64) { const int rw_ = ml_row(d, (ci), tid); gi = GT[(size_t)rw_ * 32 + d * 16 + h]; gf = GT[(size_t)rw_ * 32 + d * 16 + 8 + h]; } } while (0)
    ML_LOAD(0);
    for (int ci = 0; ci < 260; ++ci) {
        if (w == 0) {
            const float ip = 15.f * tanhf((gi + bias_i) * (1.f / 15.f)), fp = 15.f * tanhf((gf + bias_f) * (1.f / 15.f));
            float cum = fp >= 0.f ? -log1pf(expf(-fp)) : fp - log1pf(expf(fp));
#pragma unroll
            for (int o = 1; o < 64; o <<= 1) { const float t = __shfl_up(cum, o); if (lane >= o) cum += t; }
            bc[lane] = cum; av[lane] = ip;
        }
        __syncthreads();
        {
            const float bj = bc[jrow], eb = expf(bj), wk = expf(bc[63] - bj + av[jrow]);
            const unsigned qw[4] = {rq.x, rq.y, rq.z, rq.w}, kw[4] = {rk.x, rk.y, rk.z, rk.w};
            f32x4 q0, q1;
#pragma unroll
            for (int e = 0; e < 4; ++e) { const float lo = __uint_as_float(qw[e] << 16) * 0.125f, hi = __uint_as_float(qw[e] & 0xffff0000u) * 0.125f;
                if (e < 2) { q0[2 * e] = lo; q0[2 * e + 1] = hi; } else { q1[2 * (e - 2)] = lo; q1[2 * (e - 2) + 1] = hi; } }
            *(LAS u32x4*)(Qs + jrow * ML_LD + 8 * kb) = pack8(q0, q1);
            *(LAS u32x4*)(Qe + jrow * ML_LD + 8 * kb) = pack8(q0 * eb, q1 * eb);
            *(LAS u32x4*)(Ks + jrow * ML_LD + 8 * kb) = rk;
#pragma unroll
            for (int e = 0; e < 4; ++e) { Kpt[(8 * kb + 2 * e) * ML_LD + jrow] = f2bf(__uint_as_float(kw[e] << 16) * wk); Kpt[(8 * kb + 2 * e + 1) * ML_LD + jrow] = f2bf(__uint_as_float(kw[e] & 0xffff0000u) * wk); }
            const unsigned vw[8] = {rv0.x, rv0.y, rv0.z, rv0.w, rv1.x, rv1.y, rv1.z, rv1.w};
#pragma unroll
            for (int e = 0; e < 8; ++e) { Vt[(16 * kb + 2 * e) * ML_LD + jrow] = (bf16)(vw[e] & 0xffffu); Vt[(16 * kb + 2 * e + 1) * ML_LD + jrow] = (bf16)(vw[e] >> 16); }
        }
        if (ci + 1 < 260) ML_LOAD(ci + 1);
        __syncthreads();
#pragma unroll
        for (int tt = 0; tt < 2; ++tt) { const int tau = 2 * w + tt, mt = tau >> 2, ns = tau & 3;
            f32x4 acc = {0.f, 0.f, 0.f, 0.f};
            if (ns <= mt) {
#pragma unroll
                for (int ks = 0; ks < 2; ++ks) acc = mfma16(ldfrag(Qs, 16 * mt, 32 * ks, lane), ldfrag(Ks, 16 * ns, 32 * ks, lane), acc); }
            const int sx = 16 * ns + r16; const float bs = bc[sx] - av[sx];
#pragma unroll
            for (int i = 0; i < 4; ++i) { const int t = 16 * mt + 4 * q4 + i; const float val = (sx <= t) ? acc[i] * expf(bc[t] - bs) : 0.f; Ss[t * ML_LD + sx] = f2bf(val); } }
        __syncthreads();
        f32x4 nacc[5];
#pragma unroll
        for (int j = 0; j < 5; ++j) { const int tau = w + 8 * j; nacc[j] = (f32x4){0.f, 0.f, 0.f, 0.f};
            if (tau < 36) { const int mt = tau / 9, nv = tau - 9 * mt; f32x4 acc = {0.f, 0.f, 0.f, 0.f};
#pragma unroll
                for (int ks = 0; ks < 2; ++ks) acc = mfma16(ldfrag(Ss, 16 * mt, 32 * ks, lane), ldfrag(Vt, 16 * nv, 32 * ks, lane), acc);
#pragma unroll
                for (int ks = 0; ks < 2; ++ks) acc = mfma16(ldfrag(Qe, 16 * mt, 32 * ks, lane), ldfrag(Ct, 16 * nv, 32 * ks, lane), acc);
                nacc[j] = acc;
                if (nv == 8 && r16 == 0) {
#pragma unroll
                    for (int i = 0; i < 4; ++i) den[16 * mt + 4 * q4 + i] = acc[i]; } } }
        __syncthreads();
#pragma unroll
        for (int j = 0; j < 5; ++j) { const int tau = w + 8 * j;
            if (tau < 36) { const int mt = tau / 9, nv = tau - 9 * mt;
                if (nv < 8) {
#pragma unroll
                    for (int i = 0; i < 4; ++i) { const int t = 16 * mt + 4 * q4 + i; const float dd = 1.f / fmaxf(fabsf(den[t]), 1.f);
                        HD[(size_t)ml_row(d, ci, t) * DBR + h * 128 + 16 * nv + r16] = nacc[j][i] * dd; } } } }
        { const float g = expf(bc[63]);
#pragma unroll
            for (int j = 0; j < 5; ++j) { const int tau = w + 8 * j;
                if (tau < 36) { const int mv = tau >> 2, nk = tau & 3; f32x4 acc = st[j] * g;
#pragma unroll
                    for (int ks = 0; ks < 2; ++ks) acc = mfma16(ldfrag(Vt, 16 * mv, 32 * ks, lane), ldfrag(Kpt, 16 * nk, 32 * ks, lane), acc);
                    st[j] = acc;
#pragma unroll
                    for (int i = 0; i < 4; ++i) Ct[(16 * mv + 4 * q4 + i) * ML_LD + 16 * nk + r16] = f2bf(acc[i]); } } }
        __syncthreads();
    }
#undef ML_LOAD
}

DI int rw_row(int P) { if (P < CTX) return SEQ + P; const int p = P - CTX; return (p & 255) * 64 + (p >> 8); }
constexpr int RW_TOK = 8;
constexpr int PT = 13, PLD = 456, P_RKV = 16 * PLD * 2;
DI void rwkv_prep_item(AP a, int l, int item, LAS unsigned char* lds) {
    const int tid = otid(), lane = tid & 63, wv = __builtin_amdgcn_readfirstlane(tid >> 6), q4 = lane >> 4, r16 = lane & 15;
    LAS bf16* LI = (LAS bf16*)lds;
    LAS bf16* RKV = (LAS bf16*)(lds + P_RKV);
    const bf16* ZC = (const bf16*)(a->ws + WS_ZC); const float* mu = a->in[I_RMU] + (size_t)l * NC;
    const int P0 = item * PT;
    __syncthreads();
    for (int i = tid; i < 3 * PLD; i += NTHR) LI[PT * PLD + i] = 0;
    for (int idx = tid; idx < PT * (NC / 4); idx += NTHR) { const int tt = idx / (NC / 4), c = 4 * (idx - tt * (NC / 4)); const int P = P0 + tt;
        const bool hp = (P != 0 && P != CTX), hn = (P != CTX - 1 && P != ROWS - 1);
        const f32x4 z0 = unpack4(*(const u32x2*)(ZC + (size_t)rw_row(P) * NC_P + c));
        const f32x4 zp = hp ? unpack4(*(const u32x2*)(ZC + (size_t)rw_row(P - 1) * NC_P + c)) : (f32x4){0.f, 0.f, 0.f, 0.f};
        const f32x4 zn = hn ? unpack4(*(const u32x2*)(ZC + (size_t)rw_row(P + 1) * NC_P + c)) : (f32x4){0.f, 0.f, 0.f, 0.f};
        f32x4 z = z0 + *(const f32x4*)(mu + c) * ((zp + zn) * 0.5f - z0);
        if (c >= 3072 && c < 3200) {
#pragma unroll
            for (int e = 0; e < 4; ++e) z[e] = tanhf(z[e]); }
        if (c >= 3328) {
#pragma unroll
            for (int e = 0; e < 4; ++e) z[e] = sigmoidf_(z[e]); }
        u32x2 w; w.x = cvt_pk_bf16(z[0], z[1]); w.y = cvt_pk_bf16(z[2], z[3]);
        if (c < 3072) *(LAS u32x2*)(RKV + tt * 3072 + c) = w; else *(LAS u32x2*)(LI + tt * PLD + (c - 3072)) = w; }
    __syncthreads();
    const bf16* LT = (const bf16*)(a->ws + WS_LORAT) + (size_t)l * LORAT_L;
    _Float16* ST = (_Float16*)(a->ws + WS_STREAM); float* RV = (float*)(a->ws + WS_RV); float* RS = (float*)(a->ws + WS_RSCAL); float* RG = (float*)(a->ws + WS_RG); float* RB = (float*)(a->ws + WS_RBON);
    for (int hs = 0; hs < 2; ++hs) { const int hh = wv + 8 * hs;
        float inv[4] = {0.f, 0.f, 0.f, 0.f};
#pragma unroll
        for (int ct = 0; ct < 4; ++ct) { const int c = hh * 64 + ct * 16 + r16; const float kkw = a->in[I_RKK][l * DBR + c];
#pragma unroll
            for (int i = 0; i < 4; ++i) { const float kv = bf2f(RKV[(4 * q4 + i) * 3072 + 1024 + c]) * kkw; inv[i] += kv * kv; } }
#pragma unroll
        for (int i = 0; i < 4; ++i) inv[i] = 1.f / fmaxf(sqrtf(rowsum16(inv[i])), 1e-12f);
        float brp[2][4], krp[2][4], bd[4], vkeep[4][4];
#pragma unroll
        for (int i = 0; i < 4; ++i) { bd[i] = 0.f; brp[0][i] = 0.f; brp[1][i] = 0.f; krp[0][i] = 0.f; krp[1][i] = 0.f; }
#pragma unroll
        for (int ct = 0; ct < 4; ++ct) { const int cc = ct * 16 + r16, c = hh * 64 + cc;
            f32x4 accW[2], accA[2], accG = {0.f, 0.f, 0.f, 0.f};
#pragma unroll
            for (int d = 0; d < 2; ++d) { accW[d] = (f32x4){0.f, 0.f, 0.f, 0.f}; accA[d] = (f32x4){0.f, 0.f, 0.f, 0.f};
#pragma unroll
                for (int ks = 0; ks < 2; ++ks) {
                    accW[d] = mfma16(*(const LAS bf16x8*)(LI + r16 * PLD + d * 64 + 32 * ks + 8 * q4), *(const bf16x8*)(LT + ((size_t)d * 1024 + c) * 64 + 32 * ks + 8 * q4), accW[d]);
                    accA[d] = mfma16(*(const LAS bf16x8*)(LI + r16 * PLD + 128 + d * 64 + 32 * ks + 8 * q4), *(const bf16x8*)(LT + LORAT_A + ((size_t)d * 1024 + c) * 64 + 32 * ks + 8 * q4), accA[d]); } }
#pragma unroll
            for (int ks = 0; ks < 5; ++ks) accG = mfma16(*(const LAS bf16x8*)(LI + r16 * PLD + 256 + 32 * ks + 8 * q4), *(const bf16x8*)(LT + LORAT_G + (size_t)c * 160 + 32 * ks + 8 * q4), accG);
            const float kkw = a->in[I_RKK][l * DBR + c], ka_w = a->in[I_RKA][l * DBR + c], rk_w = a->in[I_RRK][l * DBR + c];
            const float w0a = a->in[I_RW0][(l * 2 + 0) * DBR + c], w0b = a->in[I_RW0][(l * 2 + 1) * DBR + c], a0a = a->in[I_RA0][(l * 2 + 0) * DBR + c], a0b = a->in[I_RA0][(l * 2 + 1) * DBR + c];
#pragma unroll
            for (int i = 0; i < 4; ++i) { const int t = 4 * q4 + i; const bool valid = t < PT; const int P = P0 + t;
                const float r = bf2f(RKV[t * 3072 + c]), k = bf2f(RKV[t * 3072 + 1024 + c]), v = bf2f(RKV[t * 3072 + 2048 + c]);
                const float kk = k * kkw * inv[i];
                float kd[2];
#pragma unroll
                for (int d = 0; d < 2; ++d) {
                    const float wdec = expf(-0.6065306597126334f * sigmoidf_((d ? w0b : w0a) + accW[d][i]));
                    const float ain = sigmoidf_((d ? a0b : a0a) + accA[d][i]);
                    kd[d] = k * (1.f + (ain - 1.f) * ka_w);
                    const float bb = kk * ain;
                    if (valid) { _Float16* sp = ST + ((((size_t)d * 16 + hh) * ROWS + P) * 5) * 64 + cc; sp[0] = (_Float16)wdec; sp[64] = (_Float16)bb; sp[128] = (_Float16)kd[d]; sp[192] = (_Float16)kk; sp[256] = (_Float16)(wdec * r); }
                    brp[d][i] += bb * r; krp[d][i] += kd[d] * r; }
                bd[i] += r * (kd[0] + kd[1]) * rk_w;
                if (valid) { RV[(size_t)P * DBR + c] = v; RG[(size_t)P * DBR + c] = accG[i]; }
                vkeep[ct][i] = v; } }
#pragma unroll
        for (int i = 0; i < 4; ++i) { const int t = 4 * q4 + i; const bool valid = t < PT; const int P = P0 + t;
#pragma unroll
            for (int d = 0; d < 2; ++d) { const float br = rowsum16(brp[d][i]), kr = rowsum16(krp[d][i]);
                if (valid && r16 == 0) { float* q = RS + (((size_t)d * 16 + hh) * ROWS + P) * 2; q[0] = br; q[1] = kr; } }
            const float bdt = rowsum16(bd[i]);
            if (valid) {
#pragma unroll
                for (int ct = 0; ct < 4; ++ct) RB[(size_t)P * DBR + hh * 64 + ct * 16 + r16] = bdt * vkeep[ct][i]; } }
    }
}
constexpr int RW_CH = 32, RW_ROWS = 16, RW_NLD = 256, RW_CHB = RW_CH * 1280 + RW_CH * RW_ROWS * 4 + RW_CH * 8;
DI int rw_stepP(int d, int n) { return d == 0 ? n : (n < CTX ? CTX - 1 - n : ROWS + CTX - 1 - n); }
struct RwRegs { f32x4 m[5]; float v[2], sc; };
DI void rw_issue(RwRegs& R, int c, int d, int lt, const _Float16* ST, const float* RV, const float* RS) {
    const int n0 = c * RW_CH; const int Pa = rw_stepP(d, n0), Pb = rw_stepP(d, n0 + RW_CH - 1); const int Pmin = Pa < Pb ? Pa : Pb;
    const f32x4* src = (const f32x4*)(ST + (size_t)Pmin * 320);
#pragma unroll
    for (int k = 0; k < 5; ++k) R.m[k] = src[lt + RW_NLD * k];
#pragma unroll
    for (int k = 0; k < 2; ++k) { const int i = lt + RW_NLD * k; R.v[k] = RV[(size_t)(Pmin + (i >> 4)) * DBR + (i & 15)]; }
    if (lt < RW_CH * 2) R.sc = RS[(size_t)Pmin * 2 + lt];
}
DI void rw_commit(const RwRegs& R, int c, int d, int lt, LAS unsigned char* lds) {
    LAS float* buf = (LAS float*)(lds + (c % 3) * RW_CHB);
    const bool desc = d != 0;
#pragma unroll
    for (int k = 0; k < 5; ++k) { const int i = lt + RW_NLD * k, st = i / 40, w = i - 40 * st; const f16x8 h = __builtin_bit_cast(f16x8, R.m[k]);
        LAS float* q = buf + (desc ? RW_CH - 1 - st : st) * 320 + 8 * w;
        *(LAS f32x4*)q = (f32x4){(float)h[0], (float)h[1], (float)h[2], (float)h[3]}; *(LAS f32x4*)(q + 4) = (f32x4){(float)h[4], (float)h[5], (float)h[6], (float)h[7]}; }
#pragma unroll
    for (int k = 0; k < 2; ++k) { const int i = lt + RW_NLD * k, st = i >> 4; buf[RW_CH * 320 + (desc ? RW_CH - 1 - st : st) * RW_ROWS + (i & 15)] = R.v[k]; }
    if (lt < RW_CH * 2) { const int st = lt >> 1; buf[RW_CH * 320 + RW_CH * RW_ROWS + (desc ? RW_CH - 1 - st : st) * 2 + (lt & 1)] = R.sc; }
}
DI void rwkv_scan(AP a, int item, LAS unsigned char* lds) {
    const int tid = otid(), lane = tid & 63, wv = tid >> 6;
    const int hd = item >> 2, d = hd >> 4, hh = hd & 15, rb = item & 3;
    const _Float16* ST = (const _Float16*)(a->ws + WS_STREAM) + (((size_t)d * 16 + hh) * ROWS) * 320;
    const float* RV = (const float*)(a->ws + WS_RV) + hh * 64 + rb * RW_ROWS; const float* RS = (const float*)(a->ws + WS_RSCAL) + (((size_t)d * 16 + hh) * ROWS) * 2;
    float* RY = (float*)(a->ws + WS_RY) + (size_t)d * ROWS * DBR + hh * 64 + rb * RW_ROWS;
    constexpr int NCHUNK = ROWS / RW_CH;
    __syncthreads();
    RwRegs R; const int lt = tid - 256;
    if (wv >= 4) { rw_issue(R, 0, d, lt, ST, RV, RS); rw_commit(R, 0, d, lt, lds); rw_issue(R, 1, d, lt, ST, RV, RS); rw_commit(R, 1, d, lt, lds); rw_issue(R, 2, d, lt, ST, RV, RS); }
    __syncthreads();
    f32x4 S = {0.f, 0.f, 0.f, 0.f};
    const int jg = lane & 15, rg = lane >> 4, vrow = wv * 4 + rg;
    for (int c = 0; c < NCHUNK; ++c) {
        if (wv >= 4) { if (c + 2 < NCHUNK) rw_commit(R, c + 2, d, lt, lds); if (c + 3 < NCHUNK) rw_issue(R, c + 3, d, lt, ST, RV, RS); }
        else {
            const LAS float* buf = (const LAS float*)(lds + (c % 3) * RW_CHB);
            const int n0 = c * RW_CH; const int Pa = rw_stepP(d, n0); const bool desc = rw_stepP(d, n0 + RW_CH - 1) < Pa; const int Pmin = desc ? Pa - (RW_CH - 1) : Pa;
#define RW_LD(st_, W4, B4, K4, KK4, WR4, V, SC) do { const LAS float* sb_ = buf + (st_) * 320 + 4 * jg; \
                W4 = *(const LAS f32x4*)(sb_); B4 = *(const LAS f32x4*)(sb_ + 64); K4 = *(const LAS f32x4*)(sb_ + 128); KK4 = *(const LAS f32x4*)(sb_ + 192); WR4 = *(const LAS f32x4*)(sb_ + 256); \
                V = buf[RW_CH * 320 + (st_) * RW_ROWS + vrow]; SC = *(const LAS f32x2*)(buf + RW_CH * 320 + RW_CH * RW_ROWS + (st_) * 2); } while (0)
#define RW_STEP(st_, W4, B4, K4, KK4, WR4, V, SC) do { \
                const f32x2 slo_ = {S[0], S[1]}, shi_ = {S[2], S[3]}; \
                const f32x2 da_ = slo_ * (f32x2){KK4[0], KK4[1]} + shi_ * (f32x2){KK4[2], KK4[3]}, dy_ = slo_ * (f32x2){WR4[0], WR4[1]} + shi_ * (f32x2){WR4[2], WR4[3]}; \
                const f32x4 t_ = S * W4 + K4 * V;                   \
                float pa_ = da_.x + da_.y, py_ = dy_.x + dy_.y; \
                pa_ = rowsum16(pa_); py_ = rowsum16(py_); const float y_ = py_ - pa_ * SC.x + V * SC.y; \
                S = t_ - B4 * pa_; ykeep = (jg == ((st_) & 15)) ? y_ : ykeep; } while (0)
            f32x4 wA, bA, kA, kkA, wrA, wB, bB, kB, kkB, wrB; float vA, vB; f32x2 scA, scB; float ykeep = 0.f;
            RW_LD(0, wA, bA, kA, kkA, wrA, vA, scA);
#pragma unroll
            for (int s = 0; s < RW_CH; s += 2) {
                RW_LD(s + 1, wB, bB, kB, kkB, wrB, vB, scB);
                RW_STEP(s, wA, bA, kA, kkA, wrA, vA, scA);
                if (s + 2 < RW_CH) RW_LD(s + 2, wA, bA, kA, kkA, wrA, vA, scA);
                RW_STEP(s + 1, wB, bB, kB, kkB, wrB, vB, scB);
                if ((s & 15) == 14) { const int st_l = (s & 16) + jg; const int ls_l = desc ? RW_CH - 1 - st_l : st_l; RY[(size_t)(Pmin + ls_l) * DBR + vrow] = ykeep; }
            }
#undef RW_LD
#undef RW_STEP
        }
        __syncthreads();
    }
}
DI void phase_mixer_post(AP a, int l, int bid, int G) {
    const int tid = otid(), lane = tid & 63, wave = tid >> 6;
    bf16* YS = (bf16*)(a->ws + WS_YS);
    const float* HD = (const float*)(a->ws + WS_HDIR); const bf16* ZA = (const bf16*)(a->ws + WS_ZA); const float* mn = a->in[I_MNORM] + (size_t)l * DBR;
    const bool lastl = (l == NL - 1);
    if (EN_MLSTM) for (int row = bid * NWAVES + wave; row < (lastl ? SEQ : ROWS); row += G * NWAVES) {
        const int c0 = lane * 16; f32x4 y[4]; float ss = 0.f;
#pragma unroll
        for (int e = 0; e < 4; ++e) { y[e] = *(const f32x4*)(HD + (size_t)row * DBR + c0 + 4 * e) + *(const f32x4*)(HD + (size_t)(ROWS + row) * DBR + c0 + 4 * e); ss += y[e][0] * y[e][0] + y[e][1] * y[e][1] + y[e][2] * y[e][2] + y[e][3] * y[e][3]; }
        ss += __shfl_xor(ss, 1); ss += __shfl_xor(ss, 2); ss += __shfl_xor(ss, 4);
        const float rs = rsqrtf(ss * (1.f / 128.f) + NORM_EPS);
        const u32x4 o0 = *(const u32x4*)(ZA + (size_t)row * NA_P + 2048 + c0), o1 = *(const u32x4*)(ZA + (size_t)row * NA_P + 2048 + c0 + 8);
        const unsigned ow[8] = {o0.x, o0.y, o0.z, o0.w, o1.x, o1.y, o1.z, o1.w};
        f32x4 r[4];
#pragma unroll
        for (int e = 0; e < 4; ++e) { const f32x4 g = *(const f32x4*)(mn + c0 + 4 * e);
            r[e][0] = y[e][0] * rs * g[0] * sigmoidf_(__uint_as_float(ow[2 * e] << 16)); r[e][1] = y[e][1] * rs * g[1] * sigmoidf_(__uint_as_float(ow[2 * e] & 0xffff0000u));
            r[e][2] = y[e][2] * rs * g[2] * sigmoidf_(__uint_as_float(ow[2 * e + 1] << 16)); r[e][3] = y[e][3] * rs * g[3] * sigmoidf_(__uint_as_float(ow[2 * e + 1] & 0xffff0000u)); }
        { u32x4 w; w.x = pk4_fp8(r[0][0] * 8.f, r[0][1] * 8.f, r[0][2] * 8.f, r[0][3] * 8.f); w.y = pk4_fp8(r[1][0] * 8.f, r[1][1] * 8.f, r[1][2] * 8.f, r[1][3] * 8.f);
          w.z = pk4_fp8(r[2][0] * 8.f, r[2][1] * 8.f, r[2][2] * 8.f, r[2][3] * 8.f); w.w = pk4_fp8(r[3][0] * 8.f, r[3][1] * 8.f, r[3][2] * 8.f, r[3][3] * 8.f);
          *(u32x4*)(a->ws + WS_YS8 + (size_t)row * DBR + c0) = w; }
    }
    const float* RY = (const float*)(a->ws + WS_RY); const float* RG = (const float*)(a->ws + WS_RG); const float* RB = (const float*)(a->ws + WS_RBON);
    const float* lw = a->in[I_RLNW] + (size_t)l * DBR; const float* lb = a->in[I_RLNB] + (size_t)l * DBR;
    bf16* YR = YS + (size_t)2 * ROWS * DBR;
    if (EN_RWKV) for (int P = (lastl ? CTX : 0) + bid * NWAVES + wave; P < ROWS; P += G * NWAVES) {
        const int c0 = lane * 16; f32x4 y[4]; float sm = 0.f;
#pragma unroll
        for (int e = 0; e < 4; ++e) { y[e] = *(const f32x4*)(RY + (size_t)P * DBR + c0 + 4 * e) + *(const f32x4*)(RY + (size_t)(ROWS + P) * DBR + c0 + 4 * e); sm += y[e][0] + y[e][1] + y[e][2] + y[e][3]; }
        sm += __shfl_xor(sm, 1); sm += __shfl_xor(sm, 2);
        const float mean = sm * (1.f / 64.f); float sv = 0.f;
#pragma unroll
        for (int e = 0; e < 4; ++e) { y[e] = y[e] - mean; sv += y[e][0] * y[e][0] + y[e][1] * y[e][1] + y[e][2] * y[e][2] + y[e][3] * y[e][3]; }
        sv += __shfl_xor(sv, 1); sv += __shfl_xor(sv, 2);
        const float rs = rsqrtf(sv * (1.f / 64.f) + 64e-5f);
        f32x4 r[4];
#pragma unroll
        for (int e = 0; e < 4; ++e) r[e] = (y[e] * rs * *(const f32x4*)(lw + c0 + 4 * e) + *(const f32x4*)(lb + c0 + 4 * e) + *(const f32x4*)(RB + (size_t)P * DBR + c0 + 4 * e)) * *(const f32x4*)(RG + (size_t)P * DBR + c0 + 4 * e);
        const int row = rw_row(P);
        { u32x4 w; w.x = pk4_fp8(r[0][0] * 8.f, r[0][1] * 8.f, r[0][2] * 8.f, r[0][3] * 8.f); w.y = pk4_fp8(r[1][0] * 8.f, r[1][1] * 8.f, r[1][2] * 8.f, r[1][3] * 8.f);
          w.z = pk4_fp8(r[2][0] * 8.f, r[2][1] * 8.f, r[2][2] * 8.f, r[2][3] * 8.f); w.w = pk4_fp8(r[3][0] * 8.f, r[3][1] * 8.f, r[3][2] * 8.f, r[3][3] * 8.f);
          *(u32x4*)(a->ws + WS_YS8 + ((size_t)ROWS + row) * DBR + c0) = w; }
    }
}

DI void phase_moe_route(AP a, int l, LAS unsigned char* lds, int bid, int G) {
    const int tid = otid(), lane = tid & 63, wave = tid >> 6, r = lane & 15, q = lane >> 4;
    const bf16* XR = (const bf16*)(a->ws + WS_XRES); bf16* H = (bf16*)(a->ws + WS_H);
    const float* gn = a->in[I_NMOE] + (size_t)l * D; const float* WRT = (const float*)(a->ws + WS_WRT) + (size_t)l * NEXP * D;
    int* EIDX = (int*)(a->ws + WS_MOE + MOE_EIDX); float* EW = (float*)(a->ws + WS_MOE + MOE_EW); int* SLOTTOK = (int*)(a->ws + WS_MOE + MOE_SLOTTOK);
    LAS int* hist = (LAS int*)(lds + 8 * 2304);
    __syncthreads();
    if (tid < NEXP) hist[tid] = 0;
    __syncthreads();
    for (int i = bid * NTHR + tid; i < NSLOT; i += G * NTHR) SLOTTOK[i] = 0;
    LAS float* lg = (LAS float*)(lds + wave * 2304);
    LAS float* ssp = (LAS float*)(lds + 8 * 2304 + 256);
    const int qd = wave >> 2, part = wave & 3, jj0 = 32 * part;
    const int nrg = (l == NL - 1) ? SEQ / 16 : ROWS / 16;
    for (int rg0 = bid * 2; rg0 < nrg; rg0 += G * 2) {
        const int rg = rg0 + qd; const bool act = rg < nrg;
        const int row = (act ? rg : 0) * 16 + r; const int isc = row >= SEQ;
        const bf16* xr = XR + (size_t)row * D + 8 * q;
        const float* mod = (const float*)(a->ws + WS_MOD) + ((size_t)l * 2 + isc) * 6 * D + 3 * D;
        float ss = 0.f;
        if (act) {
#pragma unroll 4
            for (int jj = jj0; jj < jj0 + 32; ++jj) { f32x4 x0, x1; unpack8(*(const u32x4*)(xr + 32 * jj), x0, x1);
                ss += x0[0] * x0[0] + x0[1] * x0[1] + x0[2] * x0[2] + x0[3] * x0[3] + x1[0] * x1[0] + x1[1] * x1[1] + x1[2] * x1[2] + x1[3] * x1[3]; } }
        ss += __shfl_xor(ss, 16); ss += __shfl_xor(ss, 32);
        if (lane < 16) ssp[wave * 16 + lane] = ss;
        __syncthreads();
        ss = ssp[(qd * 4 + 0) * 16 + r] + ssp[(qd * 4 + 1) * 16 + r] + ssp[(qd * 4 + 2) * 16 + r] + ssp[(qd * 4 + 3) * 16 + r];
        const float rs = rsqrtf(ss * (1.f / D) + NORM_EPS);
        f32x4 acc0 = {0.f, 0.f, 0.f, 0.f}, acc1 = {0.f, 0.f, 0.f, 0.f};
        if (act) {
#pragma unroll 2
            for (int jj = jj0; jj < jj0 + 32; ++jj) { const int c = 32 * jj + 8 * q;
                f32x4 hv[2], xx[2]; unpack8(*(const u32x4*)(xr + 32 * jj), xx[0], xx[1]);
#pragma unroll
                for (int e = 0; e < 2; ++e) { const f32x4 x = xx[e], g = *(const f32x4*)(gn + c + 4 * e), sh = *(const f32x4*)(mod + c + 4 * e), sc = *(const f32x4*)(mod + D + c + 4 * e);
                    hv[e] = (x * rs) * g * (sc + 1.f) + sh; }
                { u32x2 h8; h8.x = pk4_fp8(hv[0][0] * 4.f, hv[0][1] * 4.f, hv[0][2] * 4.f, hv[0][3] * 4.f); h8.y = pk4_fp8(hv[1][0] * 4.f, hv[1][1] * 4.f, hv[1][2] * 4.f, hv[1][3] * 4.f);
                  *(u32x2*)((unsigned char*)H + (size_t)row * D + c) = h8; }
                const f32x4 wa0 = *(const f32x4*)(WRT + (size_t)r * D + c), wa1 = *(const f32x4*)(WRT + (size_t)r * D + c + 4), wb0 = *(const f32x4*)(WRT + (size_t)(16 + r) * D + c), wb1 = *(const f32x4*)(WRT + (size_t)(16 + r) * D + c + 4);
#pragma unroll
                for (int e = 0; e < 4; ++e) { acc0 = __builtin_amdgcn_mfma_f32_16x16x4f32(hv[0][e], wa0[e], acc0, 0, 0, 0); acc1 = __builtin_amdgcn_mfma_f32_16x16x4f32(hv[0][e], wb0[e], acc1, 0, 0, 0); }
#pragma unroll
                for (int e = 0; e < 4; ++e) { acc0 = __builtin_amdgcn_mfma_f32_16x16x4f32(hv[1][e], wa1[e], acc0, 0, 0, 0); acc1 = __builtin_amdgcn_mfma_f32_16x16x4f32(hv[1][e], wb1[e], acc1, 0, 0, 0); } } }
#pragma unroll
        for (int i = 0; i < 4; ++i) { lg[(4 * q + i) * 36 + r] = acc0[i]; lg[(4 * q + i) * 36 + 16 + r] = acc1[i]; }
        __syncthreads();
        if (act && part == 0 && lane < 16) { float v[NEXP];
            const LAS float* l0 = (const LAS float*)(lds + (qd * 4) * 2304) + lane * 36;
#pragma unroll
            for (int e = 0; e < NEXP; ++e) v[e] = ((l0[e] + l0[576 + e]) + (l0[1152 + e] + l0[1728 + e])) + a->in[I_RTB][l * NEXP + e];
            int bi[4]; float bv[4];
#pragma unroll
            for (int k = 0; k < 4; ++k) { float best = -3.0e38f; int be = 0;
#pragma unroll
                for (int e = 0; e < NEXP; ++e) { const bool taken = (k > 0 && bi[0] == e) || (k > 1 && bi[1] == e) || (k > 2 && bi[2] == e); if (!taken && v[e] > best) { best = v[e]; be = e; } }
                bi[k] = be; bv[k] = best; }
            const float e1 = __expf(bv[1] - bv[0]), e2 = __expf(bv[2] - bv[0]), e3 = __expf(bv[3] - bv[0]); const float inv = 1.f / (1.f + e1 + e2 + e3);
            const int rr = rg * 16 + lane;
            *(int4*)(EIDX + (size_t)rr * 4) = make_int4(bi[0], bi[1], bi[2], bi[3]);
            *(f32x4*)(EW + (size_t)rr * 4) = (f32x4){inv, e1 * inv, e2 * inv, e3 * inv};
#pragma unroll
            for (int k = 0; k < 4; ++k) __hip_atomic_fetch_add(hist + bi[k], 1, __ATOMIC_RELAXED, __HIP_MEMORY_SCOPE_WORKGROUP); }
        __syncthreads();
    }
    __syncthreads();
    if (tid < NEXP) ((int*)(a->ws + WS_MOE + MOE_CNTW))[bid * NEXP + tid] = hist[tid];
}
DI void phase_moe_slots(AP a, int l, LAS unsigned char* lds, int bid, int G) {
    const int tid = otid();
    LAS int* red = (LAS int*)lds;
    LAS int* base = red + 1024;
    LAS int* lc = base + 32;
    const int* CNTW = (const int*)(a->ws + WS_MOE + MOE_CNTW);
    const int* EIDX = (const int*)(a->ws + WS_MOE + MOE_EIDX); int* TOKSLOT = (int*)(a->ws + WS_MOE + MOE_TOKSLOT); int* SLOTTOK = (int*)(a->ws + WS_MOE + MOE_SLOTTOK); int* TILEE = (int*)(a->ws + WS_MOE + MOE_TILEE);
    __syncthreads();
    { const int e = tid & 31, part = tid >> 5; int tot = 0, pre = 0;
      for (int b = part; b < G; b += 16) { const int c = CNTW[b * NEXP + e]; tot += c; pre += (b < bid) ? c : 0; }
      red[part * 32 + e] = tot; red[512 + part * 32 + e] = pre; }
    __syncthreads();
    if (tid < NEXP) { int tot = 0, pre = 0;
#pragma unroll
        for (int p2 = 0; p2 < 16; ++p2) { tot += red[p2 * 32 + tid]; pre += red[512 + p2 * 32 + tid]; }
        red[tid] = tot; red[512 + tid] = pre; }
    __syncthreads();
    if (tid == 0) { int acc = 0; for (int e = 0; e < NEXP; ++e) { base[e] = acc * 256 + red[512 + e]; lc[e] = 0; const int nt = (red[e] + 255) >> 8; if (bid == 0) for (int t = 0; t < nt; ++t) TILEE[1 + acc + t] = e; acc += nt; } if (bid == 0) TILEE[0] = acc; }
    __syncthreads();
    const int nrg = (l == NL - 1) ? SEQ / 16 : ROWS / 16;
    for (int rg0 = bid * 2; rg0 < nrg; rg0 += G * 2) {
        const int rg = rg0 + (tid >> 6); if ((tid >> 6) < 2 && rg < nrg) { const int i = rg * 64 + (tid & 63); const int e = EIDX[i];
            const int slot = base[e] + __hip_atomic_fetch_add(lc + e, 1, __ATOMIC_RELAXED, __HIP_MEMORY_SCOPE_WORKGROUP); TOKSLOT[i] = slot; SLOTTOK[slot] = i >> 2; } }
}
struct MoeGU {
    static constexpr bool GATHER = true, FP8 = true;
    int K, G, c, ntile; const char* Hb; const char* Wb; const int* SLOTTOK; const int* TILEE; const float* bgu; unsigned char* ACT;
    DI bool next(int i, Unit& u) const { const long L = (long)i * G + c; if (L >= (long)ntile * 4) return false; u.pm = (int)(L >> 2); u.pn = (int)(L & 3); u.aux = TILEE[1 + u.pm]; return true; }
    DI const char* a_ptr(const Unit&) const { return Hb; }
    DI const char* b_ptr(const Unit& u) const { return Wb + ((size_t)u.aux * 1024 + (size_t)u.pn * 256) * D; }
    DI unsigned a_row_off(const Unit& u, int r) const { return (unsigned)SLOTTOK[u.pm * 256 + r] * (unsigned)D; }
    DI void epi(const f32x4 (&acc)[2][2][4][2], const Unit& u, int wr, int wc, int fr, int fq) const {
        const float* bb = bgu + (size_t)u.aux * 1024 + u.pn * 256;
        f32x4 bv[2][2];
        _Pragma("unroll") for (int bj = 0; bj < 2; ++bj) { const int cl = bj * 128 + wc * 32 + 8 * fq; bv[bj][0] = *(const f32x4*)(bb + cl); bv[bj][1] = *(const f32x4*)(bb + cl + 4); }
        EPI_LOOP({ const f32x4 x0 = v0 * (1.f / 2048.f) + bv[bj][0], x1 = v1 * (1.f / 2048.f) + bv[bj][1];
                   float o[4];
                   _Pragma("unroll") for (int e = 0; e < 4; ++e) { const float gv = e < 2 ? x0[2 * e] : x1[2 * (e - 2)], lv = e < 2 ? x0[2 * e + 1] : x1[2 * (e - 2) + 1];
                       const float glu = fminf(gv, 7.f), lin = fminf(fmaxf(lv, -7.f), 7.f); o[e] = glu * sigmoidf_(1.702f * glu) * (lin + 1.f); }
                   *(unsigned*)(ACT + (size_t)(u.pm * 256 + rl) * DEXP + (u.pn * 256 + cl) / 2) = pk4_fp8(o[0] * 4.f, o[1] * 4.f, o[2] * 4.f, o[3] * 4.f); })
    }
};
struct MoeDown {
    static constexpr bool GATHER = false, FP8 = true;
    int K, G, c, ntile; const char* Ab; const char* Wb; const int* TILEE; const float* bdn; unsigned char* YSLOT;
    DI bool next(int i, Unit& u) const { const long L = (long)i * G + c; if (L >= (long)ntile * 16) return false; u.pm = (int)(L >> 4); u.pn = (int)(L & 15); u.aux = TILEE[1 + u.pm]; return true; }
    DI const char* a_ptr(const Unit& u) const { return Ab + (size_t)u.pm * 256 * DEXP; }
    DI const char* b_ptr(const Unit& u) const { return Wb + ((size_t)u.aux * D + (size_t)u.pn * 256) * DEXP; }
    DI unsigned a_row_off(const Unit&, int) const { return 0u; }
    DI void epi(const f32x4 (&acc)[2][2][4][2], const Unit& u, int wr, int wc, int fr, int fq) const {
        const float* bb = bdn + (size_t)u.aux * D + u.pn * 256;
        f32x4 bv[2][2];
        _Pragma("unroll") for (int bj = 0; bj < 2; ++bj) { const int cl = bj * 128 + wc * 32 + 8 * fq; bv[bj][0] = *(const f32x4*)(bb + cl); bv[bj][1] = *(const f32x4*)(bb + cl + 4); }
        EPI_LOOP({ const f32x4 y0 = (v0 * (1.f / 1024.f) + bv[bj][0]) * 8.f, y1 = (v1 * (1.f / 1024.f) + bv[bj][1]) * 8.f;
                   u32x2 w; w.x = pk4_fp8(y0[0], y0[1], y0[2], y0[3]); w.y = pk4_fp8(y1[0], y1[1], y1[2], y1[3]);
                   *(u32x2*)(YSLOT + (size_t)(u.pm * 256 + rl) * D + u.pn * 256 + cl) = w; })
    }
};
DI void phase_moe_combine(AP a, int l, LAS unsigned char* lds, int bid, int G) {
    const int tid = otid(), lane = tid & 63, wave = tid >> 6;
    LAS float* xrow = (LAS float*)(lds + wave * 16384);
    bf16* XR = (bf16*)(a->ws + WS_XRES); const unsigned char* YSLOT = a->ws + WS_YSLOT; bf16* H = (bf16*)(a->ws + WS_H);
    const int* TOKSLOT = (const int*)(a->ws + WS_MOE + MOE_TOKSLOT); const float* EW = (const float*)(a->ws + WS_MOE + MOE_EW);
    const bool last = (l == NL - 1); const int nrows = last ? SEQ : ROWS;
    const float* gn = last ? a->in[I_NFIN] : a->in[I_NMIX] + (size_t)(l + 1) * D;
    for (int row = bid * NWAVES + wave; row < nrows; row += G * NWAVES) {
        const int isc = row >= SEQ;
        const float* g2 = (const float*)(a->ws + WS_MOD) + ((size_t)l * 2 + isc) * 6 * D + 5 * D;
        const float* modn = (const float*)(a->ws + WS_MOD) + ((size_t)(last ? l : l + 1) * 2 + isc) * 6 * D;
        const int4 sl = *(const int4*)(TOKSLOT + (size_t)row * 4); const f32x4 ww = *(const f32x4*)(EW + (size_t)row * 4);
        const int sls[4] = {sl.x, sl.y, sl.z, sl.w};
        float ss = 0.f;
#pragma unroll 1
        for (int jb = 0; jb < 4; ++jb) {
            u32x2 y[2][4]; u32x4 xr[2]; f32x4 ga[2], gb[2];
#pragma unroll
            for (int jj = 0; jj < 2; ++jj) { const int c = 8 * (lane + 64 * (2 * jb + jj));
#pragma unroll
                for (int k = 0; k < 4; ++k) y[jj][k] = *(const u32x2*)(YSLOT + (size_t)sls[k] * D + c);
                xr[jj] = *(const u32x4*)(XR + (size_t)row * D + c); ga[jj] = *(const f32x4*)(g2 + c); gb[jj] = *(const f32x4*)(g2 + c + 4); }
#pragma unroll
            for (int jj = 0; jj < 2; ++jj) { const int j = 2 * jb + jj; const int c = 8 * (lane + 64 * j);
                f32x4 s0 = {0.f, 0.f, 0.f, 0.f}, s1 = {0.f, 0.f, 0.f, 0.f};
#pragma unroll
                for (int k = 0; k < 4; ++k) { const u32x2 yy = y[jj][k]; const float wk = ww[k] * 0.125f;
                    const f32x2 a0 = __builtin_amdgcn_cvt_pk_f32_fp8((int)yy.x, false), a1 = __builtin_amdgcn_cvt_pk_f32_fp8((int)yy.x, true), a2 = __builtin_amdgcn_cvt_pk_f32_fp8((int)yy.y, false), a3 = __builtin_amdgcn_cvt_pk_f32_fp8((int)yy.y, true);
                    s0[0] += wk * a0.x; s0[1] += wk * a0.y; s0[2] += wk * a1.x; s0[3] += wk * a1.y; s1[0] += wk * a2.x; s1[1] += wk * a2.y; s1[2] += wk * a3.x; s1[3] += wk * a3.y; }
                f32x4 xa, xb; unpack8(xr[jj], xa, xb);
                const f32x4 x0 = xa + ga[jj] * s0, x1 = xb + gb[jj] * s1;
                *(LAS f32x4*)(xrow + c) = x0; *(LAS f32x4*)(xrow + c + 4) = x1;
                if (!last) *(u32x4*)(XR + (size_t)row * D + c) = pack8(x0, x1);
                ss += x0[0] * x0[0] + x0[1] * x0[1] + x0[2] * x0[2] + x0[3] * x0[3] + x1[0] * x1[0] + x1[1] * x1[1] + x1[2] * x1[2] + x1[3] * x1[3]; }
        }
        const float rs = rsqrtf(wave_sum(ss) * (1.f / D) + NORM_EPS);
#pragma unroll 1
        for (int jb = 0; jb < 4; ++jb) {
            f32x4 g0[2], g1[2], sh0[2], sh1[2], sc0[2], sc1[2];
#pragma unroll
            for (int jj = 0; jj < 2; ++jj) { const int c = 8 * (lane + 64 * (2 * jb + jj));
                g0[jj] = *(const f32x4*)(gn + c); g1[jj] = *(const f32x4*)(gn + c + 4);
                if (!last) { sh0[jj] = *(const f32x4*)(modn + c); sh1[jj] = *(const f32x4*)(modn + c + 4); sc0[jj] = *(const f32x4*)(modn + D + c); sc1[jj] = *(const f32x4*)(modn + D + c + 4); } }
#pragma unroll
            for (int jj = 0; jj < 2; ++jj) { const int j = 2 * jb + jj; const int c = 8 * (lane + 64 * j);
                const f32x4 x0 = *(const LAS f32x4*)(xrow + c), x1 = *(const LAS f32x4*)(xrow + c + 4);
                if (last) { *(f32x4*)(a->out + (size_t)row * D + c) = (x0 * rs) * g0[jj]; *(f32x4*)(a->out + (size_t)row * D + c + 4) = (x1 * rs) * g1[jj]; }
                else { const f32x4 h0 = (x0 * rs) * g0[jj] * (sc0[jj] + 1.f) + sh0[jj], h1 = (x1 * rs) * g1[jj] * (sc1[jj] + 1.f) + sh1[jj];
                    *(u32x4*)(H + (size_t)row * D + c) = pack8(h0, h1);
                    u32x2 h8; h8.x = pk4_fp8(h0[0] * 4.f, h0[1] * 4.f, h0[2] * 4.f, h0[3] * 4.f); h8.y = pk4_fp8(h1[0] * 4.f, h1[1] * 4.f, h1[2] * 4.f, h1[3] * 4.f);
                    *(u32x2*)(a->ws + WS_H8 + (size_t)row * D + c) = h8; } }
        }
    }
}

__global__ void __launch_bounds__(NTHR, 2) mk_fwd(Args a_by_value) {
    AP a0 = (AP)__builtin_amdgcn_kernarg_segment_ptr();
    extern __shared__ __attribute__((aligned(16))) unsigned char lds_raw[];
    LAS unsigned char* lds = (LAS unsigned char*)lds_raw;
    volatile LAS unsigned* MISC = (volatile LAS unsigned*)(lds + MISC_OFF);
    const int tid = threadIdx.x, G = gridDim.x, bid = blockIdx.x;
    unsigned char* ws = a0->ws; const int ph_lo = a0->ph_lo, ph_hi = a0->ph_hi;
    for (int u = tid; u < (LDS_SMALL - LDSCTL_OFF) / 4; u += NTHR) ((LAS unsigned*)(lds + LDSCTL_OFF))[u] = 0u;
    __syncthreads();
    XcdBarrier bar; bar.bar = (unsigned*)(ws + WS_CTL) + 4096; bar.x = 0; bar.st = nullptr;
    if (!MK_MULTI) bar = xcd_barrier_post((unsigned*)(ws + WS_CTL) + 4096, MISC + 8);
    int ph = 0;
#ifndef PHMASK
#define PHMASK 0xffffffffu
#endif
#define PH(id, ...) { if (((PHMASK >> (id)) & 1u) && ph >= ph_lo && ph < ph_hi) { AP a = a0; asm volatile("" : "+s"(a)); unsigned char* ws = a->ws; __VA_ARGS__ } ++ph; if (!MK_MULTI) { XcdBarrier bb = bar; asm volatile("" : "+s"(bb.bar), "+s"(bb.x)); xcd_barrier(bb); } }

    PH(0, phase_prologue(a, lds, bid, G);)
    PH(1, phase_mod_reduce(a, bid, G);)
#define LAYER(l) \
        PH(2, if (l == 0 || !EN_MOE) phase_norm_mod(a, l, 0, l == 0, bid, G);) \
        PH(3, { \
            const bool lastl = (l == NL - 1); \
            InProj8 P; P.K = D; P.G = G; P.c = bid; P.lastl = lastl; P.Hb = (const char*)(ws + WS_H8); P.Wb = (const char*)(ws + WS_WIN8 + l * WIN8_L); \
            P.ZA = (bf16*)(ws + WS_ZA); P.GATES = (float*)(ws + WS_GATES); P.ZC = (bf16*)(ws + WS_ZC); P.SGp = (bf16*)(ws + WS_SG); \
            pg8::gemm_phase(lds, P); \
            const int u8 = lastl ? (NPAN - 1) * TF8 + TAC : NPAN * TF8;             \
            InProj16 Q; Q.K = D; Q.G = G; Q.c = (bid - u8 % G + G) % G; Q.nM = lastl ? NPAN - 1 : NPAN; Q.Hb = (const char*)(ws + WS_H); Q.Wb = (const char*)(ws + WS_WIN + l * WIN_L); \
            Q.ZBT = (float*)(ws + WS_ZBT); Q.SGp = (bf16*)(ws + WS_SG); \
            pg8::gemm_phase(lds, Q); }) \
        PH(4, { if (EN_RWKV) for (int it = bid; it < ROWS / PT; it += G) rwkv_prep_item(a, l, it, lds); }) \
        PH(5, { \
            if (G >= 192) { \
                if (bid < 128) { if (EN_RWKV) rwkv_scan(a, bid, lds); } \
                else if (bid < 144) { if (EN_MLSTM) mlstm_scan(a, l, (bid - 128) & 7, (bid - 128) >> 3, lds); } \
            } else { \
                if (EN_RWKV) for (int it = bid; it < 128; it += G) rwkv_scan(a, it, lds); \
                if (EN_MLSTM) for (int hdx = bid; hdx < 16; hdx += G) mlstm_scan(a, l, hdx & 7, hdx >> 3, lds); \
            } \
            { unsigned* hq = (unsigned*)(ws + WS_CTL) + CW_HQ + 64 * l; LAS int* qs = (LAS int*)(lds + LDS_SMALL + 2048); \
              for (;;) { __syncthreads(); if (threadIdx.x == 0) qs[0] = (int)__hip_atomic_fetch_add(hq, 1u, __ATOMIC_RELAXED, __HIP_MEMORY_SCOPE_AGENT); __syncthreads(); \
                  int it = qs[0]; \
                  {                          \
                      if (it < (CVQ_R + 1) * cvq_q(l)) { const int q = it / (CVQ_R + 1), r = it - q * (CVQ_R + 1); \
                          if (r != 0) { const int cc = CVQ_R * q + r - 1; if (cc < cvq_nch(l)) conv_chunk(a, cc, lds, l); continue; } \
                          it = q; } \
                      else it = cvq_q(l) + (it - (CVQ_R + 1) * cvq_q(l)); } \
                  if (it >= ((l == NL - 1) ? DBR : 2 * DBR)) break; \
                  const int seq = it >= DBR, ch = it & (DBR - 1); hyena_item(a, l, ch, seq, lds, ws + WS_HSCR + (size_t)bid * HSCR_WG); } } }) \
        PH(6, { phase_mixer_post(a, l, bid, G); phase_yb_transpose(a, lds, bid, G, (l == NL - 1) ? SEQ / 64 : ROWS / 64); }) \
        PH(7, { \
            const int nMb = (l == NL - 1) ? NPAN - 1 : NPAN; \
            BranchProj8 P; P.K = DBR; P.G = G; P.c = bid; P.nM = nMb; P.YS = (const char*)(ws + WS_YS8); P.Wb = (const char*)(ws + WS_WBR8 + (size_t)l * 2 * D * DBR); \
            P.SGp = (const bf16*)(ws + WS_SG); P.M32 = (bf16*)(ws + WS_MERGED); \
            pg8::gemm_phase(lds, P); \
            BranchProj16 Q; Q.K = DBR; Q.G = G; Q.c = bid; Q.nM = nMb; Q.YS = (const char*)(ws + WS_YS); Q.Wb = (const char*)(ws + WS_WBR + l * WBR_L); \
            Q.SGp = (const bf16*)(ws + WS_SG); Q.M32 = (const bf16*)(ws + WS_MERGED); Q.MERGED = (bf16*)(ws + WS_MERGED); \
            pg8::gemm_phase(lds, Q); }) \
        PH(8, { \
            OutProj P; P.K = D; P.G = G; P.c = bid; P.nM = (l == NL - 1) ? NPAN - 1 : NPAN; P.Ab = (const char*)(ws + WS_MERGED); P.Wb = (const char*)(ws + WS_WOUT + l * WOUT_L); \
            P.XR = (bf16*)(ws + WS_XRES); P.gate = (const float*)(ws + WS_MOD) + (size_t)l * 2 * 6 * D + 2 * D; P.xin = (l == 0) ? a->in[I_X] : nullptr; P.cin = (l == 0) ? a->in[I_CTX] : nullptr; \
            pg8::gemm_phase(lds, P); }) \
        PH(9, if (EN_MOE) phase_moe_route(a, l, lds, bid, G);) \
        PH(10, if (EN_MOE) phase_moe_slots(a, l, lds, bid, G);) \
        PH(11, if (EN_MOE) { \
            MoeGU P; P.K = D; P.G = G; P.c = bid; P.TILEE = (const int*)(ws + WS_MOE + MOE_TILEE); P.ntile = P.TILEE[0]; P.Hb = (const char*)(ws + WS_H); P.Wb = (const char*)(ws + WS_WGU + l * WGU_L); \
            P.SLOTTOK = (const int*)(ws + WS_MOE + MOE_SLOTTOK); P.bgu = a->in[I_EBGU] + (size_t)l * NEXP * 1024; P.ACT = ws + WS_ACT; \
            pg8::gemm_phase(lds, P); }) \
        PH(12, if (EN_MOE) { \
            MoeDown P; P.K = DEXP; P.G = G; P.c = bid; P.TILEE = (const int*)(ws + WS_MOE + MOE_TILEE); P.ntile = P.TILEE[0]; P.Ab = (const char*)(ws + WS_ACT); P.Wb = (const char*)(ws + WS_WDN + l * WDN_L); \
            P.bdn = a->in[I_EBDN] + (size_t)l * NEXP * D; P.YSLOT = ws + WS_YSLOT; \
            pg8::gemm_phase(lds, P); }) \
        PH(13, if (EN_MOE) phase_moe_combine(a, l, lds, bid, G);)
    LAYER(0)
    LAYER(1)
#undef LAYER
    PH(14, if (!EN_MOE) phase_final_norm(a, bid, G);)
}
constexpr int N_PHASES = 2 + NL * 12 + 1;

extern "C" void kernel_launch(void* const* d_in, const int* in_sizes, int n_in, void* d_out, int out_size, void* d_ws, size_t ws_size, hipStream_t stream) {
    static int grid = 0;
    if (grid == 0) {
        if (n_in != 40 || ws_size < WS_END0) { fprintf(stderr, "kernel_launch: unexpected n_in %d / ws %zu (need %zu)\n", n_in, ws_size, (size_t)WS_END0); grid = -1; return; }
        int dev = 0, cus = 0, per_cu = 0;
        if (hipGetDevice(&dev) != hipSuccess || hipDeviceGetAttribute(&cus, hipDeviceAttributeMultiprocessorCount, dev) != hipSuccess) { grid = -1; return; }
        if (hipFuncSetAttribute((const void*)mk_fwd, hipFuncAttributeMaxDynamicSharedMemorySize, LDS_BYTES) != hipSuccess) { fprintf(stderr, "kernel_launch: hipFuncSetAttribute failed\n"); grid = -1; return; }
        if (hipOccupancyMaxActiveBlocksPerMultiprocessor(&per_cu, (const void*)mk_fwd, NTHR, LDS_BYTES) != hipSuccess || per_cu < 1) { fprintf(stderr, "kernel_launch: occupancy query says %d\n", per_cu); }
        (void)hipGetLastError();
        grid = cus;
    }
    if (grid < 0) return;
    if (hipMemsetAsync((char*)d_ws + WS_CTL, 0, CTL_ZERO_BYTES, stream) != hipSuccess) return;
    Args a{};
    for (int i = 0; i < 40; ++i) a.in[i] = (const float*)d_in[i];
    a.out = (float*)d_out; a.ws = (unsigned char*)d_ws;
#if MK_MULTI
    for (int p = 0; p < N_PHASES; ++p) { a.ph_lo = p; a.ph_hi = p + 1; hipLaunchKernelGGL(mk_fwd, dim3(grid), dim3(NTHR), LDS_BYTES, stream, a); }
#else
    a.ph_lo = 0; a.ph_hi = N_PHASES;
    hipLaunchKernelGGL(mk_fwd, dim3(grid), dim3(NTHR), LDS_BYTES, stream, a);
#endif
}
```
